# Optimizing an MI355X kernel written in HIP

```python
import math
import jax, jax.numpy as jnp
from jax import lax
import numpy as np


D_MODEL = 1024
BATCH = 16
SEQ = 4096
DEPTH = 1

HEAD_DIM = 64
A_HEADS = 4
A_VDIM = 2 * HEAD_DIM
B_HEADS = 8
B_KV_HEADS = 2
B_GROUP = B_HEADS // B_KV_HEADS
IDX_HEADS = 8
IDX_DIM = 64
TOPK_MAX = 256
N_BUCKETS = 32
MAX_DISTANCE = 128
D_FF = 2816
CONV_W = 3
Q_BLOCK = 128
EPS = 1e-6
MIX_WIDTH = A_HEADS * A_VDIM + B_HEADS * HEAD_DIM
IN_SIZES = (A_HEADS * 2 * HEAD_DIM, A_HEADS * 2 * HEAD_DIM, A_HEADS * A_VDIM,
            B_HEADS * HEAD_DIM, B_KV_HEADS * HEAD_DIM, B_KV_HEADS * HEAD_DIM,
            IDX_HEADS * IDX_DIM, IDX_DIM, IDX_HEADS)
IN_COLS = sum(IN_SIZES)

kernel_name = 'hybrid_diffattn_dsa_convffn_block'


def rms_norm(x, g):
    xf = x.astype(jnp.float32)
    y = xf * lax.rsqrt(jnp.mean(xf * xf, axis=-1, keepdims=True) + EPS)
    return (y * g.astype(jnp.float32)).astype(x.dtype)


def t5_bucket(rel):
    n = jnp.maximum(rel, 0)
    max_exact = N_BUCKETS // 2
    nf = jnp.maximum(n, 1).astype(jnp.float32)
    large = max_exact + (jnp.log(nf / max_exact) / math.log(MAX_DISTANCE / max_exact)
                         * (N_BUCKETS - max_exact)).astype(jnp.int32)
    large = jnp.minimum(large, N_BUCKETS - 1)
    return jnp.where(n < max_exact, n, large)


def diff_attention(q, k, v, lam, lam_init, subln_g, bias_a):
    B_, S_, H, _, Dh = q.shape
    E = v.shape[-1]
    nb = S_ // Q_BLOCK
    kpos = jnp.arange(S_)
    scale = Dh ** -0.5

    def block(i):
        start = i * Q_BLOCK
        qb = lax.dynamic_slice_in_dim(q, start, Q_BLOCK, axis=1)
        qpos = start + jnp.arange(Q_BLOCK)
        rel = qpos[:, None] - kpos[None, :]
        bias = jnp.transpose(bias_a[t5_bucket(rel)], (2, 0, 1))
        logits = jnp.einsum('bthcd,bshcd->bhcts', qb, k).astype(jnp.float32) * scale
        logits = logits + bias[None, :, None].astype(jnp.float32)
        logits = jnp.where((rel >= 0)[None, None, None], logits, -jnp.inf)
        p = jax.nn.softmax(logits, axis=-1)
        attn = p[:, :, 0] - lam * p[:, :, 1]
        return jnp.einsum('bhts,bshe->bthe', attn.astype(v.dtype), v)

    out = lax.map(block, jnp.arange(nb))
    out = jnp.moveaxis(out, 0, 1).reshape(B_, S_, H, E)
    out = rms_norm(out, subln_g) * (1.0 - lam_init)
    return out.reshape(B_, S_, H * E)


def dsa_attention(q, k, v, iq, ik, iw, bias_b):
    B_, S_, HB, Dh = q.shape
    G = k.shape[2]
    R = HB // G
    topk = min(TOPK_MAX, S_ // 4)
    nb = S_ // Q_BLOCK
    kpos = jnp.arange(S_)
    scale = Dh ** -0.5

    def block(i):
        start = i * Q_BLOCK
        qb = lax.dynamic_slice_in_dim(q, start, Q_BLOCK, axis=1)
        iqb = lax.dynamic_slice_in_dim(iq, start, Q_BLOCK, axis=1)
        iwb = lax.dynamic_slice_in_dim(iw, start, Q_BLOCK, axis=1)
        qpos = start + jnp.arange(Q_BLOCK)
        causal = qpos[:, None] >= kpos[None, :]
        s_h = jax.nn.relu(jnp.einsum('bthd,bsd->bths', iqb, ik).astype(jnp.float32))
        score = jnp.einsum('bth,bths->bts', iwb.astype(jnp.float32), s_h)
        score = jnp.where(causal[None], score, -jnp.inf)
        _, idx = lax.top_k(score, topk)
        valid = idx <= qpos[None, :, None]
        kg = jax.vmap(lambda a, ix: a[ix])(k, idx)
        vg = jax.vmap(lambda a, ix: a[ix])(v, idx)
        qg = qb.reshape(B_, Q_BLOCK, G, R, Dh)
        logits = jnp.einsum('btgrd,btkgd->btgrk', qg, kg).astype(jnp.float32) * scale
        bias = bias_b[t5_bucket(qpos[None, :, None] - idx)]
        bias = jnp.transpose(bias.reshape(B_, Q_BLOCK, topk, G, R), (0, 1, 3, 4, 2))
        logits = jnp.where(valid[:, :, None, None, :], logits + bias.astype(jnp.float32), -jnp.inf)
        p = jax.nn.softmax(logits, axis=-1)
        o = jnp.einsum('btgrk,btkgd->btgrd', p.astype(vg.dtype), vg)
        return o.reshape(B_, Q_BLOCK, HB * Dh)

    out = lax.map(block, jnp.arange(nb))
    return jnp.moveaxis(out, 0, 1).reshape(B_, S_, HB * Dh)


def causal_dwconv(u, w, b):
    S_ = u.shape[1]
    up = jnp.pad(u, ((0, 0), (CONV_W - 1, 0), (0, 0)))
    y = b
    for j in range(CONV_W):
        y = y + up[:, j:j + S_] * w[j]
    return y


def setup_inputs(seed: int = 0) -> dict:
    key = jax.random.key(seed)
    ks = jax.random.split(key, 24)
    f32 = jnp.float32

    def nrm(k, shape, s):
        return jax.random.normal(k, shape, f32) * s

    L = DEPTH
    return {
        'x': nrm(ks[0], (BATCH, SEQ, D_MODEL), 1.0),
        'c': nrm(ks[1], (BATCH, D_MODEL), 1.0),
        'w_ada': nrm(ks[2], (L, D_MODEL, 6 * D_MODEL), 0.5 * D_MODEL ** -0.5),
        'b_ada': nrm(ks[3], (L, 6 * D_MODEL), 0.01),
        'g_attn': 1.0 + nrm(ks[4], (L, D_MODEL), 0.01),
        'w_in': nrm(ks[5], (L, D_MODEL, IN_COLS), D_MODEL ** -0.5),
        'q_norm_a': 1.0 + nrm(ks[6], (L, HEAD_DIM), 0.01),
        'k_norm_a': 1.0 + nrm(ks[7], (L, HEAD_DIM), 0.01),
        'q_norm_b': 1.0 + nrm(ks[8], (L, HEAD_DIM), 0.01),
        'k_norm_b': 1.0 + nrm(ks[9], (L, HEAD_DIM), 0.01),
        'lam_vecs': nrm(ks[10], (L, 4, HEAD_DIM), 0.1),
        'subln_a': 1.0 + nrm(ks[11], (L, A_VDIM), 0.01),
        'w_out': nrm(ks[12], (L, MIX_WIDTH, D_MODEL), MIX_WIDTH ** -0.5),
        'g_ffn': 1.0 + nrm(ks[13], (L, D_MODEL), 0.01),
        'w_up': nrm(ks[14], (L, D_MODEL, 2 * D_FF), D_MODEL ** -0.5),
        'conv_w': nrm(ks[15], (L, CONV_W, 2 * D_FF), CONV_W ** -0.5),
        'conv_b': nrm(ks[16], (L, 2 * D_FF), 0.01),
        'w_down': nrm(ks[17], (L, D_FF, D_MODEL), D_FF ** -0.5),
        'rel_bias': nrm(ks[18], (N_BUCKETS, A_HEADS + B_HEADS), 0.5),
    }


def reference(x, c, w_ada, b_ada, g_attn, w_in, q_norm_a, k_norm_a, q_norm_b, k_norm_b,
              lam_vecs, subln_a, w_out, g_ffn, w_up, conv_w, conv_b, w_down, rel_bias):
    B_, S_, _ = x.shape
    split_points = [int(v) for v in np.cumsum(IN_SIZES)[:-1]]
    bias_a = rel_bias[:, :A_HEADS]
    bias_b = rel_bias[:, A_HEADS:]
    for l in range(DEPTH):
        lam_init = 0.8 - 0.6 * math.exp(-0.3 * l)
        mod = jax.nn.silu(c) @ w_ada[l] + b_ada[l]
        sh_a, sc_a, gt_a, sh_f, sc_f, gt_f = jnp.split(mod, 6, axis=-1)

        h = rms_norm(x, g_attn[l]) * (1.0 + sc_a[:, None]) + sh_a[:, None]
        proj = h @ w_in[l]
        aq, ak, av, bq, bk, bv, iq, ik, iw = jnp.split(proj, split_points, axis=-1)
        aq = rms_norm(aq.reshape(B_, S_, A_HEADS, 2, HEAD_DIM), q_norm_a[l])
        ak = rms_norm(ak.reshape(B_, S_, A_HEADS, 2, HEAD_DIM), k_norm_a[l])
        av = av.reshape(B_, S_, A_HEADS, A_VDIM)
        bq = rms_norm(bq.reshape(B_, S_, B_HEADS, HEAD_DIM), q_norm_b[l])
        bk = rms_norm(bk.reshape(B_, S_, B_KV_HEADS, HEAD_DIM), k_norm_b[l])
        bv = bv.reshape(B_, S_, B_KV_HEADS, HEAD_DIM)
        iq = iq.reshape(B_, S_, IDX_HEADS, IDX_DIM)
        iw = iw * (IDX_HEADS * IDX_DIM) ** -0.5

        lv = lam_vecs[l].astype(jnp.float32)
        lam = jnp.exp(jnp.sum(lv[0] * lv[1])) - jnp.exp(jnp.sum(lv[2] * lv[3])) + lam_init

        o_a = diff_attention(aq, ak, av, lam, lam_init, subln_a[l], bias_a)
        o_b = dsa_attention(bq, bk, bv, iq, ik, iw, bias_b)
        mixed = jnp.concatenate([o_a, o_b], axis=-1) @ w_out[l]
        x = x + gt_a[:, None] * mixed

        h = rms_norm(x, g_ffn[l]) * (1.0 + sc_f[:, None]) + sh_f[:, None]
        u = causal_dwconv(h @ w_up[l], conv_w[l], conv_b[l])
        u_gate, u_val = jnp.split(u, 2, axis=-1)
        y = (jax.nn.silu(u_gate) * u_val) @ w_down[l]
        x = x + gt_f[:, None] * y
    return x
```

```cpp
#include <hip/hip_runtime.h>
#include <hip/hip_cooperative_groups.h>
#include <cstdio>
#include <cstdint>
#include <cmath>
namespace cg = cooperative_groups;

namespace pg8 {
#define PG8_LAS __attribute__((address_space(3)))
typedef unsigned short bf16_t;
typedef short bf16x8 __attribute__((ext_vector_type(8)));
typedef float f32x4 __attribute__((ext_vector_type(4)));
typedef unsigned u32x4 __attribute__((ext_vector_type(4)));
constexpr int BM = 256, BK = 64, HALF = 128, HTB = HALF * BK * 2  , STAGE_BYTES = 8 * HTB, NXCD = 8, WGM = 8;

__host__ __device__ __forceinline__ int lds_byte(int r, int c) { const int st = (r >> 4) * 2 + (c >> 5), rr = r & 15, cc = c & 31, ob = rr * 64 + cc * 2; return st * 1024 + (ob ^ (((ob >> 9) & 1) << 5)); }
__host__ __device__ __forceinline__ void stage_rc(int b, int& R, int& C) { const int st = b / 1024, sb = b % 1024, swz = sb ^ (((sb >> 9) & 1) << 5); R = (st >> 1) * 16 + swz / 64; C = (st & 1) * 32 + (swz % 64) / 2; }
__host__ __device__ __forceinline__ int perm32(int rho) { const int n = rho >> 4, i = rho & 15; return 8 * (i >> 2) + 4 * n + (i & 3); }

struct Unit { int pm, pn; };
struct Gemm { const bf16_t* A; const bf16_t* Bt; int M, N, K; int a_rows = 256; };

struct StaticOrder {
    int nM, nN, nwg, G, c;
    __host__ __device__ void init(int M, int N, int G_, int c_) { nM = M / BM; nN = N / BM; nwg = nM * nN; G = G_; c = c_; }
    __host__ __device__ bool next(int i, Unit& u) const {
        const long L = (long)i * G + c; if (L >= nwg) return false;
        int wgid = (int)L; { const int q = nwg / NXCD, r = nwg % NXCD, xcd = wgid % NXCD, off = wgid / NXCD; wgid = (xcd < r ? xcd * (q + 1) : r * (q + 1) + (xcd - r) * q) + off; }
        const int nig = WGM * nN, gid = wgid / nig, fm = gid * WGM, gsz = (nM - fm) < WGM ? (nM - fm) : WGM;
        u.pm = fm + ((wgid % nig) % gsz); u.pn = (wgid % nig) / gsz; return true;
    }
    __device__ __forceinline__ void a_ready(const Unit&) const {}
    __device__ __forceinline__ void done(const Unit&) const {}
};

__device__ __forceinline__ unsigned cvt_pk_bf16(float lo, float hi) { unsigned r; asm volatile("v_cvt_pk_bf16_f32 %0, %1, %2" : "=v"(r) : "v"(lo), "v"(hi)); return r; }
template <class Epi, class Sched, bool ALIGN_EPI = false, bool SP2 = false>
__device__ __forceinline__ void gemm_phase(PG8_LAS unsigned char* lds, const Gemm g, const Sched& S, const Epi& E, const int wv) {
    int tid_; asm volatile("v_mbcnt_lo_u32_b32 %0, -1, 0\n\tv_mbcnt_hi_u32_b32 %0, -1, %0" : "=v"(tid_)); tid_ += wv * 64;
    const int tid = tid_, wid = __builtin_amdgcn_readfirstlane(tid >> 6), lane = tid & 63, wr = wid >> 2, wc = wid & 3, fr = lane & 15, fq = lane >> 4;
    const int K = g.K, nt = K / BK;
    unsigned voffA[2], voffB[2];
#pragma unroll
    for (int i = 0; i < 2; ++i) { int R, C; stage_rc(tid * 16 + i * 8192, R, C); const int Rb = Epi::PERM ? ((R & ~31) + perm32(R & 31)) : R;
        voffA[i] = (unsigned)(R * K + C) * 2u; voffB[i] = (unsigned)(Rb * K + C) * 2u; }
    const size_t kstep = (size_t)(BK * 2);
    const size_t hstep = (size_t)HALF * K * 2;
    const size_t tstep = 2 * hstep; const size_t tstepA = (size_t)g.a_rows * K * 2;
    const unsigned ldsw = (unsigned)wid * 1024u;
    const int aoff = lds_byte(wr * 64 + fr, fq * 8), boff = lds_byte(wc * 32 + fr, fq * 8);
#define PG8_SA(b, h) (((b) * 2 + (h)) * HTB)
#define PG8_SB(b, h) ((4 + (b) * 2 + (h)) * HTB)
#define PG8_STAGE(bufoff, gbase, voff) do { _Pragma("unroll") for (int _i = 0; _i < 2; ++_i) \
        __builtin_amdgcn_global_load_lds((const unsigned*)((const char*)(gbase) + (voff)[_i]), (PG8_LAS unsigned*)(lds + (bufoff) + ldsw + _i * 8192), 16, 0, 0); } while (0)
#define PG8_LDA(dst, b, h) do { _Pragma("unroll") for (int m = 0; m < 4; ++m) _Pragma("unroll") for (int k = 0; k < 2; ++k) dst[m][k] = *(const PG8_LAS bf16x8*)(lds + PG8_SA(b, h) + aoff + m * 2048 + k * 1024); } while (0)
#define PG8_LDB(dst, b, h) do { _Pragma("unroll") for (int n = 0; n < 2; ++n) _Pragma("unroll") for (int k = 0; k < 2; ++k) dst[n][k] = *(const PG8_LAS bf16x8*)(lds + PG8_SB(b, h) + boff + n * 2048 + k * 1024); } while (0)
#define PG8_MMA(ai, bj, At, Bt) do { __builtin_amdgcn_s_setprio(1); _Pragma("unroll") for (int m = 0; m < 4; ++m) _Pragma("unroll") for (int n = 0; n < 2; ++n) _Pragma("unroll") for (int k = 0; k < 2; ++k) \
        acc[ai][bj][m][n] = __builtin_amdgcn_mfma_f32_16x16x32_bf16(Bt[n][k], At[m][k], acc[ai][bj][m][n], 0, 0, 0); __builtin_amdgcn_s_setprio(0); } while (0)
#define PG8_WAIT_V(n) asm volatile("s_waitcnt vmcnt(" #n ")" ::: "memory")
#define PG8_WAIT_L(n) asm volatile("s_waitcnt lgkmcnt(" #n ")" ::: "memory")
#define PG8_BAR __builtin_amdgcn_s_barrier()
#define PG8_SCHED __builtin_amdgcn_sched_barrier(0)
    Unit cur, nxt; int ui = 0;
    if (!S.next(0, cur)) return;
    f32x4 acc[2][2][4][2];
#pragma unroll
    for (int a = 0; a < 2; ++a)
#pragma unroll
        for (int b = 0; b < 2; ++b)
#pragma unroll
            for (int m = 0; m < 4; ++m)
#pragma unroll
                for (int n = 0; n < 2; ++n) acc[a][b][m][n] = (f32x4){0.f, 0.f, 0.f, 0.f};
    bf16x8 At[4][2], B0[2][2], B1[2][2];
    const char* cA = (const char*)g.A + (size_t)cur.pm * tstepA; const char* cB = (const char*)g.Bt + (size_t)cur.pn * tstep;
    S.a_ready(cur);
    if constexpr (SP2) {
        PG8_STAGE(PG8_SB(0, 0), cB, voffB); PG8_STAGE(PG8_SB(0, 1), cB + hstep, voffB); PG8_STAGE(PG8_SA(0, 0), cA, voffA); PG8_STAGE(PG8_SA(0, 1), cA + hstep, voffA);
        if (wr == 1) PG8_BAR;
        PG8_WAIT_V(2); PG8_BAR;
        PG8_STAGE(PG8_SB(1, 0), cB + kstep, voffB); PG8_STAGE(PG8_SA(1, 0), cA + kstep, voffA); PG8_STAGE(PG8_SB(1, 1), cB + hstep + kstep, voffB);
        PG8_WAIT_V(6); PG8_BAR;
    } else {
        PG8_STAGE(PG8_SB(0, 0), cB, voffB); PG8_STAGE(PG8_SA(0, 0), cA, voffA); PG8_STAGE(PG8_SB(0, 1), cB + hstep, voffB); PG8_STAGE(PG8_SA(0, 1), cA + hstep, voffA);
        if (wr == 1) PG8_BAR;
        PG8_WAIT_V(4); PG8_BAR;
        PG8_STAGE(PG8_SB(1, 0), cB + kstep, voffB); PG8_STAGE(PG8_SA(1, 0), cA + kstep, voffA); PG8_STAGE(PG8_SB(1, 1), cB + hstep + kstep, voffB);
        PG8_WAIT_V(6); PG8_BAR;
    }
    for (;;) {
        const bool has_next = S.next(ui + 1, nxt);
        const char* nA = has_next ? (const char*)g.A + (size_t)nxt.pm * tstepA : cA; const char* nB = has_next ? (const char*)g.Bt + (size_t)nxt.pn * tstep : cB;
        for (int t = 0; t < nt; t += 2) {
            const bool last = (t == nt - 2);
            const char* a1 = cA + (size_t)(t + 1) * kstep;
            const char* a2 = last ? nA : cA + (size_t)(t + 2) * kstep; const char* b2 = last ? nB : cB + (size_t)(t + 2) * kstep;
            const char* a3 = a2 + kstep; const char* b3 = b2 + kstep;
            if (last && has_next) S.a_ready(nxt);
            if constexpr (SP2) {
            PG8_LDB(B0, 0, 0); PG8_LDB(B1, 0, 1); PG8_SCHED; PG8_LDA(At, 0, 0); PG8_STAGE(PG8_SA(1, 1), a1 + hstep, voffA);
            PG8_WAIT_V(8); PG8_WAIT_L(0); PG8_BAR; PG8_MMA(0, 0, At, B0); PG8_MMA(0, 1, At, B1); PG8_BAR; PG8_SCHED;
            PG8_LDA(At, 0, 1); PG8_STAGE(PG8_SB(0, 0), b2, voffB); PG8_STAGE(PG8_SB(0, 1), b2 + hstep, voffB); PG8_STAGE(PG8_SA(0, 0), a2, voffA);
            PG8_WAIT_V(8); PG8_WAIT_L(0); PG8_BAR; PG8_MMA(1, 0, At, B0); PG8_MMA(1, 1, At, B1); PG8_BAR; PG8_SCHED;
            PG8_LDB(B0, 1, 0); PG8_LDB(B1, 1, 1); PG8_SCHED; PG8_LDA(At, 1, 0); PG8_STAGE(PG8_SA(0, 1), a2 + hstep, voffA);
            PG8_WAIT_V(8); PG8_WAIT_L(0); PG8_BAR; PG8_MMA(0, 0, At, B0); PG8_MMA(0, 1, At, B1); PG8_BAR; PG8_SCHED;
            PG8_LDA(At, 1, 1); PG8_STAGE(PG8_SB(1, 0), b3, voffB); PG8_STAGE(PG8_SB(1, 1), b3 + hstep, voffB); PG8_STAGE(PG8_SA(1, 0), a3, voffA);
            PG8_WAIT_V(8); PG8_WAIT_L(0); PG8_BAR; PG8_MMA(1, 0, At, B0); PG8_MMA(1, 1, At, B1); PG8_BAR; PG8_SCHED;
            } else {
            PG8_LDB(B0, 0, 0); PG8_SCHED; PG8_LDA(At, 0, 0); PG8_STAGE(PG8_SA(1, 1), a1 + hstep, voffA);
            PG8_WAIT_L(8); PG8_BAR; PG8_WAIT_L(0); PG8_MMA(0, 0, At, B0); PG8_BAR; PG8_SCHED;
            PG8_LDB(B1, 0, 1); PG8_STAGE(PG8_SB(0, 0), b2, voffB);
            PG8_BAR; PG8_WAIT_L(0); PG8_MMA(0, 1, At, B1); PG8_BAR;
            PG8_LDA(At, 0, 1); PG8_STAGE(PG8_SA(0, 0), a2, voffA);
            PG8_BAR; PG8_WAIT_L(0); PG8_MMA(1, 0, At, B0); PG8_BAR; PG8_SCHED;
            PG8_STAGE(PG8_SB(0, 1), b2 + hstep, voffB);
            PG8_WAIT_V(6); PG8_BAR; PG8_MMA(1, 1, At, B1); PG8_BAR;
            PG8_LDB(B0, 1, 0); PG8_SCHED; PG8_LDA(At, 1, 0); PG8_STAGE(PG8_SA(0, 1), a2 + hstep, voffA);
            PG8_WAIT_L(8); PG8_BAR; PG8_WAIT_L(0); PG8_MMA(0, 0, At, B0); PG8_BAR; PG8_SCHED;
            PG8_LDB(B1, 1, 1); PG8_STAGE(PG8_SB(1, 0), b3, voffB);
            PG8_BAR; PG8_WAIT_L(0); PG8_MMA(0, 1, At, B1); PG8_BAR;
            PG8_LDA(At, 1, 1); PG8_STAGE(PG8_SA(1, 0), a3, voffA);
            PG8_BAR; PG8_WAIT_L(0); PG8_MMA(1, 0, At, B0); PG8_BAR; PG8_SCHED;
            PG8_STAGE(PG8_SB(1, 1), b3 + hstep, voffB);
            PG8_WAIT_V(6); PG8_BAR; PG8_MMA(1, 1, At, B1); PG8_BAR;
            }
        }
        if constexpr (ALIGN_EPI) { if (wr == 0) PG8_BAR; }
        if constexpr (!Epi::AFTER_DRAIN) { E(acc, cur, wr, wc, fr, fq); S.done(cur); }
        if (!has_next) break;
#pragma unroll
        for (int a = 0; a < 2; ++a)
#pragma unroll
            for (int b = 0; b < 2; ++b)
#pragma unroll
                for (int m = 0; m < 4; ++m)
#pragma unroll
                    for (int n = 0; n < 2; ++n) acc[a][b][m][n] = (f32x4){0.f, 0.f, 0.f, 0.f};
        cur = nxt; cA = nA; cB = nB; ++ui;
        if constexpr (ALIGN_EPI) { if (wr == 1) PG8_BAR; }
    }
    PG8_WAIT_V(0);
    if constexpr (!ALIGN_EPI) { if (wr == 0) PG8_BAR; }
    PG8_BAR;
    if constexpr (Epi::AFTER_DRAIN) { E.fused(acc, cur, wr, wc, fr, fq, lds, wid, lane); S.done(cur); }
#undef PG8_SA
#undef PG8_SB
#undef PG8_STAGE
#undef PG8_LDA
#undef PG8_LDB
#undef PG8_MMA
#undef PG8_WAIT_V
#undef PG8_WAIT_L
#undef PG8_BAR
#undef PG8_SCHED
}
}

using pg8::bf16_t; using pg8::f32x4; using pg8::Unit; using pg8::cvt_pk_bf16;
typedef short bf16x8 __attribute__((ext_vector_type(8)));
typedef _Float16 f16x8 __attribute__((ext_vector_type(8)));
typedef float f32x16 __attribute__((ext_vector_type(16)));
typedef unsigned u32x4 __attribute__((ext_vector_type(4)));
typedef unsigned u32x2 __attribute__((ext_vector_type(2)));
typedef short s16x4 __attribute__((ext_vector_type(4)));
#define LAS __attribute__((address_space(3)))

constexpr int BATCH = 16, SEQ = 4096, DM = 1024, MTOK = BATCH * SEQ;
constexpr int NPROJ = 3072, NREAL = 2888, DFF = 2816, NUP = 5632, MODW = 6144;
constexpr int MHALF = MTOK / 2;
constexpr float EPS = 1e-6f, LOG2E = 1.4426950408889634f, QSCALE = 0.125f * LOG2E;
constexpr size_t MiB = 1u << 20;
constexpr size_t WS_MOD = 0, WS_WIN = 1 * MiB, WS_WOUT = 7 * MiB, WS_WUP = 9 * MiB, WS_WDN = 20 * MiB, WS_H = 26 * MiB;
constexpr size_t WS_AQ = 154 * MiB, WS_AK = 218 * MiB, WS_AV = 282 * MiB, WS_BQ = 346 * MiB, WS_BK = 410 * MiB, WS_BV = 426 * MiB;
constexpr size_t WS_IQ = 442 * MiB, WS_IK = 506 * MiB, WS_IW = 514 * MiB, WS_CAT = 516 * MiB, WS_SC = 644 * MiB;
constexpr size_t WS_U = 154 * MiB, WS_G = 506 * MiB, WS_END = 1024 * MiB;
constexpr int LDS_BYTES = 147456;

struct Params {
    const float *x, *c, *w_ada, *b_ada, *g_attn, *w_in, *qna, *kna, *qnb, *knb, *lam, *subln, *w_out, *g_ffn, *w_up, *conv_w, *conv_b, *w_down, *rel_bias;
    float* out; unsigned char* ws;
};

__device__ __forceinline__ int otid(int wv) { int l; asm volatile("v_mbcnt_lo_u32_b32 %0, -1, 0\n\tv_mbcnt_hi_u32_b32 %0, -1, %0" : "=v"(l)); return wv * 64 + l; }
__device__ __forceinline__ float wave_sum(float v) {
#pragma unroll
    for (int o = 1; o < 64; o <<= 1) v += __shfl_xor(v, o);
    return v;
}
__device__ __forceinline__ float wave_max(float v) {
#pragma unroll
    for (int o = 1; o < 64; o <<= 1) v = fmaxf(v, __shfl_xor(v, o));
    return v;
}
__device__ __forceinline__ unsigned pk_f16(float a, float b) {
    _Float16 x = (_Float16)a, y = (_Float16)b;
    return (unsigned)__builtin_bit_cast(unsigned short, x) | ((unsigned)__builtin_bit_cast(unsigned short, y) << 16);
}
__device__ __forceinline__ int pi32(int m) { const int a = m >> 3, h = (m >> 2) & 1, c = m & 3; return 16 * (a >> 1) + 8 * h + 4 * (a & 1) + c; }
__device__ __forceinline__ int crow(int r, int hi) { return (r & 3) + 8 * (r >> 2) + 4 * hi; }
__device__ __forceinline__ int t5_bucket(int n) {
    if (n < 16) return n;
    return 16 + (n >= 19) + (n >= 21) + (n >= 24) + (n >= 27) + (n >= 31) + (n >= 35) + (n >= 40) + (n >= 46) + (n >= 52) + (n >= 59) + (n >= 67) + (n >= 77) + (n >= 87) + (n >= 99) + (n >= 113);
}
__device__ __forceinline__ s16x4 vtr(const LAS unsigned char* p) {
    return __builtin_bit_cast(s16x4, __builtin_amdgcn_ds_read_tr16_b64_v4i16((LAS s16x4*)p));
}

__device__ __forceinline__ int perm_inv(int n) { return (n & ~255) + 128 * ((n >> 5) & 1) + 32 * ((n >> 6) & 3) + (n & 31); }
__device__ __forceinline__ int perm_up(int n) { const int v = n >= DFF, m = n - (v ? DFF : 0); return (m >> 7) * 256 + 128 * v + (m & 127); }
__device__ __forceinline__ void transpose_tile(const float* W, int K, int N, int nreal, bf16_t* Bt, int k0, int n0, int permute, LAS float* scr, int tid) {
#pragma unroll
    for (int i = 0; i < 8; ++i) { const int kk = (tid >> 6) + 8 * i, nn = tid & 63, n = n0 + nn; scr[kk * 65 + nn] = (n < nreal) ? W[(size_t)(k0 + kk) * N + n] : 0.f; }
    __syncthreads();
    { const int nn = tid >> 3, c = tid & 7, n = n0 + nn, drow = permute == 1 ? perm_inv(n) : (permute == 2 ? perm_up(n) : n); const LAS float* s = scr + (8 * c) * 65 + nn;
      u32x4 o; o.x = cvt_pk_bf16(s[0], s[65]); o.y = cvt_pk_bf16(s[130], s[195]); o.z = cvt_pk_bf16(s[260], s[325]); o.w = cvt_pk_bf16(s[390], s[455]);
      *(u32x4*)(Bt + (size_t)drow * K + k0 + 8 * c) = o; }
    __syncthreads();
}
__device__ __forceinline__ void phase0(const Params& p, LAS unsigned char* lds, int wv) {
    const int tid = otid(wv);
    LAS float* sc = (LAS float*)lds;
    LAS float* scr = (LAS float*)(lds + 65536);
    LAS float* red = (LAS float*)(lds + 65536 + 16640);
    constexpr int I_IN = 16 * 48, I_OUT = 16 * 16, I_UP = 16 * 88, I_DN = 44 * 16, NIT = I_IN + I_OUT + I_UP + I_DN;
    for (int it = blockIdx.x; it < NIT; it += gridDim.x) {
        int r = it;
        if (r < I_IN) { transpose_tile(p.w_in, 1024, NREAL, NREAL, (bf16_t*)(p.ws + WS_WIN), 64 * (r / 48), 64 * (r % 48), 1, scr, tid); continue; } r -= I_IN;
        if (r < I_OUT) { transpose_tile(p.w_out, 1024, 1024, 1024, (bf16_t*)(p.ws + WS_WOUT), 64 * (r / 16), 64 * (r % 16), 0, scr, tid); continue; } r -= I_OUT;
        if (r < I_UP) { transpose_tile(p.w_up, 1024, NUP, NUP, (bf16_t*)(p.ws + WS_WUP), 64 * (r / 88), 64 * (r % 88), 2, scr, tid); continue; } r -= I_UP;
        transpose_tile(p.w_down, DFF, 1024, 1024, (bf16_t*)(p.ws + WS_WDN), 64 * (r / 16), 64 * (r % 16), 0, scr, tid);
    }
    if (blockIdx.x < 192) {
        for (int i = tid; i < 16 * 1024; i += 512) { const float v = p.c[i]; sc[i] = v / (1.f + __expf(-v)); }
        __syncthreads();
        float* mod = (float*)(p.ws + WS_MOD);
        for (int g = blockIdx.x; g < 192; g += gridDim.x) {
            const int kq = tid >> 5, col = tid & 31;
            float acc[16];
#pragma unroll
            for (int b = 0; b < 16; ++b) acc[b] = 0.f;
#pragma unroll 1
            for (int kb = 0; kb < 64; kb += 16) {
                float wv16[16];
#pragma unroll
                for (int i = 0; i < 16; ++i) wv16[i] = p.w_ada[(size_t)(kq * 64 + kb + i) * MODW + g * 32 + col];
#pragma unroll
                for (int i = 0; i < 16; ++i) { const int k = kq * 64 + kb + i;
#pragma unroll
                    for (int b = 0; b < 16; ++b) acc[b] += sc[b * 1024 + k] * wv16[i]; } }
#pragma unroll
            for (int b = 0; b < 16; ++b) red[(kq * 16 + b) * 32 + col] = acc[b];
            __syncthreads();
            { const int b = tid >> 5; float s = p.b_ada[g * 32 + col];
#pragma unroll
              for (int q = 0; q < 16; ++q) s += red[(q * 16 + b) * 32 + col];
              mod[b * MODW + g * 32 + col] = s; }
            __syncthreads();
        }
    }
}

__device__ __forceinline__ void norm_phase(const float* X, const float* gvec, const float* mod, int sc_off, int sh_off, bf16_t* H, int wv) {
    const int tid = otid(wv); const int lane = tid & 63, gw = blockIdx.x * 8 + (tid >> 6), NGW = gridDim.x * 8;
    for (int row = gw; row < MTOK; row += 2 * NGW) {
        const int row2 = row + NGW;
        const bool has2 = row2 < MTOK;
        const f32x4* xr = (const f32x4*)(X + (size_t)row * DM) + lane;
        const f32x4* xr2 = (const f32x4*)(X + (size_t)(has2 ? row2 : row) * DM) + lane;
        f32x4 v[4], w[4]; float ss = 0.f, ss2 = 0.f;
#pragma unroll
        for (int j = 0; j < 4; ++j) { v[j] = xr[64 * j]; w[j] = xr2[64 * j]; }
#pragma unroll
        for (int j = 0; j < 4; ++j) { ss += (v[j].x * v[j].x + v[j].y * v[j].y) + (v[j].z * v[j].z + v[j].w * v[j].w); ss2 += (w[j].x * w[j].x + w[j].y * w[j].y) + (w[j].z * w[j].z + w[j].w * w[j].w); }
        const float rs = 1.0f / sqrtf(wave_sum(ss) * (1.f / DM) + EPS), rs2 = 1.0f / sqrtf(wave_sum(ss2) * (1.f / DM) + EPS);
        const int b = row >> 12, b2 = (has2 ? row2 : row) >> 12;
#pragma unroll
        for (int j = 0; j < 4; ++j) { const int col = (lane + 64 * j) * 4;
            const f32x4 g4 = *(const f32x4*)(gvec + col);
            { const f32x4 s4 = *(const f32x4*)(mod + b * MODW + sc_off + col), h4 = *(const f32x4*)(mod + b * MODW + sh_off + col);
              const f32x4 y = (v[j] * rs) * g4 * (s4 + 1.0f) + h4; u32x2 o; o.x = cvt_pk_bf16(y.x, y.y); o.y = cvt_pk_bf16(y.z, y.w);
              *(u32x2*)(H + (size_t)row * DM + col) = o; }
            if (has2) { const f32x4 s4 = *(const f32x4*)(mod + b2 * MODW + sc_off + col), h4 = *(const f32x4*)(mod + b2 * MODW + sh_off + col);
              const f32x4 y = (w[j] * rs2) * g4 * (s4 + 1.0f) + h4; u32x2 o; o.x = cvt_pk_bf16(y.x, y.y); o.y = cvt_pk_bf16(y.z, y.w);
              *(u32x2*)(H + (size_t)row2 * DM + col) = o; }
        }
    }
}

struct EpiProj {
    static constexpr bool PERM = true, AFTER_DRAIN = false;
    unsigned char* ws; const float *qa, *ka, *qb, *kb;
    __device__ __forceinline__ void operator()(const f32x4 (&acc)[2][2][4][2], const Unit& u, int wr, int wc, int fr, int fq) const {
        const int G = u.pn * 4 + wc;
        if (G >= 46) return;
        int kind = 0, ld = 512, coloff = 0; unsigned char* base = ws; const float* gn = nullptr; float scale = 1.f;
        if (G < 8) { base = ws + WS_AQ; coloff = 64 * G; gn = qa; scale = QSCALE; }
        else if (G < 16) { base = ws + WS_AK; coloff = 64 * (G - 8); gn = ka; }
        else if (G < 24) { base = ws + WS_AV; coloff = 64 * (G - 16); }
        else if (G < 32) { base = ws + WS_BQ; coloff = 64 * (G - 24); gn = qb; scale = QSCALE; }
        else if (G < 34) { base = ws + WS_BK; ld = 128; coloff = 64 * (G - 32); gn = kb; }
        else if (G < 36) { base = ws + WS_BV; ld = 128; coloff = 64 * (G - 34); }
        else if (G < 44) { base = ws + WS_IQ; kind = 1; coloff = 64 * (G - 36); }
        else if (G == 44) { base = ws + WS_IK; kind = 1; ld = 64; }
        else { base = ws + WS_IW; kind = 2; }
        const int row0 = u.pm * 256 + wr * 64 + fr;
        f32x4 gv[2][2];
#pragma unroll
        for (int bj = 0; bj < 2; ++bj)
#pragma unroll
            for (int n = 0; n < 2; ++n) { gv[bj][n] = gn ? *(const f32x4*)(gn + 32 * bj + 8 * fq + 4 * n) : (f32x4){1.f, 1.f, 1.f, 1.f}; gv[bj][n] = gv[bj][n] * scale; }
#pragma unroll
        for (int ai = 0; ai < 2; ++ai)
#pragma unroll
            for (int m = 0; m < 4; ++m) {
                const size_t row = (size_t)(row0 + 128 * ai + 16 * m);
                float rs = 1.f;
                if (gn) { float ss = 0.f;
#pragma unroll
                    for (int bj = 0; bj < 2; ++bj)
#pragma unroll
                        for (int n = 0; n < 2; ++n) { const f32x4 v = acc[ai][bj][m][n]; ss += (v.x * v.x + v.y * v.y) + (v.z * v.z + v.w * v.w); }
                    ss += __shfl_xor(ss, 16); ss += __shfl_xor(ss, 32);
                    rs = __builtin_amdgcn_rsqf(ss * (1.f / 64.f) + EPS); }
                if (kind == 2) { if (fq == 0) { *(f32x4*)((float*)base + row * 8) = acc[ai][0][m][0] * 0.04419417382415922f; *(f32x4*)((float*)base + row * 8 + 4) = acc[ai][0][m][1] * 0.04419417382415922f; } }
                else {
#pragma unroll
                    for (int bj = 0; bj < 2; ++bj) { const f32x4 v0 = acc[ai][bj][m][0] * rs * gv[bj][0], v1 = acc[ai][bj][m][1] * rs * gv[bj][1]; u32x4 w;
                        if (kind == 0) { w.x = cvt_pk_bf16(v0.x, v0.y); w.y = cvt_pk_bf16(v0.z, v0.w); w.z = cvt_pk_bf16(v1.x, v1.y); w.w = cvt_pk_bf16(v1.z, v1.w); }
                        else { w.x = pk_f16(v0.x, v0.y); w.y = pk_f16(v0.z, v0.w); w.z = pk_f16(v1.x, v1.y); w.w = pk_f16(v1.z, v1.w); }
                        *(u32x4*)((bf16_t*)base + row * ld + coloff + 32 * bj + 8 * fq) = w; }
                }
            }
    }
};
struct EpiOut {
    static constexpr bool PERM = true, AFTER_DRAIN = false;
    const float* x; const float* gate; float* out;
    __device__ __forceinline__ void operator()(const f32x4 (&acc)[2][2][4][2], const Unit& u, int wr, int wc, int fr, int fq) const {
        const int row0 = u.pm * 256 + wr * 64 + fr, col0 = u.pn * 256 + wc * 32 + 8 * fq;
#pragma unroll
        for (int ai = 0; ai < 2; ++ai)
#pragma unroll
            for (int m = 0; m < 4; ++m) { const int row = row0 + 128 * ai + 16 * m, b = row >> 12;
#pragma unroll
                for (int bj = 0; bj < 2; ++bj)
#pragma unroll
                    for (int n = 0; n < 2; ++n) { const int col = col0 + 128 * bj + 4 * n; const size_t off = (size_t)row * DM + col;
                        const f32x4 g = *(const f32x4*)(gate + b * MODW + col), xv = *(const f32x4*)(x + off);
                        *(f32x4*)(out + off) = xv + g * acc[ai][bj][m][n]; } }
    }
};
struct EpiUp {
    static constexpr bool PERM = false, AFTER_DRAIN = false;
    bf16_t* U;
    __device__ __forceinline__ void operator()(const f32x4 (&acc)[2][2][4][2], const Unit& u, int wr, int wc, int fr, int fq) const {
        const int row0 = u.pm * 256 + wr * 64 + fr, col0 = u.pn * 256 + wc * 32 + 4 * fq;
#pragma unroll
        for (int ai = 0; ai < 2; ++ai)
#pragma unroll
            for (int m = 0; m < 4; ++m) { const size_t row = (size_t)(row0 + 128 * ai + 16 * m);
#pragma unroll
                for (int bj = 0; bj < 2; ++bj)
#pragma unroll
                    for (int n = 0; n < 2; ++n) { const f32x4 v = acc[ai][bj][m][n]; u32x2 w; w.x = cvt_pk_bf16(v.x, v.y); w.y = cvt_pk_bf16(v.z, v.w);
                        *(u32x2*)(U + row * NUP + col0 + 128 * bj + 16 * n) = w; } }
    }
};
constexpr int HALO_OFF = 131072;
__device__ __forceinline__ f32x4 dpp_ror(const f32x4 v, const int which) {
    f32x4 r;
    if (which == 1) { r.x = __int_as_float(__builtin_amdgcn_update_dpp(0, __float_as_int(v.x), 0x121, 0xf, 0xf, false)); r.y = __int_as_float(__builtin_amdgcn_update_dpp(0, __float_as_int(v.y), 0x121, 0xf, 0xf, false));
                      r.z = __int_as_float(__builtin_amdgcn_update_dpp(0, __float_as_int(v.z), 0x121, 0xf, 0xf, false)); r.w = __int_as_float(__builtin_amdgcn_update_dpp(0, __float_as_int(v.w), 0x121, 0xf, 0xf, false)); }
    else { r.x = __int_as_float(__builtin_amdgcn_update_dpp(0, __float_as_int(v.x), 0x122, 0xf, 0xf, false)); r.y = __int_as_float(__builtin_amdgcn_update_dpp(0, __float_as_int(v.y), 0x122, 0xf, 0xf, false));
           r.z = __int_as_float(__builtin_amdgcn_update_dpp(0, __float_as_int(v.z), 0x122, 0xf, 0xf, false)); r.w = __int_as_float(__builtin_amdgcn_update_dpp(0, __float_as_int(v.w), 0x122, 0xf, 0xf, false)); }
    return r;
}
struct EpiUpConv {
    static constexpr bool PERM = true, AFTER_DRAIN = false;
    bf16_t* Gout; const float* cw; const float* cb; LAS float* halo;
    __device__ __forceinline__ void operator()(const f32x4 (&acc)[2][2][4][2], const Unit& u, int wr, int wc, int fr_, int fq_) const {
        int fr = fr_, fq = fq_; asm volatile("" : "+v"(fr), "+v"(fq));
        if (fr >= 14) {
#pragma unroll
            for (int ai = 0; ai < 2; ++ai)
#pragma unroll
                for (int bj = 0; bj < 2; ++bj)
#pragma unroll
                    for (int n = 0; n < 2; ++n) *(LAS f32x4*)(halo + ((2 * ai + wr) * 2 + (fr - 14)) * 256 + 128 * bj + 32 * wc + 8 * fq + 4 * n) = acc[ai][bj][3][n];
        }
        asm volatile("s_waitcnt lgkmcnt(0)" ::: "memory"); __builtin_amdgcn_s_barrier(); asm volatile("" ::: "memory");
        const int R0 = u.pm * 254 - 2;
#pragma unroll
        for (int n = 0; n < 2; ++n) {
            const int cr = u.pn * 128 + wc * 32 + 8 * fq + 4 * n;
            const f32x4 g0 = *(const f32x4*)(cw + cr), g1 = *(const f32x4*)(cw + NUP + cr), g2 = *(const f32x4*)(cw + 2 * NUP + cr), gb = *(const f32x4*)(cb + cr);
            const f32x4 v0 = *(const f32x4*)(cw + DFF + cr), v1 = *(const f32x4*)(cw + NUP + DFF + cr), v2 = *(const f32x4*)(cw + 2 * NUP + DFF + cr), vb = *(const f32x4*)(cb + DFF + cr);
#pragma unroll
            for (int ai = 0; ai < 2; ++ai) {
                const int seg = 2 * ai + wr;
                f32x4 pr1[2], pr2[2];
#pragma unroll
                for (int bj = 0; bj < 2; ++bj) {
                    pr1[bj] = (f32x4){0.f, 0.f, 0.f, 0.f}; pr2[bj] = (f32x4){0.f, 0.f, 0.f, 0.f};
                    if (seg > 0) { const LAS float* hp = halo + ((seg - 1) * 2) * 256 + 128 * bj + 32 * wc + 8 * fq + 4 * n;
                        pr1[bj] = *(const LAS f32x4*)(hp + 256); pr2[bj] = *(const LAS f32x4*)(hp + ((fr & 1) ? 256 : 0)); }
                }
#pragma unroll
                for (int m = 0; m < 4; ++m) {
                    const int r = 128 * ai + 64 * wr + 16 * m + fr, R = R0 + r, t = R & (SEQ - 1);
                    f32x4 y[2];
#pragma unroll
                    for (int bj = 0; bj < 2; ++bj) {
                        const f32x4 X = acc[ai][bj][m][n]; const f32x4 r1 = dpp_ror(X, 1), r2 = dpp_ror(X, 2);
                        f32x4 p1 = (fr == 0) ? pr1[bj] : r1, p2 = (fr < 2) ? pr2[bj] : r2;
                        pr1[bj] = r1; pr2[bj] = r2;
                        if (t == 0) p1 = (f32x4){0.f, 0.f, 0.f, 0.f};
                        if (t <= 1) p2 = (f32x4){0.f, 0.f, 0.f, 0.f};
                        y[bj] = bj == 0 ? (gb + g0 * p2 + g1 * p1 + g2 * X) : (vb + v0 * p2 + v1 * p1 + v2 * X);
                    }
                    f32x4 o;
                    o.x = y[0].x * __builtin_amdgcn_rcpf(1.f + __builtin_amdgcn_exp2f(-LOG2E * y[0].x)) * y[1].x; o.y = y[0].y * __builtin_amdgcn_rcpf(1.f + __builtin_amdgcn_exp2f(-LOG2E * y[0].y)) * y[1].y;
                    o.z = y[0].z * __builtin_amdgcn_rcpf(1.f + __builtin_amdgcn_exp2f(-LOG2E * y[0].z)) * y[1].z; o.w = y[0].w * __builtin_amdgcn_rcpf(1.f + __builtin_amdgcn_exp2f(-LOG2E * y[0].w)) * y[1].w;
                    if (r >= 2 && R < MTOK) { u32x2 w; w.x = cvt_pk_bf16(o.x, o.y); w.y = cvt_pk_bf16(o.z, o.w); *(u32x2*)(Gout + (size_t)R * DFF + cr) = w; }
                }
            }
        }
    }
};
struct EpiDown {
    static constexpr bool PERM = true, AFTER_DRAIN = false;
    const float* gate; float* out; int rowoff;
    __device__ __forceinline__ void operator()(const f32x4 (&acc)[2][2][4][2], const Unit& u, int wr, int wc, int fr, int fq) const {
        const int row0 = rowoff + u.pm * 256 + wr * 64 + fr, col0 = u.pn * 256 + wc * 32 + 8 * fq;
#pragma unroll
        for (int ai = 0; ai < 2; ++ai)
#pragma unroll
            for (int m = 0; m < 4; ++m) { const int row = row0 + 128 * ai + 16 * m, b = row >> 12;
#pragma unroll
                for (int bj = 0; bj < 2; ++bj)
#pragma unroll
                    for (int n = 0; n < 2; ++n) { const int col = col0 + 128 * bj + 4 * n; const size_t off = (size_t)row * DM + col;
                        const f32x4 g = *(const f32x4*)(gate + b * MODW + col), xv = *(const f32x4*)(out + off);
                        *(f32x4*)(out + off) = xv + g * acc[ai][bj][m][n]; } }
    }
};

__device__ __forceinline__ void unpack8(const u32x4 w, float* f) {
    f[0] = __uint_as_float(w.x << 16); f[1] = __uint_as_float(w.x & 0xffff0000u); f[2] = __uint_as_float(w.y << 16); f[3] = __uint_as_float(w.y & 0xffff0000u);
    f[4] = __uint_as_float(w.z << 16); f[5] = __uint_as_float(w.z & 0xffff0000u); f[6] = __uint_as_float(w.w << 16); f[7] = __uint_as_float(w.w & 0xffff0000u);
}
__device__ __forceinline__ void conv_phase(const Params& p, const bf16_t* U, bf16_t* Gb, int wv) {
    constexpr int NCH = DFF / 8, NTASK = (MHALF / 32) * NCH;
    const int tid = otid(wv);
    for (int task = blockIdx.x * 512 + tid; task < NTASK; task += gridDim.x * 512) {
        const int ch = task % NCH, strip = task / NCH, r0 = strip * 32, col = ch * 8;
        float wg[3][8], wv[3][8], bg[8], bv[8];
#pragma unroll
        for (int j = 0; j < 3; ++j)
#pragma unroll
            for (int e = 0; e < 8; ++e) { wg[j][e] = p.conv_w[j * NUP + col + e]; wv[j][e] = p.conv_w[j * NUP + DFF + col + e]; }
#pragma unroll
        for (int e = 0; e < 8; ++e) { bg[e] = p.conv_b[col + e]; bv[e] = p.conv_b[DFF + col + e]; }
        float g2[8], g1[8], v2[8], v1[8];
        if ((r0 & (SEQ - 1)) == 0) {
#pragma unroll
            for (int e = 0; e < 8; ++e) { g2[e] = 0.f; g1[e] = 0.f; v2[e] = 0.f; v1[e] = 0.f; }
        } else {
            unpack8(*(const u32x4*)(U + (size_t)(r0 - 2) * NUP + col), g2); unpack8(*(const u32x4*)(U + (size_t)(r0 - 1) * NUP + col), g1);
            unpack8(*(const u32x4*)(U + (size_t)(r0 - 2) * NUP + DFF + col), v2); unpack8(*(const u32x4*)(U + (size_t)(r0 - 1) * NUP + DFF + col), v1);
        }
        for (int r = 0; r < 32; ++r) {
            float g0[8], v0[8], o[8];
            unpack8(*(const u32x4*)(U + (size_t)(r0 + r) * NUP + col), g0); unpack8(*(const u32x4*)(U + (size_t)(r0 + r) * NUP + DFF + col), v0);
#pragma unroll
            for (int e = 0; e < 8; ++e) {
                const float yg = bg[e] + wg[0][e] * g2[e] + wg[1][e] * g1[e] + wg[2][e] * g0[e];
                const float yv = bv[e] + wv[0][e] * v2[e] + wv[1][e] * v1[e] + wv[2][e] * v0[e];
                o[e] = yg / (1.f + __expf(-yg)) * yv;
                g2[e] = g1[e]; g1[e] = g0[e]; v2[e] = v1[e]; v1[e] = v0[e]; }
            u32x4 w; w.x = cvt_pk_bf16(o[0], o[1]); w.y = cvt_pk_bf16(o[2], o[3]); w.z = cvt_pk_bf16(o[4], o[5]); w.w = cvt_pk_bf16(o[6], o[7]);
            *(u32x4*)(Gb + (size_t)(r0 + r) * DFF + col) = w;
        }
    }
}
#ifndef REPM
#define REPM 1
#endif
#ifndef REPK
#define REPK 1
#endif
#ifndef REPT
#define REPT 1
#endif
#ifndef REPA
#define REPA 1
#endif
#ifndef REPB
#define REPB 1
#endif
#ifndef PB
#define PB 7
#endif

constexpr int A_KROW = 272, A_VROW = 320, A_KBUF = 64 * A_KROW, A_VBUF = 64 * A_VROW, A_STG = A_KBUF + A_VBUF;
constexpr int A_TOFF = 2 * A_STG, A_LOFF = A_TOFF + 1280;
__device__ __forceinline__ void attnA_phase(const Params& p, LAS unsigned char* lds, int wv) {
    const int tid = otid(wv), lane = tid & 63, wid = __builtin_amdgcn_readfirstlane(tid >> 6), r32 = lane & 31, hi = lane >> 5;
    const int c = wid >> 2, qg = wid & 3;
    float lam; { float a = p.lam[lane] * p.lam[64 + lane], b2 = p.lam[128 + lane] * p.lam[192 + lane]; a = wave_sum(a); b2 = wave_sum(b2); lam = expf(a) - expf(b2) + 0.2f; }
    const float Mq = wave_max(fabsf(p.qna[lane])), Mk = wave_max(fabsf(p.kna[lane]));
    const unsigned char* AQ = p.ws + WS_AQ; const unsigned char* AK = p.ws + WS_AK; const unsigned char* AV = p.ws + WS_AV;
    bf16_t* CAT = (bf16_t*)(p.ws + WS_CAT);
    LAS float* T = (LAS float*)(lds + A_TOFF);
    LAS float* linv = (LAS float*)(lds + A_LOFF) + wid * 32;
    const int vblkA = (gridDim.x == 256) ? (int)((blockIdx.x & 7) * 32 + (blockIdx.x >> 3)) : (int)blockIdx.x;
    for (int ui = vblkA; ui < 2048 * REPA; ui += gridDim.x) {
        const int v = ui & 255, rnd = (ui >> 8) & 7, bh = v >> 2, pp = (v & 3) + 4 * (rnd >> 1), qb = (rnd & 1) ? 31 - pp : pp;
        const int b = bh >> 2, h = bh & 3, q0 = qb * 128, NT = 2 * qb + 2;
        const size_t tokbase = (size_t)b * SEQ;
        if (tid < 320) { const int d = 223 - tid;
            T[tid] = d < 0 ? -1e30f : (p.rel_bias[t5_bucket(min(d, 127)) * 12 + h] - p.rel_bias[31 * 12 + h]) * LOG2E; }
        bf16x8 qf[4];
        { const unsigned char* Qp = AQ + (tokbase + q0 + 32 * qg + r32) * 1024 + h * 256 + c * 128 + hi * 16;
#pragma unroll
          for (int ds = 0; ds < 4; ++ds) qf[ds] = *(const bf16x8*)(Qp + 32 * ds); }
        const int qpos = q0 + 32 * qg + r32, qw0 = q0 + 32 * qg;
        f32x16 O[4];
#pragma unroll
        for (int e = 0; e < 4; ++e)
#pragma unroll
            for (int r = 0; r < 16; ++r) O[e][r] = 0.f;
        float l = 0.f;
        u32x4 kreg[2], vreg[2];
        const int srow = tid >> 4, sch = tid & 15;
#define A_LOAD(t) do { _Pragma("unroll") for (int i = 0; i < 2; ++i) { const size_t g = (tokbase + 64 * (t) + srow + 32 * i) * 1024 + h * 256 + sch * 16; \
        kreg[i] = *(const u32x4*)(AK + g); vreg[i] = *(const u32x4*)(AV + g); } } while (0)
#define A_WRITE(st) do { _Pragma("unroll") for (int i = 0; i < 2; ++i) { *(LAS u32x4*)(lds + (st) * A_STG + (srow + 32 * i) * A_KROW + sch * 16) = kreg[i]; \
        *(LAS u32x4*)(lds + (st) * A_STG + A_KBUF + (srow + 32 * i) * A_VROW + sch * 16) = vreg[i]; } } while (0)
        A_LOAD(0); A_WRITE(0);
        __syncthreads();
        for (int t = 0; t < NT; ++t) {
            if (t + 1 < NT) A_LOAD(t + 1);
            const int k0 = 64 * t;
            if (k0 <= qw0 + 31) {
                const bool near = (k0 + 63 + 113 > qw0);
                const LAS unsigned char* Kb = lds + (t & 1) * A_STG; const LAS unsigned char* Vb = Kb + A_KBUF;
                f32x16 s0, s1;
#pragma unroll
                for (int r = 0; r < 16; ++r) { s0[r] = 0.f; s1[r] = 0.f; }
                {
                    const LAS unsigned char* kp0 = Kb + (pi32(r32)) * A_KROW + c * 128 + hi * 16;
                    const LAS unsigned char* kp1 = kp0 + 32 * A_KROW;
#pragma unroll
                    for (int ds = 0; ds < 4; ++ds) { const bf16x8 ka = *(const LAS bf16x8*)(kp0 + 32 * ds), kb = *(const LAS bf16x8*)(kp1 + 32 * ds);
                        s0 = __builtin_amdgcn_mfma_f32_32x32x16_bf16(ka, qf[ds], s0, 0, 0, 0); s1 = __builtin_amdgcn_mfma_f32_32x32x16_bf16(kb, qf[ds], s1, 0, 0, 0); }
                }
                __builtin_amdgcn_sched_barrier(0);
                float sacc = 0.f;
#define A_SOFTMAX(S, HF) do { \
                    if (!near) { _Pragma("unroll") for (int r = 0; r < 16; ++r) S[r] = __builtin_amdgcn_exp2f(S[r]); } \
                    else { int ib = 223 - (qpos - k0 - 8 * hi - 32 * (HF)); asm volatile("" : "+v"(ib)); const LAS float* tp = T + ib; \
                        _Pragma("unroll") for (int r = 0; r < 16; ++r) S[r] = __builtin_amdgcn_exp2f(S[r] + tp[16 * (r >> 3) + (r & 7)]); } \
                    _Pragma("unroll") for (int r = 0; r < 16; ++r) sacc += S[r]; } while (0)
#define A_PV(S, HF) do { \
                    _Pragma("unroll") for (int jj = 0; jj < 2; ++jj) { \
                        const int j = 2 * (HF) + jj, rb = 8 * jj; \
                        u32x4 pw; pw.x = cvt_pk_bf16(S[rb], S[rb + 1]); pw.y = cvt_pk_bf16(S[rb + 2], S[rb + 3]); pw.z = cvt_pk_bf16(S[rb + 4], S[rb + 5]); pw.w = cvt_pk_bf16(S[rb + 6], S[rb + 7]); \
                        const bf16x8 pa = __builtin_bit_cast(bf16x8, pw); \
                        const LAS unsigned char* vp = Vb + (16 * j + 8 * hi + ((lane & 15) >> 2)) * A_VROW + (16 * ((lane >> 4) & 1) + 4 * (lane & 3)) * 2; \
                        _Pragma("unroll") for (int eb = 0; eb < 4; ++eb) { \
                            const s16x4 lo = vtr(vp + eb * 64), hh = vtr(vp + 4 * A_VROW + eb * 64); \
                            const bf16x8 vf = (bf16x8){lo[0], lo[1], lo[2], lo[3], hh[0], hh[1], hh[2], hh[3]}; \
                            O[eb] = __builtin_amdgcn_mfma_f32_32x32x16_bf16(pa, vf, O[eb], 0, 0, 0); } } } while (0)
                A_SOFTMAX(s0, 0);
                __builtin_amdgcn_sched_barrier(0);
                A_PV(s0, 0);
                A_SOFTMAX(s1, 1);
                __builtin_amdgcn_sched_barrier(0);
                A_PV(s1, 1);
#undef A_SOFTMAX
#undef A_PV
                l += sacc;
            }
            if (t + 1 < NT) A_WRITE((t + 1) & 1);
            __syncthreads();
        }
#undef A_LOAD
#undef A_WRITE
        l += __shfl_xor(l, 32);
        if (hi == 0) linv[r32] = (c == 1 ? lam : 1.f) / l;
        LAS float* comb = (LAS float*)lds + qg * (32 * 128);
        float f[16];
#pragma unroll
        for (int r = 0; r < 16; ++r) f[r] = linv[crow(r, hi)];
#pragma unroll
        for (int eb = 0; eb < 4; ++eb)
#pragma unroll
            for (int r = 0; r < 16; ++r) O[eb][r] *= f[r];
        if (c == 1) {
#pragma unroll
            for (int eb = 0; eb < 4; ++eb)
#pragma unroll
                for (int r = 0; r < 16; ++r) comb[crow(r, hi) * 128 + 32 * eb + r32] = O[eb][r];
        }
        __syncthreads();
        if (c == 0) {
            float gl[4];
#pragma unroll
            for (int eb = 0; eb < 4; ++eb) gl[eb] = p.subln[32 * eb + r32] * 0.8f;
#pragma unroll
            for (int r = 0; r < 16; ++r) {
                const int qr = crow(r, hi); float ss = 0.f;
#pragma unroll
                for (int eb = 0; eb < 4; ++eb) { O[eb][r] -= comb[qr * 128 + 32 * eb + r32]; ss += O[eb][r] * O[eb][r]; }
                ss += __shfl_xor(ss, 1); ss += __shfl_xor(ss, 2); ss += __shfl_xor(ss, 4); ss += __shfl_xor(ss, 8); ss += __shfl_xor(ss, 16);
                const float rs = 1.0f / sqrtf(ss * (1.f / 128.f) + EPS);
                bf16_t* op = CAT + (tokbase + q0 + 32 * qg + qr) * 1024 + h * 128 + r32;
#pragma unroll
                for (int eb = 0; eb < 4; ++eb) op[32 * eb] = (bf16_t)(cvt_pk_bf16(O[eb][r] * rs * gl[eb], 0.f) & 0xffffu);
            }
        }
        __syncthreads();
    }
}

#ifndef SKIP
#define SKIP 0
#endif
constexpr int B_QROW = 1040;
constexpr int B_HIST = 66560, B_HROW = 257;
constexpr int B_TOFF = B_HIST + 64 * B_HROW * 4;
constexpr int B_DT = 75776;
constexpr int B_INFO = B_TOFF + 4096;
constexpr int B_LINV = B_INFO + 1024;
constexpr int B_MASK = 98304, B_MROW = 130;
__device__ __forceinline__ unsigned ord_key(float f) { const unsigned u = __float_as_uint(f); return u ^ ((u >> 31) ? 0xffffffffu : 0x80000000u); }
__device__ __forceinline__ void phaseB(const Params& p, LAS unsigned char* lds, int wv) {
    const _Float16* IQ = (const _Float16*)(p.ws + WS_IQ); const _Float16* IK = (const _Float16*)(p.ws + WS_IK); const float* IW = (const float*)(p.ws + WS_IW);
    const unsigned char* BQ = p.ws + WS_BQ; const unsigned char* BK = p.ws + WS_BK; const unsigned char* BV = p.ws + WS_BV;
    bf16_t* CAT = (bf16_t*)(p.ws + WS_CAT);
    float* SC = (float*)(p.ws + WS_SC + (size_t)blockIdx.x * MiB);
    LAS float* Tb = (LAS float*)(lds + B_DT);
    LAS unsigned* hist = (LAS unsigned*)(lds + B_HIST);
    LAS unsigned* pfx = (LAS unsigned*)(lds + B_INFO); LAS int* needv = (LAS int*)(lds + B_INFO + 256); LAS unsigned* ceqv = (LAS unsigned*)(lds + B_INFO + 512); LAS int* cutv = (LAS int*)(lds + B_INFO + 768);
    const int vblkB = (gridDim.x == 256) ? (int)((blockIdx.x & 7) * 32 + (blockIdx.x >> 3)) : (int)blockIdx.x;
    for (int ui = vblkB; ui < 1024 * REPB; ui += gridDim.x) {
        const int v = ui & 255, rnd = (ui >> 8) & 3, b = v >> 4, pp = (v & 15) + 16 * (rnd >> 1), qb = (rnd & 1) ? 63 - pp : pp;
        const int q0 = 64 * qb, NT = qb + 1;
        const size_t tokbase = (size_t)b * SEQ;
        {
        const int tid = otid(wv);
        const int lane = tid & 63, wid = __builtin_amdgcn_readfirstlane(tid >> 6), r32 = lane & 31, hi = lane >> 5; (void)r32; (void)hi; (void)wid;
#pragma unroll
        for (int i = 0; i < 8; ++i) { const int id = tid + 512 * i, row = id >> 6, ch = id & 63;
            *(LAS u32x4*)(lds + row * B_QROW + ch * 16) = *(const u32x4*)((const unsigned char*)IQ + (tokbase + q0 + row) * 1024 + ch * 16); }
        for (int i = tid; i < 64 * B_HROW; i += 512) hist[i] = 0u;
        if (tid < 64) { const int n = q0 + tid + 1; pfx[tid] = 0u; needv[tid] = (n > 256) ? 256 : -1; ceqv[tid] = 0u; cutv[tid] = 4096; }
        __syncthreads();
#if !(SKIP & 1)
        {
            const int qg = wid & 1, ks = wid >> 1;
            const float* wp = IW + (tokbase + q0 + 32 * qg + r32) * 8;
            const LAS unsigned char* qp = lds + (32 * qg + r32) * B_QROW + hi * 16;
            LAS unsigned* hrow = hist + (32 * qg + r32) * B_HROW;
            const int tq = q0 + 32 * qg + r32;
#pragma unroll 1
            for (int rep1 = 0; rep1 < REPK; ++rep1)
#pragma unroll 1
            for (int kt = ks; kt < NT; kt += 4) {
                const int k0 = 64 * kt;
                f16x8 kf[2][4];
#pragma unroll
                for (int hf = 0; hf < 2; ++hf)
#pragma unroll
                    for (int ds = 0; ds < 4; ++ds) kf[hf][ds] = *(const f16x8*)(IK + (tokbase + k0 + 32 * hf + pi32(r32)) * 64 + 16 * ds + 8 * hi);
                f32x16 acc0, acc1;
#pragma unroll
                for (int r = 0; r < 16; ++r) { acc0[r] = 0.f; acc1[r] = 0.f; }
#pragma unroll 2
                for (int hh = 0; hh < 8; ++hh) {
                    const float wh = wp[hh];
                    f32x16 s0, s1;
#pragma unroll
                    for (int r = 0; r < 16; ++r) { s0[r] = 0.f; s1[r] = 0.f; }
#pragma unroll
                    for (int ds = 0; ds < 4; ++ds) { const f16x8 qfr = *(const LAS f16x8*)(qp + hh * 128 + ds * 32);
                        s0 = __builtin_amdgcn_mfma_f32_32x32x16_f16(kf[0][ds], qfr, s0, 0, 0, 0); s1 = __builtin_amdgcn_mfma_f32_32x32x16_f16(kf[1][ds], qfr, s1, 0, 0, 0); }
#pragma unroll
                    for (int r = 0; r < 16; ++r) { acc0[r] += wh * fmaxf(s0[r], 0.f); acc1[r] += wh * fmaxf(s1[r], 0.f); }
                }
                float* sp = SC + (size_t)(32 * qg + r32) * SEQ + k0 + 8 * hi;
                *(f32x4*)(sp) = (f32x4){acc0[0], acc0[1], acc0[2], acc0[3]}; *(f32x4*)(sp + 4) = (f32x4){acc0[4], acc0[5], acc0[6], acc0[7]};
                *(f32x4*)(sp + 16) = (f32x4){acc0[8], acc0[9], acc0[10], acc0[11]}; *(f32x4*)(sp + 20) = (f32x4){acc0[12], acc0[13], acc0[14], acc0[15]};
                *(f32x4*)(sp + 32) = (f32x4){acc1[0], acc1[1], acc1[2], acc1[3]}; *(f32x4*)(sp + 36) = (f32x4){acc1[4], acc1[5], acc1[6], acc1[7]};
                *(f32x4*)(sp + 48) = (f32x4){acc1[8], acc1[9], acc1[10], acc1[11]}; *(f32x4*)(sp + 52) = (f32x4){acc1[12], acc1[13], acc1[14], acc1[15]};
                if (q0 + 63 > 255 && rep1 == 0) {
                    int e0 = k0 + 8 * hi; asm volatile("" : "+v"(e0));
#pragma unroll
                    for (int r = 0; r < 16; ++r) { const int kp0 = e0 + 16 * (r >> 3) + (r & 7);
                        if (kp0 <= tq) atomicAdd((unsigned*)&hrow[ord_key(acc0[r]) >> 24], 1u);
                        if (kp0 + 32 <= tq) atomicAdd((unsigned*)&hrow[ord_key(acc1[r]) >> 24], 1u); }
                }
            }
        }
#endif
        }
        __builtin_amdgcn_fence(__ATOMIC_RELEASE, "workgroup");
        __syncthreads();
        __builtin_amdgcn_fence(__ATOMIC_ACQUIRE, "workgroup");
        {
        const int tid = otid(wv);
        const int lane = tid & 63, wid = __builtin_amdgcn_readfirstlane(tid >> 6);
#pragma unroll 1
        for (int rr = 0; rr < 8; ++rr) {
            const int row = wid * 8 + rr; const int need = needv[row];
            if (need > 0) {
                const LAS unsigned* hr = hist + row * B_HROW + 4 * lane;
                const unsigned c0 = hr[0], c1 = hr[1], c2 = hr[2], c3 = hr[3];
                const unsigned sl = c0 + c1 + c2 + c3; unsigned suf = sl;
#pragma unroll
                for (int o = 1; o < 64; o <<= 1) { const unsigned tv = __shfl_down(suf, o); if (lane + o < 64) suf += tv; }
                unsigned cum = suf - sl; int fbin = -1; unsigned fabove = 0u, fcnt = 0u;
                { if ((int)cum < need && (int)(cum + c3) >= need) { fbin = 4 * lane + 3; fabove = cum; fcnt = c3; } cum += c3;
                  if ((int)cum < need && (int)(cum + c2) >= need) { fbin = 4 * lane + 2; fabove = cum; fcnt = c2; } cum += c2;
                  if ((int)cum < need && (int)(cum + c1) >= need) { fbin = 4 * lane + 1; fabove = cum; fcnt = c1; } cum += c1;
                  if ((int)cum < need && (int)(cum + c0) >= need) { fbin = 4 * lane + 0; fabove = cum; fcnt = c0; } }
                if (fbin >= 0) { pfx[row] = (unsigned)fbin << 24; needv[row] = need - (int)fabove; ceqv[row] = fcnt; }
            }
        }
        }
        __syncthreads();
        {
            const int tid = otid(wv);
            for (int i = tid; i < 2560; i += 512) { const int hh = i / 320, d = 223 - (i - 320 * hh);
                Tb[i] = d < 0 ? -1e30f : (p.rel_bias[t5_bucket(min(d, 127)) * 12 + 4 + hh] - p.rel_bias[31 * 12 + 4 + hh]) * LOG2E; }
        }
        {
        const int tid = otid(wv);
        const int lane = tid & 63, wid = __builtin_amdgcn_readfirstlane(tid >> 6);
        LAS unsigned* wh = (LAS unsigned*)lds + wid * 320;
        const int nwords = 2 * NT;
        u32x4 bufA[16], bufB[16];
#define ROW_LOAD(buf, rowi) do { const float* sr_ = SC + (size_t)(rowi) * SEQ + 4 * lane; _Pragma("unroll") for (int i = 0; i < 16; ++i) { buf[i] = (u32x4){0u, 0u, 0u, 0u}; if (256 * i <= q0 + 63) buf[i] = *(const u32x4*)(sr_ + 256 * i); } } while (0)
#define OKEY(u) ((u) ^ (((u) >> 31) ? 0xffffffffu : 0x80000000u))
#define ROW_PROC(key, rowi) do { \
            const int row = (rowi), tr = q0 + row; \
            unsigned thr = 0u; int cut = -1; \
            int need = needv[row]; \
            _Pragma("unroll") for (int i = 0; i < 16; ++i) { const int e = 256 * i + 4 * lane; \
                key[i].x = (e <= tr) ? OKEY(key[i].x) : 0u; key[i].y = (e + 1 <= tr) ? OKEY(key[i].y) : 0u; key[i].z = (e + 2 <= tr) ? OKEY(key[i].z) : 0u; key[i].w = (e + 3 <= tr) ? OKEY(key[i].w) : 0u; } \
            if (need > 0) { \
                unsigned prefix = pfx[row]; unsigned cnt = ceqv[row]; bool done = false; \
                if (need == (int)cnt) { thr = prefix - 1u; done = true; } \
                _Pragma("unroll 1") for (int pass = 1; pass < 4 && !done; ++pass) { \
                    const int shift = 24 - 8 * pass; const unsigned msk = 0xffffffffu << (shift + 8); \
                    wh[lane] = 0u; wh[64 + lane] = 0u; wh[128 + lane] = 0u; wh[192 + lane] = 0u; \
                    _Pragma("unroll") for (int i = 0; i < 16; ++i) { \
                        { const unsigned k = key[i].x; atomicAdd((unsigned*)&wh[((k & msk) == prefix) ? ((k >> shift) & 255u) : (256u + lane)], 1u); } \
                        { const unsigned k = key[i].y; atomicAdd((unsigned*)&wh[((k & msk) == prefix) ? ((k >> shift) & 255u) : (256u + lane)], 1u); } \
                        { const unsigned k = key[i].z; atomicAdd((unsigned*)&wh[((k & msk) == prefix) ? ((k >> shift) & 255u) : (256u + lane)], 1u); } \
                        { const unsigned k = key[i].w; atomicAdd((unsigned*)&wh[((k & msk) == prefix) ? ((k >> shift) & 255u) : (256u + lane)], 1u); } } \
                    const unsigned c0 = wh[4 * lane], c1 = wh[4 * lane + 1], c2 = wh[4 * lane + 2], c3 = wh[4 * lane + 3]; \
                    const unsigned sl = c0 + c1 + c2 + c3; unsigned suf = sl; \
                    _Pragma("unroll") for (int o = 1; o < 64; o <<= 1) { const unsigned tv = __shfl_down(suf, o); if (lane + o < 64) suf += tv; } \
                    unsigned cum = suf - sl; int fbin = -1; unsigned fabove = 0u, fcnt = 0u; \
                    { if ((int)cum < need && (int)(cum + c3) >= need) { fbin = 4 * lane + 3; fabove = cum; fcnt = c3; } cum += c3; \
                      if ((int)cum < need && (int)(cum + c2) >= need) { fbin = 4 * lane + 2; fabove = cum; fcnt = c2; } cum += c2; \
                      if ((int)cum < need && (int)(cum + c1) >= need) { fbin = 4 * lane + 1; fabove = cum; fcnt = c1; } cum += c1; \
                      if ((int)cum < need && (int)(cum + c0) >= need) { fbin = 4 * lane + 0; fabove = cum; fcnt = c0; } } \
                    const unsigned long long bm = __ballot(fbin >= 0); const int src = __ffsll((long long)bm) - 1; \
                    const int bin = __shfl(fbin, src); const unsigned above = __shfl(fabove, src); cnt = __shfl(fcnt, src); \
                    prefix |= (unsigned)bin << shift; need -= (int)above; \
                    if (pass < 3 && need == (int)cnt) { thr = prefix - 1u; done = true; } \
                } \
                if (!done) { thr = prefix; cut = 4096; \
                    if (need < (int)cnt) {        \
                        const float* srow = SC + (size_t)row * SEQ; int tbase = 0; \
                        for (int j = 0; j * 64 <= tr; ++j) { const int e = 64 * j + lane; const bool eq = (e <= tr) && (ord_key(srow[e]) == thr); \
                            const unsigned long long be = __ballot(eq); \
                            const int tpos = tbase + (int)__builtin_amdgcn_mbcnt_hi((unsigned)(be >> 32), __builtin_amdgcn_mbcnt_lo((unsigned)be, 0u)); \
                            const unsigned long long bh = __ballot(eq && tpos == need - 1); \
                            if (bh) { cut = 64 * j + (__ffsll((long long)bh) - 1); break; } \
                            tbase += __popcll(be); } \
                    } \
                } \
            } \
            LAS unsigned* mw = (LAS unsigned*)(lds + B_MASK) + row * B_MROW; \
            _Pragma("unroll") for (int i = 0; i < 16; ++i) if (256 * i <= q0 + 63) { const int e = 256 * i + 4 * lane; \
                unsigned nib = 0u; \
                nib |= (key[i].x > thr || (key[i].x == thr && e <= cut)) ? 1u : 0u; nib |= (key[i].y > thr || (key[i].y == thr && e + 1 <= cut)) ? 2u : 0u; \
                nib |= (key[i].z > thr || (key[i].z == thr && e + 2 <= cut)) ? 4u : 0u; nib |= (key[i].w > thr || (key[i].w == thr && e + 3 <= cut)) ? 8u : 0u; \
                unsigned v = nib << (4 * (lane & 7)); v |= __shfl_xor(v, 1); v |= __shfl_xor(v, 2); v |= __shfl_xor(v, 4); \
                const int w = 8 * i + (lane >> 3); if ((lane & 7) == 0 && w < nwords) mw[w] = v; } \
        } while (0)
        ROW_LOAD(bufA, wid * 8);
#pragma unroll 1
        for (int rr = 0; rr < 8; rr += 2) {
            ROW_LOAD(bufB, wid * 8 + rr + 1);
            ROW_PROC(bufA, wid * 8 + rr);
            if (rr + 2 < 8) ROW_LOAD(bufA, wid * 8 + rr + 2);
            ROW_PROC(bufB, wid * 8 + rr + 1);
        }
#undef ROW_LOAD
#undef ROW_PROC
#undef OKEY
        }
        __syncthreads();
#pragma unroll 1
        for (int rep3 = 0; rep3 < ((SKIP & 8) ? 0 : REPT); ++rep3) {
        const int tid = otid(wv);
        const int lane = tid & 63, wid = __builtin_amdgcn_readfirstlane(tid >> 6), r32 = lane & 31, hi = lane >> 5; (void)r32; (void)hi; (void)wid;
            LAS float* linv = (LAS float*)(lds + B_LINV) + wid * 64;
            const int qg = wid & 1, hp = wid >> 1, g = hp >> 1;
            const int qpos = q0 + 32 * qg + r32, qw0 = q0 + 32 * qg;
            const unsigned char* Qp0 = BQ + (tokbase + qpos) * 1024 + (2 * hp) * 128 + hi * 16;
            const LAS unsigned* mrow = (const LAS unsigned*)(lds + B_MASK) + (32 * qg + r32) * B_MROW;
            f32x16 O[2][2];
#pragma unroll
            for (int hh = 0; hh < 2; ++hh)
#pragma unroll
                for (int db = 0; db < 2; ++db)
#pragma unroll
                    for (int r = 0; r < 16; ++r) O[hh][db][r] = 0.f;
            float l0 = 0.f, l1 = 0.f;
            u32x4 kreg[2], vreg[2];
            const int srow_ = tid >> 4, sch = tid & 15;
#define B_LOAD(t) do { _Pragma("unroll") for (int i = 0; i < 2; ++i) { const size_t gofs = (tokbase + 64 * (t) + srow_ + 32 * i) * 256 + sch * 16; \
            kreg[i] = *(const u32x4*)(BK + gofs); vreg[i] = *(const u32x4*)(BV + gofs); } } while (0)
#define B_WRITE(st) do { _Pragma("unroll") for (int i = 0; i < 2; ++i) { *(LAS u32x4*)(lds + (st) * A_STG + (srow_ + 32 * i) * A_KROW + sch * 16) = kreg[i]; \
            *(LAS u32x4*)(lds + (st) * A_STG + A_KBUF + (srow_ + 32 * i) * A_VROW + sch * 16) = vreg[i]; } } while (0)
            B_LOAD(0); B_WRITE(0);
            __syncthreads();
#pragma unroll 1
            for (int t = 0; t < NT; ++t) {
                if (t + 1 < NT) B_LOAD(t + 1);
                const int k0 = 64 * t;
                const bool near = (k0 + 63 + 113 > qw0);
                const LAS unsigned char* Kb = lds + (t & 1) * A_STG; const LAS unsigned char* Vb = Kb + A_KBUF;
                unsigned selm;
                { const unsigned w0 = mrow[2 * t] >> (8 * hi), w1 = mrow[2 * t + 1] >> (8 * hi);
                  selm = (w0 & 0xffu) | ((w0 >> 8) & 0xff00u) | ((w1 & 0xffu) << 16) | ((w1 << 8) & 0xff000000u); }
#pragma unroll
                for (int hh = 0; hh < 2; ++hh) {
                    const LAS float* Th = Tb + (2 * hp + hh) * 320;
                    const float cinit = 0.f;
                    bf16x8 qfh[4];
#pragma unroll
                    for (int ds = 0; ds < 4; ++ds) qfh[ds] = *(const bf16x8*)(Qp0 + hh * 128 + 32 * ds);
                    float sacc = 0.f;
#pragma unroll
                    for (int hf = 0; hf < 2; ++hf) {
                        f32x16 s;
#pragma unroll
                        for (int r = 0; r < 16; ++r) s[r] = cinit;
                        const LAS unsigned char* kp = Kb + (32 * hf + pi32(r32)) * A_KROW + g * 128 + hi * 16;
#pragma unroll
                        for (int ds = 0; ds < 4; ++ds) { const bf16x8 kf = *(const LAS bf16x8*)(kp + 32 * ds); s = __builtin_amdgcn_mfma_f32_32x32x16_bf16(kf, qfh[ds], s, 0, 0, 0); }
                        if (!near) {
#pragma unroll
                            for (int r = 0; r < 16; ++r) { const float pv = __builtin_amdgcn_exp2f(s[r]); s[r] = ((selm >> (16 * hf + r)) & 1u) ? pv : 0.f; }
                        } else {
                            int ib = 223 - (qpos - k0 - 8 * hi - 32 * hf); asm volatile("" : "+v"(ib)); const LAS float* tp = Th + ib;
#pragma unroll
                            for (int r = 0; r < 16; ++r) { const float pv = __builtin_amdgcn_exp2f(s[r] + tp[16 * (r >> 3) + (r & 7)]); s[r] = ((selm >> (16 * hf + r)) & 1u) ? pv : 0.f; }
                        }
#pragma unroll
                        for (int r = 0; r < 16; ++r) sacc += s[r];
#pragma unroll
                        for (int jj = 0; jj < 2; ++jj) {
                            const int j = 2 * hf + jj, rb = 8 * jj;
                            u32x4 pw; pw.x = cvt_pk_bf16(s[rb], s[rb + 1]); pw.y = cvt_pk_bf16(s[rb + 2], s[rb + 3]); pw.z = cvt_pk_bf16(s[rb + 4], s[rb + 5]); pw.w = cvt_pk_bf16(s[rb + 6], s[rb + 7]);
                            const bf16x8 pa = __builtin_bit_cast(bf16x8, pw);
                            const LAS unsigned char* vp = Vb + (16 * j + 8 * hi + ((lane & 15) >> 2)) * A_VROW + (g * 64 + 16 * ((lane >> 4) & 1) + 4 * (lane & 3)) * 2;
#pragma unroll
                            for (int db = 0; db < 2; ++db) {
                                const s16x4 lo = vtr(vp + db * 64), hv = vtr(vp + 4 * A_VROW + db * 64);
                                const bf16x8 vf = (bf16x8){lo[0], lo[1], lo[2], lo[3], hv[0], hv[1], hv[2], hv[3]};
                                O[hh][db] = __builtin_amdgcn_mfma_f32_32x32x16_bf16(pa, vf, O[hh][db], 0, 0, 0);
                            }
                        }
                        __builtin_amdgcn_sched_barrier(0);
                    }
                    if (hh == 0) l0 += sacc; else l1 += sacc;
                }
                if (t + 1 < NT) B_WRITE((t + 1) & 1);
                __syncthreads();
            }
#undef B_LOAD
#undef B_WRITE
            l0 += __shfl_xor(l0, 32); l1 += __shfl_xor(l1, 32);
            if (hi == 0) { linv[r32] = 1.0f / l0; linv[32 + r32] = 1.0f / l1; }
#pragma unroll
            for (int hh = 0; hh < 2; ++hh)
#pragma unroll
                for (int r = 0; r < 16; ++r) { const int qr = crow(r, hi); const float f = linv[32 * hh + qr];
                    bf16_t* op = CAT + (tokbase + q0 + 32 * qg + qr) * 1024 + 512 + (2 * hp + hh) * 64 + r32;
#pragma unroll
                    for (int db = 0; db < 2; ++db) op[32 * db] = (bf16_t)(cvt_pk_bf16(O[hh][db][r] * f, 0.f) & 0xffffu); }
            if (REPT > 1) __syncthreads();
        }
        __syncthreads();
    }
}
#ifndef REPG1
#define REPG1 1
#endif
#ifndef REPG2
#define REPG2 1
#endif
#ifndef REPG3
#define REPG3 1
#endif
#ifndef PH
#define PH 255
#endif

#define XB_TMO      128
#define XB_XCNT(j)  (256  + 64 * (j))
#define XB_XSUB(j)  (1280 + 64 * (j))
#define XB_XGEN(j)  (2304 + 64 * (j))
#define XB_TOP      3328
#define XB_TOPGEN   3392
#define XCD_BAR_WORDS 3456
#define XB_SPIN_CAP (1u << 18)

__device__ __forceinline__ unsigned xb_ld(unsigned* p)              { return __hip_atomic_load(p, __ATOMIC_RELAXED, __HIP_MEMORY_SCOPE_AGENT); }
__device__ __forceinline__ unsigned xb_add(unsigned* p, unsigned v) { return __hip_atomic_fetch_add(p, v, __ATOMIC_RELAXED, __HIP_MEMORY_SCOPE_AGENT); }
__device__ __forceinline__ unsigned xb_xcc_id() { return (unsigned)__builtin_amdgcn_s_getreg((3 << 11) | 20) & 0xFu; }
#define XB_SPIN(cond, bar) do { unsigned _sp = 0; while (cond) { __builtin_amdgcn_s_sleep(1); \
    if ((++_sp & 255u) == 0u) { if (xb_ld(&(bar)[XB_TMO])) break; if (_sp > XB_SPIN_CAP) { atomicAdd(&(bar)[XB_TMO], 1u); break; } } } } while (0)

struct XcdBarrier {
    unsigned* bar; unsigned x;
    volatile LAS unsigned* st;
};

__device__ __forceinline__ XcdBarrier xcd_barrier_post(unsigned* bar, volatile LAS unsigned* st) {
    XcdBarrier b; b.bar = bar; b.x = xb_xcc_id(); b.st = st;
    if (threadIdx.x == 0) (void)xb_add(&bar[XB_XCNT(b.x)], 1u);
    return b;
}
__device__ __forceinline__ void xcd_barrier_complete(unsigned* bar, unsigned x, unsigned& nloc, unsigned& nx) {
    const unsigned G = gridDim.x * gridDim.y * gridDim.z;
    unsigned sum, cnt, mine, sp = 0u;
    for (;;) {
        sum = 0u; cnt = 0u; mine = 0u;
#pragma unroll
        for (unsigned j = 0; j < 16; ++j) { const unsigned c = xb_ld(&bar[XB_XCNT(j)]); sum += c; cnt += (c > 0u) ? 1u : 0u; mine = (j == x) ? c : mine; }
        if (sum == G) break;
        __builtin_amdgcn_s_sleep(1);
        if ((++sp & 255u) == 0u) { if (xb_ld(&bar[XB_TMO])) break; if (sp > XB_SPIN_CAP) { atomicAdd(&bar[XB_TMO], 1u); break; } }
    }
    nloc = mine > 0u ? mine : 1u; nx = cnt > 0u ? cnt : 1u;
}

__device__ __forceinline__ void xcd_barrier(const XcdBarrier& b) {
    asm volatile("s_waitcnt vmcnt(0)" ::: "memory");
    __syncthreads();
    if (threadIdx.x == 0) {
        unsigned* bar = b.bar;
        __builtin_amdgcn_s_waitcnt(0);
        unsigned nloc = b.st[0], nx = b.st[1];
        if (nloc == 0u) { xcd_barrier_complete(bar, b.x, nloc, nx); b.st[0] = nloc; b.st[1] = nx; }
        const unsigned old = xb_add(&bar[XB_XSUB(b.x)], 1u);
        const unsigned gen = old / nloc;
        if (old + 1u == (gen + 1u) * nloc) {
            __builtin_amdgcn_fence(__ATOMIC_RELEASE, "agent");
            asm volatile("s_waitcnt vmcnt(0)" ::: "memory");
            const unsigned og = xb_add(&bar[XB_TOP], 1u);
            const unsigned tg = og / nx;
            if (og + 1u == (tg + 1u) * nx) xb_add(&bar[XB_TOPGEN], 1u);
            else XB_SPIN(xb_ld(&bar[XB_TOPGEN]) == tg, bar);
            __builtin_amdgcn_fence(__ATOMIC_ACQUIRE, "agent");
            xb_add(&bar[XB_XGEN(b.x)], 1u);
            asm volatile("s_waitcnt vmcnt(0)" ::: "memory");
        } else {
            XB_SPIN(xb_ld(&bar[XB_XGEN(b.x)]) == gen, bar);
            __builtin_amdgcn_fence(__ATOMIC_ACQUIRE, "agent");
            asm volatile("s_waitcnt vmcnt(0)" ::: "memory");
        }
    }
    __syncthreads();
}

constexpr size_t WS_BAR = 786432;
constexpr int XB_LDS_OFF = LDS_BYTES - 16;
typedef const __attribute__((address_space(4))) Params* KParamsPtr;
__device__ __forceinline__ Params load_params(KParamsPtr q) {
    Params r; r.x = q->x; r.c = q->c; r.w_ada = q->w_ada; r.b_ada = q->b_ada; r.g_attn = q->g_attn; r.w_in = q->w_in; r.qna = q->qna; r.kna = q->kna; r.qnb = q->qnb; r.knb = q->knb;
    r.lam = q->lam; r.subln = q->subln; r.w_out = q->w_out; r.g_ffn = q->g_ffn; r.w_up = q->w_up; r.conv_w = q->conv_w; r.conv_b = q->conv_b; r.w_down = q->w_down; r.rel_bias = q->rel_bias;
    r.out = q->out; r.ws = q->ws; return r;
}
#define FRESH_PARAMS() KParamsPtr pp_ = (KParamsPtr)__builtin_amdgcn_kernarg_segment_ptr(); asm volatile("" : "+s"(pp_)); const Params p = load_params(pp_); \
    float* mod = (float*)(p.ws + WS_MOD); bf16_t* H = (bf16_t*)(p.ws + WS_H); const int G = (int)gridDim.x, cb = (int)blockIdx.x; (void)mod; (void)H; (void)G; (void)cb
__global__ void __launch_bounds__(512, 2) hybrid_block_fwd(Params p_unused) {
    extern __shared__ __attribute__((aligned(16))) unsigned char lds_raw[];
    LAS unsigned char* lds = (LAS unsigned char*)lds_raw;
    cg::grid_group grid = cg::this_grid();
    if (threadIdx.x < 4) ((LAS unsigned*)(lds + XB_LDS_OFF))[threadIdx.x] = 0u;
    __syncthreads();
    const int wv = __builtin_amdgcn_readfirstlane((int)threadIdx.x >> 6);
    { FRESH_PARAMS(); if (blockIdx.x == 0) { unsigned* bw = (unsigned*)(p.ws + WS_BAR); for (int i = threadIdx.x; i < XCD_BAR_WORDS; i += 512) bw[i] = 0u; }
      phase0(p, lds, wv); }
    grid.sync();
    XcdBarrier bar;
    { FRESH_PARAMS(); bar = xcd_barrier_post((unsigned*)(p.ws + WS_BAR), (volatile LAS unsigned*)(lds + XB_LDS_OFF)); }
    { FRESH_PARAMS(); norm_phase(p.x, p.g_attn, mod, 1024, 0, H, wv); }
    xcd_barrier(bar);
    {
        FRESH_PARAMS();
        pg8::Gemm g{H, (const bf16_t*)(p.ws + WS_WIN), MTOK, NPROJ, DM}; pg8::StaticOrder S; S.init(MTOK, NPROJ, G, cb);
        EpiProj E{p.ws, p.qna, p.kna, p.qnb, p.knb};
#pragma unroll 1
        for (int rep = 0; rep < REPG1; ++rep) pg8::gemm_phase<EpiProj, pg8::StaticOrder, true, true>(lds, g, S, E, wv);
    }
    xcd_barrier(bar);
    { FRESH_PARAMS(); attnA_phase(p, lds, wv); }
    __syncthreads();
    { FRESH_PARAMS(); phaseB(p, lds, wv); }
    xcd_barrier(bar);
    {
        FRESH_PARAMS();
        pg8::Gemm g{(const bf16_t*)(p.ws + WS_CAT), (const bf16_t*)(p.ws + WS_WOUT), MTOK, DM, DM}; pg8::StaticOrder S; S.init(MTOK, DM, G, cb);
        EpiOut E{p.x, mod + 2048, p.out};
#pragma unroll 1
        for (int rep = 0; rep < REPG2; ++rep) pg8::gemm_phase<EpiOut, pg8::StaticOrder, true, true>(lds, g, S, E, wv);
    }
    xcd_barrier(bar);
    { FRESH_PARAMS(); norm_phase(p.out, p.g_ffn, mod, 4096, 3072, H, wv); }
    xcd_barrier(bar);
    {
        FRESH_PARAMS();
        pg8::Gemm g{H - 2 * DM, (const bf16_t*)(p.ws + WS_WUP), 259 * 256, NUP, DM, 254}; pg8::StaticOrder S; S.init(259 * 256, NUP, G, cb);
        EpiUpConv E{(bf16_t*)(p.ws + WS_U), p.conv_w, p.conv_b, (LAS float*)(lds + HALO_OFF)};
#pragma unroll 1
        for (int rep = 0; rep < REPG3; ++rep) pg8::gemm_phase<EpiUpConv, pg8::StaticOrder, true, true>(lds, g, S, E, wv);
    }
    xcd_barrier(bar);
    {
        FRESH_PARAMS();
        pg8::Gemm g{(const bf16_t*)(p.ws + WS_U), (const bf16_t*)(p.ws + WS_WDN), MTOK, DM, DFF}; pg8::StaticOrder S; S.init(MTOK, DM, G, cb);
        EpiDown E{mod + 5120, p.out, 0};
        pg8::gemm_phase<EpiDown, pg8::StaticOrder, true, true>(lds, g, S, E, wv);
    }
}

extern "C" void kernel_launch(void* const* d_in, const int* in_sizes, int n_in, void* d_out, int out_size, void* d_ws, size_t ws_size, hipStream_t stream) {
    static int grid_blocks = 0;
    if (grid_blocks == 0) {
        if (n_in != 19 || ws_size < WS_END) { fprintf(stderr, "kernel_launch: unexpected n_in %d / ws %zu\n", n_in, ws_size); grid_blocks = -1; return; }
        int dev = 0, cus = 0, per_cu = 0;
        hipGetDevice(&dev);
        hipDeviceGetAttribute(&cus, hipDeviceAttributeMultiprocessorCount, dev);
        if (hipFuncSetAttribute((const void*)hybrid_block_fwd, hipFuncAttributeMaxDynamicSharedMemorySize, LDS_BYTES) != hipSuccess) { fprintf(stderr, "hipFuncSetAttribute failed\n"); }
        if (hipOccupancyMaxActiveBlocksPerMultiprocessor(&per_cu, (const void*)hybrid_block_fwd, 512, LDS_BYTES) != hipSuccess || per_cu < 1) { fprintf(stderr, "occupancy query: %d\n", per_cu); per_cu = 1; }
        (void)hipGetLastError();
        grid_blocks = cus * (per_cu > 1 ? 1 : per_cu);
        if (grid_blocks > 256) grid_blocks = 256;
    }
    if (grid_blocks < 0) return;
    Params p{};
    const float** f = (const float**)&p;
    for (int i = 0; i < 19; ++i) f[i] = (const float*)d_in[i];
    p.out = (float*)d_out; p.ws = (unsigned char*)d_ws;
    void* args[] = {&p};
    hipError_t e = hipLaunchCooperativeKernel((const void*)hybrid_block_fwd, dim3(grid_blocks), dim3(512), args, LDS_BYTES, stream);
    if (e != hipSuccess) fprintf(stderr, "cooperative launch failed: %s (grid %d)\n", hipGetErrorString(e), grid_blocks);
}
```

```cpp
#include <hip/hip_runtime.h>
#include <hip/hip_cooperative_groups.h>
#include <cstdio>
#include <cstdint>
#include <cmath>
namespace cg = cooperative_groups;

namespace pg8 {
#define PG8_LAS __attribute__((address_space(3)))
typedef unsigned short bf16_t;
typedef short bf16x8 __attribute__((ext_vector_type(8)));
typedef float f32x4 __attribute__((ext_vector_type(4)));
typedef unsigned u32x4 __attribute__((ext_vector_type(4)));
constexpr int BM = 256, BK = 64, HALF = 128, HTB = HALF * BK * 2  , STAGE_BYTES = 8 * HTB, NXCD = 8, WGM = 8;

__host__ __device__ __forceinline__ int lds_byte(int r, int c) { const int st = (r >> 4) * 2 + (c >> 5), rr = r & 15, cc = c & 31, ob = rr * 64 + cc * 2; return st * 1024 + (ob ^ (((ob >> 9) & 1) << 5)); }
__host__ __device__ __forceinline__ void stage_rc(int b, int& R, int& C) { const int st = b / 1024, sb = b % 1024, swz = sb ^ (((sb >> 9) & 1) << 5); R = (st >> 1) * 16 + swz / 64; C = (st & 1) * 32 + (swz % 64) / 2; }
__host__ __device__ __forceinline__ int perm32(int rho) { const int n = rho >> 4, i = rho & 15; return 8 * (i >> 2) + 4 * n + (i & 3); }

struct Unit { int pm, pn; };
struct Gemm { const bf16_t* A; const bf16_t* Bt; int M, N, K; int a_rows = 256; };

struct StaticOrder {
    int nM, nN, nwg, G, c;
    __host__ __device__ void init(int M, int N, int G_, int c_) { nM = M / BM; nN = N / BM; nwg = nM * nN; G = G_; c = c_; }
    __host__ __device__ bool next(int i, Unit& u) const {
        const long L = (long)i * G + c; if (L >= nwg) return false;
        int wgid = (int)L; { const int q = nwg / NXCD, r = nwg % NXCD, xcd = wgid % NXCD, off = wgid / NXCD; wgid = (xcd < r ? xcd * (q + 1) : r * (q + 1) + (xcd - r) * q) + off; }
        const int nig = WGM * nN, gid = wgid / nig, fm = gid * WGM, gsz = (nM - fm) < WGM ? (nM - fm) : WGM;
        u.pm = fm + ((wgid % nig) % gsz); u.pn = (wgid % nig) / gsz; return true;
    }
    __device__ __forceinline__ void a_ready(const Unit&) const {}
    __device__ __forceinline__ void done(const Unit&) const {}
};

__device__ __forceinline__ unsigned cvt_pk_bf16(float lo, float hi) { unsigned r; asm volatile("v_cvt_pk_bf16_f32 %0, %1, %2" : "=v"(r) : "v"(lo), "v"(hi)); return r; }
template <class Epi, class Sched, bool ALIGN_EPI = false, bool SP2 = false>
__device__ __forceinline__ void gemm_phase(PG8_LAS unsigned char* lds, const Gemm g, const Sched& S, const Epi& E, const int wv) {
    int tid_; asm volatile("v_mbcnt_lo_u32_b32 %0, -1, 0\n\tv_mbcnt_hi_u32_b32 %0, -1, %0" : "=v"(tid_)); tid_ += wv * 64;
    const int tid = tid_, wid = __builtin_amdgcn_readfirstlane(tid >> 6), lane = tid & 63, wr = wid >> 2, wc = wid & 3, fr = lane & 15, fq = lane >> 4;
    const int K = g.K, nt = K / BK;
    unsigned voffA[2], voffB[2];
#pragma unroll
    for (int i = 0; i < 2; ++i) { int R, C; stage_rc(tid * 16 + i * 8192, R, C); const int Rb = Epi::PERM ? ((R & ~31) + perm32(R & 31)) : R;
        voffA[i] = (unsigned)(R * K + C) * 2u; voffB[i] = (unsigned)(Rb * K + C) * 2u; }
    const size_t kstep = (size_t)(BK * 2);
    const size_t hstep = (size_t)HALF * K * 2;
    const size_t tstep = 2 * hstep; const size_t tstepA = (size_t)g.a_rows * K * 2;
    const unsigned ldsw = (unsigned)wid * 1024u;
    const int aoff = lds_byte(wr * 64 + fr, fq * 8), boff = lds_byte(wc * 32 + fr, fq * 8);
#define PG8_SA(b, h) (((b) * 2 + (h)) * HTB)
#define PG8_SB(b, h) ((4 + (b) * 2 + (h)) * HTB)
#define PG8_STAGE(bufoff, gbase, voff) do { _Pragma("unroll") for (int _i = 0; _i < 2; ++_i) \
        __builtin_amdgcn_global_load_lds((const unsigned*)((const char*)(gbase) + (voff)[_i]), (PG8_LAS unsigned*)(lds + (bufoff) + ldsw + _i * 8192), 16, 0, 0); } while (0)
#define PG8_LDA(dst, b, h) do { _Pragma("unroll") for (int m = 0; m < 4; ++m) _Pragma("unroll") for (int k = 0; k < 2; ++k) dst[m][k] = *(const PG8_LAS bf16x8*)(lds + PG8_SA(b, h) + aoff + m * 2048 + k * 1024); } while (0)
#define PG8_LDB(dst, b, h) do { _Pragma("unroll") for (int n = 0; n < 2; ++n) _Pragma("unroll") for (int k = 0; k < 2; ++k) dst[n][k] = *(const PG8_LAS bf16x8*)(lds + PG8_SB(b, h) + boff + n * 2048 + k * 1024); } while (0)
#define PG8_MMA(ai, bj, At, Bt) do { __builtin_amdgcn_s_setprio(1); _Pragma("unroll") for (int m = 0; m < 4; ++m) _Pragma("unroll") for (int n = 0; n < 2; ++n) _Pragma("unroll") for (int k = 0; k < 2; ++k) \
        acc[ai][bj][m][n] = __builtin_amdgcn_mfma_f32_16x16x32_bf16(Bt[n][k], At[m][k], acc[ai][bj][m][n], 0, 0, 0); __builtin_amdgcn_s_setprio(0); } while (0)
#define PG8_WAIT_V(n) asm volatile("s_waitcnt vmcnt(" #n ")" ::: "memory")
#define PG8_WAIT_L(n) asm volatile("s_waitcnt lgkmcnt(" #n ")" ::: "memory")
#define PG8_BAR __builtin_amdgcn_s_barrier()
#define PG8_SCHED __builtin_amdgcn_sched_barrier(0)
    Unit cur, nxt; int ui = 0;
    if (!S.next(0, cur)) return;
    f32x4 acc[2][2][4][2];
#pragma unroll
    for (int a = 0; a < 2; ++a)
#pragma unroll
        for (int b = 0; b < 2; ++b)
#pragma unroll
            for (int m = 0; m < 4; ++m)
#pragma unroll
                for (int n = 0; n < 2; ++n) acc[a][b][m][n] = (f32x4){0.f, 0.f, 0.f, 0.f};
    bf16x8 At[4][2], B0[2][2], B1[2][2];
    const char* cA = (const char*)g.A + (size_t)cur.pm * tstepA; const char* cB = (const char*)g.Bt + (size_t)cur.pn * tstep;
    S.a_ready(cur);
    if constexpr (SP2) {
        PG8_STAGE(PG8_SB(0, 0), cB, voffB); PG8_STAGE(PG8_SB(0, 1), cB + hstep, voffB); PG8_STAGE(PG8_SA(0, 0), cA, voffA); PG8_STAGE(PG8_SA(0, 1), cA + hstep, voffA);
        if (wr == 1) PG8_BAR;
        PG8_WAIT_V(2); PG8_BAR;
        PG8_STAGE(PG8_SB(1, 0), cB + kstep, voffB); PG8_STAGE(PG8_SA(1, 0), cA + kstep, voffA); PG8_STAGE(PG8_SB(1, 1), cB + hstep + kstep, voffB);
        PG8_WAIT_V(6); PG8_BAR;
    } else {
        PG8_STAGE(PG8_SB(0, 0), cB, voffB); PG8_STAGE(PG8_SA(0, 0), cA, voffA); PG8_STAGE(PG8_SB(0, 1), cB + hstep, voffB); PG8_STAGE(PG8_SA(0, 1), cA + hstep, voffA);
        if (wr == 1) PG8_BAR;
        PG8_WAIT_V(4); PG8_BAR;
        PG8_STAGE(PG8_SB(1, 0), cB + kstep, voffB); PG8_STAGE(PG8_SA(1, 0), cA + kstep, voffA); PG8_STAGE(PG8_SB(1, 1), cB + hstep + kstep, voffB);
        PG8_WAIT_V(6); PG8_BAR;
    }
    for (;;) {
        const bool has_next = S.next(ui + 1, nxt);
        const char* nA = has_next ? (const char*)g.A + (size_t)nxt.pm * tstepA : cA; const char* nB = has_next ? (const char*)g.Bt + (size_t)nxt.pn * tstep : cB;
        for (int t = 0; t < nt; t += 2) {
            const bool last = (t == nt - 2);
            const char* a1 = cA + (size_t)(t + 1) * kstep;
            const char* a2 = last ? nA : cA + (size_t)(t + 2) * kstep; const char* b2 = last ? nB : cB + (size_t)(t + 2) * kstep;
            const char* a3 = a2 + kstep; const char* b3 = b2 + kstep;
            if (last && has_next) S.a_ready(nxt);
            if constexpr (SP2) {
            PG8_LDB(B0, 0, 0); PG8_LDB(B1, 0, 1); PG8_SCHED; PG8_LDA(At, 0, 0); PG8_STAGE(PG8_SA(1, 1), a1 + hstep, voffA);
            PG8_WAIT_V(8); PG8_WAIT_L(0); PG8_BAR; PG8_MMA(0, 0, At, B0); PG8_MMA(0, 1, At, B1); PG8_BAR; PG8_SCHED;
            PG8_LDA(At, 0, 1); PG8_STAGE(PG8_SB(0, 0), b2, voffB); PG8_STAGE(PG8_SB(0, 1), b2 + hstep, voffB); PG8_STAGE(PG8_SA(0, 0), a2, voffA);
            PG8_WAIT_V(8); PG8_WAIT_L(0); PG8_BAR; PG8_MMA(1, 0, At, B0); PG8_MMA(1, 1, At, B1); PG8_BAR; PG8_SCHED;
            PG8_LDB(B0, 1, 0); PG8_LDB(B1, 1, 1); PG8_SCHED; PG8_LDA(At, 1, 0); PG8_STAGE(PG8_SA(0, 1), a2 + hstep, voffA);
            PG8_WAIT_V(8); PG8_WAIT_L(0); PG8_BAR; PG8_MMA(0, 0, At, B0); PG8_MMA(0, 1, At, B1); PG8_BAR; PG8_SCHED;
            PG8_LDA(At, 1, 1); PG8_STAGE(PG8_SB(1, 0), b3, voffB); PG8_STAGE(PG8_SB(1, 1), b3 + hstep, voffB); PG8_STAGE(PG8_SA(1, 0), a3, voffA);
            PG8_WAIT_V(8); PG8_WAIT_L(0); PG8_BAR; PG8_MMA(1, 0, At, B0); PG8_MMA(1, 1, At, B1); PG8_BAR; PG8_SCHED;
            } else {
            PG8_LDB(B0, 0, 0); PG8_SCHED; PG8_LDA(At, 0, 0); PG8_STAGE(PG8_SA(1, 1), a1 + hstep, voffA);
            PG8_WAIT_L(8); PG8_BAR; PG8_WAIT_L(0); PG8_MMA(0, 0, At, B0); PG8_BAR; PG8_SCHED;
            PG8_LDB(B1, 0, 1); PG8_STAGE(PG8_SB(0, 0), b2, voffB);
            PG8_BAR; PG8_WAIT_L(0); PG8_MMA(0, 1, At, B1); PG8_BAR;
            PG8_LDA(At, 0, 1); PG8_STAGE(PG8_SA(0, 0), a2, voffA);
            PG8_BAR; PG8_WAIT_L(0); PG8_MMA(1, 0, At, B0); PG8_BAR; PG8_SCHED;
            PG8_STAGE(PG8_SB(0, 1), b2 + hstep, voffB);
            PG8_WAIT_V(6); PG8_BAR; PG8_MMA(1, 1, At, B1); PG8_BAR;
            PG8_LDB(B0, 1, 0); PG8_SCHED; PG8_LDA(At, 1, 0); PG8_STAGE(PG8_SA(0, 1), a2 + hstep, voffA);
            PG8_WAIT_L(8); PG8_BAR; PG8_WAIT_L(0); PG8_MMA(0, 0, At, B0); PG8_BAR; PG8_SCHED;
            PG8_LDB(B1, 1, 1); PG8_STAGE(PG8_SB(1, 0), b3, voffB);
            PG8_BAR; PG8_WAIT_L(0); PG8_MMA(0, 1, At, B1); PG8_BAR;
            PG8_LDA(At, 1, 1); PG8_STAGE(PG8_SA(1, 0), a3, voffA);
            PG8_BAR; PG8_WAIT_L(0); PG8_MMA(1, 0, At, B0); PG8_BAR; PG8_SCHED;
            PG8_STAGE(PG8_SB(1, 1), b3 + hstep, voffB);
            PG8_WAIT_V(6); PG8_BAR; PG8_MMA(1, 1, At, B1); PG8_BAR;
            }
        }
        if constexpr (ALIGN_EPI) { if (wr == 0) PG8_BAR; }
        if constexpr (!Epi::AFTER_DRAIN) { E(acc, cur, wr, wc, fr, fq); S.done(cur); }
        if (!has_next) break;
#pragma unroll
        for (int a = 0; a < 2; ++a)
#pragma unroll
            for (int b = 0; b < 2; ++b)
#pragma unroll
                for (int m = 0; m < 4; ++m)
#pragma unroll
                    for (int n = 0; n < 2; ++n) acc[a][b][m][n] = (f32x4){0.f, 0.f, 0.f, 0.f};
        cur = nxt; cA = nA; cB = nB; ++ui;
        if constexpr (ALIGN_EPI) { if (wr == 1) PG8_BAR; }
    }
    PG8_WAIT_V(0);
    if constexpr (!ALIGN_EPI) { if (wr == 0) PG8_BAR; }
    PG8_BAR;
    if constexpr (Epi::AFTER_DRAIN) { E.fused(acc, cur, wr, wc, fr, fq, lds, wid, lane); S.done(cur); }
#undef PG8_SA
#undef PG8_SB
#undef PG8_STAGE
#undef PG8_LDA
#undef PG8_LDB
#undef PG8_MMA
#undef PG8_WAIT_V
#undef PG8_WAIT_L
#undef PG8_BAR
#undef PG8_SCHED
}
}

using pg8::bf16_t; using pg8::f32x4; using pg8::Unit; using pg8::cvt_pk_bf16;
typedef short bf16x8 __attribute__((ext_vector_type(8)));
typedef _Float16 f16x8 __attribute__((ext_vector_type(8)));
typedef float f32x16 __attribute__((ext_vector_type(16)));
typedef unsigned u32x4 __attribute__((ext_vector_type(4)));
typedef unsigned u32x2 __attribute__((ext_vector_type(2)));
typedef short s16x4 __attribute__((ext_vector_type(4)));
#define LAS __attribute__((address_space(3)))

constexpr int BATCH = 16, SEQ = 4096, DM = 1024, MTOK = BATCH * SEQ;
constexpr int NPROJ = 3072, NREAL = 2888, DFF = 2816, NUP = 5632, MODW = 6144;
constexpr int MHALF = MTOK / 2;
constexpr float EPS = 1e-6f, LOG2E = 1.4426950408889634f, QSCALE = 0.125f * LOG2E;
constexpr size_t MiB = 1u << 20;
constexpr size_t WS_MOD = 0, WS_WIN = 1 * MiB, WS_WOUT = 7 * MiB, WS_WUP = 9 * MiB, WS_WDN = 20 * MiB, WS_H = 26 * MiB;
constexpr size_t WS_AQ = 154 * MiB, WS_AK = 218 * MiB, WS_AV = 282 * MiB, WS_BQ = 346 * MiB, WS_BK = 410 * MiB, WS_BV = 426 * MiB;
constexpr size_t WS_IQ = 442 * MiB, WS_IK = 506 * MiB, WS_IW = 514 * MiB, WS_CAT = 516 * MiB, WS_SC = 644 * MiB;
constexpr size_t WS_U = 154 * MiB, WS_G = 506 * MiB, WS_END = 1024 * MiB;
constexpr int LDS_BYTES = 147456;

struct Params {
    const float *x, *c, *w_ada, *b_ada, *g_attn, *w_in, *qna, *kna, *qnb, *knb, *lam, *subln, *w_out, *g_ffn, *w_up, *conv_w, *conv_b, *w_down, *rel_bias;
    float* out; unsigned char* ws;
};

__device__ __forceinline__ int otid(int wv) { int l; asm volatile("v_mbcnt_lo_u32_b32 %0, -1, 0\n\tv_mbcnt_hi_u32_b32 %0, -1, %0" : "=v"(l)); return wv * 64 + l; }
__device__ __forceinline__ float wave_sum(float v) {
#pragma unroll
    for (int o = 1; o < 64; o <<= 1) v += __shfl_xor(v, o);
    return v;
}
__device__ __forceinline__ float wave_max(float v) {
#pragma unroll
    for (int o = 1; o < 64; o <<= 1) v = fmaxf(v, __shfl_xor(v, o));
    return v;
}
__device__ __forceinline__ unsigned pk_f16(float a, float b) {
    _Float16 x = (_Float16)a, y = (_Float16)b;
    return (unsigned)__builtin_bit_cast(unsigned short, x) | ((unsigned)__builtin_bit_cast(unsigned short, y) << 16);
}
__device__ __forceinline__ int pi32(int m) { const int a = m >> 3, h = (m >> 2) & 1, c = m & 3; return 16 * (a >> 1) + 8 * h + 4 * (a & 1) + c; }
__device__ __forceinline__ int crow(int r, int hi) { return (r & 3) + 8 * (r >> 2) + 4 * hi; }
__device__ __forceinline__ int t5_bucket(int n) {
    if (n < 16) return n;
    return 16 + (n >= 19) + (n >= 21) + (n >= 24) + (n >= 27) + (n >= 31) + (n >= 35) + (n >= 40) + (n >= 46) + (n >= 52) + (n >= 59) + (n >= 67) + (n >= 77) + (n >= 87) + (n >= 99) + (n >= 113);
}
__device__ __forceinline__ s16x4 vtr(const LAS unsigned char* p) {
    return __builtin_bit_cast(s16x4, __builtin_amdgcn_ds_read_tr16_b64_v4i16((LAS s16x4*)p));
}

__device__ __forceinline__ int perm_inv(int n) { return (n & ~255) + 128 * ((n >> 5) & 1) + 32 * ((n >> 6) & 3) + (n & 31); }
__device__ __forceinline__ int perm_up(int n) { const int v = n >= DFF, m = n - (v ? DFF : 0); return (m >> 7) * 256 + 128 * v + (m & 127); }
__device__ __forceinline__ void transpose_tile(const float* W, int K, int N, int nreal, bf16_t* Bt, int k0, int n0, int permute, LAS float* scr, int tid) {
#pragma unroll
    for (int i = 0; i < 8; ++i) { const int kk = (tid >> 6) + 8 * i, nn = tid & 63, n = n0 + nn; scr[kk * 65 + nn] = (n < nreal) ? W[(size_t)(k0 + kk) * N + n] : 0.f; }
    __syncthreads();
    { const int nn = tid >> 3, c = tid & 7, n = n0 + nn, drow = permute == 1 ? perm_inv(n) : (permute == 2 ? perm_up(n) : n); const LAS float* s = scr + (8 * c) * 65 + nn;
      u32x4 o; o.x = cvt_pk_bf16(s[0], s[65]); o.y = cvt_pk_bf16(s[130], s[195]); o.z = cvt_pk_bf16(s[260], s[325]); o.w = cvt_pk_bf16(s[390], s[455]);
      *(u32x4*)(Bt + (size_t)drow * K + k0 + 8 * c) = o; }
    __syncthreads();
}
__device__ __forceinline__ void phase0(const Params& p, LAS unsigned char* lds, int wv) {
    const int tid = otid(wv);
    LAS float* sc = (LAS float*)lds;
    LAS float* scr = (LAS float*)(lds + 65536);
    LAS float* red = (LAS float*)(lds + 65536 + 16640);
    constexpr int I_IN = 16 * 48, I_OUT = 16 * 16, I_UP = 16 * 88, I_DN = 44 * 16, NIT = I_IN + I_OUT + I_UP + I_DN;
    for (int it = blockIdx.x; it < NIT; it += gridDim.x) {
        int r = it;
        if (r < I_IN) { transpose_tile(p.w_in, 1024, NREAL, NREAL, (bf16_t*)(p.ws + WS_WIN), 64 * (r / 48), 64 * (r % 48), 1, scr, tid); continue; } r -= I_IN;
        if (r < I_OUT) { transpose_tile(p.w_out, 1024, 1024, 1024, (bf16_t*)(p.ws + WS_WOUT), 64 * (r / 16), 64 * (r % 16), 0, scr, tid); continue; } r -= I_OUT;
        if (r < I_UP) { transpose_tile(p.w_up, 1024, NUP, NUP, (bf16_t*)(p.ws + WS_WUP), 64 * (r / 88), 64 * (r % 88), 2, scr, tid); continue; } r -= I_UP;
        transpose_tile(p.w_down, DFF, 1024, 1024, (bf16_t*)(p.ws + WS_WDN), 64 * (r / 16), 64 * (r % 16), 0, scr, tid);
    }
    if (blockIdx.x < 192) {
        for (int i = tid; i < 16 * 1024; i += 512) { const float v = p.c[i]; sc[i] = v / (1.f + __expf(-v)); }
        __syncthreads();
        float* mod = (float*)(p.ws + WS_MOD);
        for (int g = blockIdx.x; g < 192; g += gridDim.x) {
            const int kq = tid >> 5, col = tid & 31;
            float acc[16];
#pragma unroll
            for (int b = 0; b < 16; ++b) acc[b] = 0.f;
#pragma unroll 1
            for (int kb = 0; kb < 64; kb += 16) {
                float wv16[16];
#pragma unroll
                for (int i = 0; i < 16; ++i) wv16[i] = p.w_ada[(size_t)(kq * 64 + kb + i) * MODW + g * 32 + col];
#pragma unroll
                for (int i = 0; i < 16; ++i) { const int k = kq * 64 + kb + i;
#pragma unroll
                    for (int b = 0; b < 16; ++b) acc[b] += sc[b * 1024 + k] * wv16[i]; } }
#pragma unroll
            for (int b = 0; b < 16; ++b) red[(kq * 16 + b) * 32 + col] = acc[b];
            __syncthreads();
            { const int b = tid >> 5; float s = p.b_ada[g * 32 + col];
#pragma unroll
              for (int q = 0; q < 16; ++q) s += red[(q * 16 + b) * 32 + col];
              mod[b * MODW + g * 32 + col] = s; }
            __syncthreads();
        }
    }
}

__device__ __forceinline__ void norm_phase(const float* X, const float* gvec, const float* mod, int sc_off, int sh_off, bf16_t* H, int wv) {
    const int tid = otid(wv); const int lane = tid & 63, gw = blockIdx.x * 8 + (tid >> 6), NGW = gridDim.x * 8;
    for (int row0 = gw; row0 < MTOK; row0 += 4 * NGW) {
        f32x4 v[4][4];
#pragma unroll
        for (int q = 0; q < 4; ++q) { const int row = min(row0 + q * NGW, MTOK - 1); const f32x4* xr = (const f32x4*)(X + (size_t)row * DM) + lane;
#pragma unroll
            for (int j = 0; j < 4; ++j) v[q][j] = xr[64 * j]; }
#pragma unroll
        for (int q = 0; q < 4; ++q) {
            const int row = row0 + q * NGW;
            float ss = 0.f;
#pragma unroll
            for (int j = 0; j < 4; ++j) ss += (v[q][j].x * v[q][j].x + v[q][j].y * v[q][j].y) + (v[q][j].z * v[q][j].z + v[q][j].w * v[q][j].w);
            const float rs = 1.0f / sqrtf(wave_sum(ss) * (1.f / DM) + EPS);
            if (row < MTOK) { const int b = row >> 12;
#pragma unroll
                for (int j = 0; j < 4; ++j) { const int col = (lane + 64 * j) * 4;
                    const f32x4 g4 = *(const f32x4*)(gvec + col), s4 = *(const f32x4*)(mod + b * MODW + sc_off + col), h4 = *(const f32x4*)(mod + b * MODW + sh_off + col);
                    const f32x4 y = (v[q][j] * rs) * g4 * (s4 + 1.0f) + h4; u32x2 o; o.x = cvt_pk_bf16(y.x, y.y); o.y = cvt_pk_bf16(y.z, y.w);
                    *(u32x2*)(H + (size_t)row * DM + col) = o; } }
        }
    }
}

struct EpiProj {
    static constexpr bool PERM = true, AFTER_DRAIN = false;
    unsigned char* ws; const float *qa, *ka, *qb, *kb;
    __device__ __forceinline__ void operator()(const f32x4 (&acc)[2][2][4][2], const Unit& u, int wr, int wc, int fr, int fq) const {
        const int G = u.pn * 4 + wc;
        if (G >= 46) return;
        int kind = 0, ld = 512, coloff = 0; unsigned char* base = ws; const float* gn = nullptr; float scale = 1.f;
        if (G < 8) { base = ws + WS_AQ; coloff = 64 * G; gn = qa; scale = QSCALE; }
        else if (G < 16) { base = ws + WS_AK; coloff = 64 * (G - 8); gn = ka; }
        else if (G < 24) { base = ws + WS_AV; coloff = 64 * (G - 16); }
        else if (G < 32) { base = ws + WS_BQ; coloff = 64 * (G - 24); gn = qb; scale = QSCALE; }
        else if (G < 34) { base = ws + WS_BK; ld = 128; coloff = 64 * (G - 32); gn = kb; }
        else if (G < 36) { base = ws + WS_BV; ld = 128; coloff = 64 * (G - 34); }
        else if (G < 44) { base = ws + WS_IQ; kind = 1; coloff = 64 * (G - 36); }
        else if (G == 44) { base = ws + WS_IK; kind = 1; ld = 64; }
        else { base = ws + WS_IW; kind = 2; }
        const int row0 = u.pm * 256 + wr * 64 + fr;
        f32x4 gv[2][2];
#pragma unroll
        for (int bj = 0; bj < 2; ++bj)
#pragma unroll
            for (int n = 0; n < 2; ++n) { gv[bj][n] = gn ? *(const f32x4*)(gn + 32 * bj + 8 * fq + 4 * n) : (f32x4){1.f, 1.f, 1.f, 1.f}; gv[bj][n] = gv[bj][n] * scale; }
#pragma unroll
        for (int ai = 0; ai < 2; ++ai)
#pragma unroll
            for (int m = 0; m < 4; ++m) {
                const size_t row = (size_t)(row0 + 128 * ai + 16 * m);
                float rs = 1.f;
                if (gn) { float ss = 0.f;
#pragma unroll
                    for (int bj = 0; bj < 2; ++bj)
#pragma unroll
                        for (int n = 0; n < 2; ++n) { const f32x4 v = acc[ai][bj][m][n]; ss += (v.x * v.x + v.y * v.y) + (v.z * v.z + v.w * v.w); }
                    ss += __shfl_xor(ss, 16); ss += __shfl_xor(ss, 32);
                    rs = __builtin_amdgcn_rsqf(ss * (1.f / 64.f) + EPS); }
                if (kind == 2) { if (fq == 0) { *(f32x4*)((float*)base + row * 8) = acc[ai][0][m][0] * 0.04419417382415922f; *(f32x4*)((float*)base + row * 8 + 4) = acc[ai][0][m][1] * 0.04419417382415922f; } }
                else {
#pragma unroll
                    for (int bj = 0; bj < 2; ++bj) { const f32x4 v0 = acc[ai][bj][m][0] * rs * gv[bj][0], v1 = acc[ai][bj][m][1] * rs * gv[bj][1]; u32x4 w;
                        if (kind == 0) { w.x = cvt_pk_bf16(v0.x, v0.y); w.y = cvt_pk_bf16(v0.z, v0.w); w.z = cvt_pk_bf16(v1.x, v1.y); w.w = cvt_pk_bf16(v1.z, v1.w); }
                        else { w.x = pk_f16(v0.x, v0.y); w.y = pk_f16(v0.z, v0.w); w.z = pk_f16(v1.x, v1.y); w.w = pk_f16(v1.z, v1.w); }
                        *(u32x4*)((bf16_t*)base + row * ld + coloff + 32 * bj + 8 * fq) = w; }
                }
            }
    }
};
struct EpiOut {
    static constexpr bool PERM = true, AFTER_DRAIN = false;
    const float* x; const float* gate; float* out;
    __device__ __forceinline__ void operator()(const f32x4 (&acc)[2][2][4][2], const Unit& u, int wr, int wc, int fr, int fq) const {
        const int row0 = u.pm * 256 + wr * 64 + fr, col0 = u.pn * 256 + wc * 32 + 8 * fq;
#pragma unroll
        for (int ai = 0; ai < 2; ++ai)
#pragma unroll
            for (int m = 0; m < 4; ++m) { const int row = row0 + 128 * ai + 16 * m, b = row >> 12;
#pragma unroll
                for (int bj = 0; bj < 2; ++bj)
#pragma unroll
                    for (int n = 0; n < 2; ++n) { const int col = col0 + 128 * bj + 4 * n; const size_t off = (size_t)row * DM + col;
                        const f32x4 g = *(const f32x4*)(gate + b * MODW + col), xv = *(const f32x4*)(x + off);
                        *(f32x4*)(out + off) = xv + g * acc[ai][bj][m][n]; } }
    }
};
struct EpiUp {
    static constexpr bool PERM = false, AFTER_DRAIN = false;
    bf16_t* U;
    __device__ __forceinline__ void operator()(const f32x4 (&acc)[2][2][4][2], const Unit& u, int wr, int wc, int fr, int fq) const {
        const int row0 = u.pm * 256 + wr * 64 + fr, col0 = u.pn * 256 + wc * 32 + 4 * fq;
#pragma unroll
        for (int ai = 0; ai < 2; ++ai)
#pragma unroll
            for (int m = 0; m < 4; ++m) { const size_t row = (size_t)(row0 + 128 * ai + 16 * m);
#pragma unroll
                for (int bj = 0; bj < 2; ++bj)
#pragma unroll
                    for (int n = 0; n < 2; ++n) { const f32x4 v = acc[ai][bj][m][n]; u32x2 w; w.x = cvt_pk_bf16(v.x, v.y); w.y = cvt_pk_bf16(v.z, v.w);
                        *(u32x2*)(U + row * NUP + col0 + 128 * bj + 16 * n) = w; } }
    }
};
constexpr int HALO_OFF = 131072;
__device__ __forceinline__ f32x4 dpp_ror(const f32x4 v, const int which) {
    f32x4 r;
    if (which == 1) { r.x = __int_as_float(__builtin_amdgcn_update_dpp(0, __float_as_int(v.x), 0x121, 0xf, 0xf, false)); r.y = __int_as_float(__builtin_amdgcn_update_dpp(0, __float_as_int(v.y), 0x121, 0xf, 0xf, false));
                      r.z = __int_as_float(__builtin_amdgcn_update_dpp(0, __float_as_int(v.z), 0x121, 0xf, 0xf, false)); r.w = __int_as_float(__builtin_amdgcn_update_dpp(0, __float_as_int(v.w), 0x121, 0xf, 0xf, false)); }
    else { r.x = __int_as_float(__builtin_amdgcn_update_dpp(0, __float_as_int(v.x), 0x122, 0xf, 0xf, false)); r.y = __int_as_float(__builtin_amdgcn_update_dpp(0, __float_as_int(v.y), 0x122, 0xf, 0xf, false));
           r.z = __int_as_float(__builtin_amdgcn_update_dpp(0, __float_as_int(v.z), 0x122, 0xf, 0xf, false)); r.w = __int_as_float(__builtin_amdgcn_update_dpp(0, __float_as_int(v.w), 0x122, 0xf, 0xf, false)); }
    return r;
}
struct EpiUpConv {
    static constexpr bool PERM = true, AFTER_DRAIN = false;
    bf16_t* Gout; const float* cw; const float* cb; LAS float* halo;
    __device__ __forceinline__ void operator()(const f32x4 (&acc)[2][2][4][2], const Unit& u, int wr, int wc, int fr_, int fq_) const {
        int fr = fr_, fq = fq_; asm volatile("" : "+v"(fr), "+v"(fq));
        if (fr >= 14) {
#pragma unroll
            for (int ai = 0; ai < 2; ++ai)
#pragma unroll
                for (int bj = 0; bj < 2; ++bj)
#pragma unroll
                    for (int n = 0; n < 2; ++n) *(LAS f32x4*)(halo + ((2 * ai + wr) * 2 + (fr - 14)) * 256 + 128 * bj + 32 * wc + 8 * fq + 4 * n) = acc[ai][bj][3][n];
        }
        asm volatile("s_waitcnt lgkmcnt(0)" ::: "memory"); __builtin_amdgcn_s_barrier(); asm volatile("" ::: "memory");
        const int R0 = u.pm * 254 - 2;
#pragma unroll
        for (int n = 0; n < 2; ++n) {
            const int cr = u.pn * 128 + wc * 32 + 8 * fq + 4 * n;
            const f32x4 g0 = *(const f32x4*)(cw + cr), g1 = *(const f32x4*)(cw + NUP + cr), g2 = *(const f32x4*)(cw + 2 * NUP + cr), gb = *(const f32x4*)(cb + cr);
            const f32x4 v0 = *(const f32x4*)(cw + DFF + cr), v1 = *(const f32x4*)(cw + NUP + DFF + cr), v2 = *(const f32x4*)(cw + 2 * NUP + DFF + cr), vb = *(const f32x4*)(cb + DFF + cr);
#pragma unroll
            for (int ai = 0; ai < 2; ++ai) {
                const int seg = 2 * ai + wr;
                f32x4 pr1[2], pr2[2];
#pragma unroll
                for (int bj = 0; bj < 2; ++bj) {
                    pr1[bj] = (f32x4){0.f, 0.f, 0.f, 0.f}; pr2[bj] = (f32x4){0.f, 0.f, 0.f, 0.f};
                    if (seg > 0) { const LAS float* hp = halo + ((seg - 1) * 2) * 256 + 128 * bj + 32 * wc + 8 * fq + 4 * n;
                        pr1[bj] = *(const LAS f32x4*)(hp + 256); pr2[bj] = *(const LAS f32x4*)(hp + ((fr & 1) ? 256 : 0)); }
                }
#pragma unroll
                for (int m = 0; m < 4; ++m) {
                    const int r = 128 * ai + 64 * wr + 16 * m + fr, R = R0 + r, t = R & (SEQ - 1);
                    f32x4 y[2];
#pragma unroll
                    for (int bj = 0; bj < 2; ++bj) {
                        const f32x4 X = acc[ai][bj][m][n]; const f32x4 r1 = dpp_ror(X, 1), r2 = dpp_ror(X, 2);
                        f32x4 p1 = (fr == 0) ? pr1[bj] : r1, p2 = (fr < 2) ? pr2[bj] : r2;
                        pr1[bj] = r1; pr2[bj] = r2;
                        if (t == 0) p1 = (f32x4){0.f, 0.f, 0.f, 0.f};
                        if (t <= 1) p2 = (f32x4){0.f, 0.f, 0.f, 0.f};
                        y[bj] = bj == 0 ? (gb + g0 * p2 + g1 * p1 + g2 * X) : (vb + v0 * p2 + v1 * p1 + v2 * X);
                    }
                    f32x4 o;
                    o.x = y[0].x * __builtin_amdgcn_rcpf(1.f + __builtin_amdgcn_exp2f(-LOG2E * y[0].x)) * y[1].x; o.y = y[0].y * __builtin_amdgcn_rcpf(1.f + __builtin_amdgcn_exp2f(-LOG2E * y[0].y)) * y[1].y;
                    o.z = y[0].z * __builtin_amdgcn_rcpf(1.f + __builtin_amdgcn_exp2f(-LOG2E * y[0].z)) * y[1].z; o.w = y[0].w * __builtin_amdgcn_rcpf(1.f + __builtin_amdgcn_exp2f(-LOG2E * y[0].w)) * y[1].w;
                    if (r >= 2 && R < MTOK) { u32x2 w; w.x = cvt_pk_bf16(o.x, o.y); w.y = cvt_pk_bf16(o.z, o.w); *(u32x2*)(Gout + (size_t)R * DFF + cr) = w; }
                }
            }
        }
    }
};
struct EpiDown {
    static constexpr bool PERM = true, AFTER_DRAIN = false;
    const float* gate; float* out; int rowoff;
    __device__ __forceinline__ void operator()(const f32x4 (&acc)[2][2][4][2], const Unit& u, int wr, int wc, int fr, int fq) const {
        const int row0 = rowoff + u.pm * 256 + wr * 64 + fr, col0 = u.pn * 256 + wc * 32 + 8 * fq;
#pragma unroll
        for (int ai = 0; ai < 2; ++ai)
#pragma unroll
            for (int m = 0; m < 4; ++m) { const int row = row0 + 128 * ai + 16 * m, b = row >> 12;
#pragma unroll
                for (int bj = 0; bj < 2; ++bj)
#pragma unroll
                    for (int n = 0; n < 2; ++n) { const int col = col0 + 128 * bj + 4 * n; const size_t off = (size_t)row * DM + col;
                        const f32x4 g = *(const f32x4*)(gate + b * MODW + col), xv = *(const f32x4*)(out + off);
                        *(f32x4*)(out + off) = xv + g * acc[ai][bj][m][n]; } }
    }
};

__device__ __forceinline__ void unpack8(const u32x4 w, float* f) {
    f[0] = __uint_as_float(w.x << 16); f[1] = __uint_as_float(w.x & 0xffff0000u); f[2] = __uint_as_float(w.y << 16); f[3] = __uint_as_float(w.y & 0xffff0000u);
    f[4] = __uint_as_float(w.z << 16); f[5] = __uint_as_float(w.z & 0xffff0000u); f[6] = __uint_as_float(w.w << 16); f[7] = __uint_as_float(w.w & 0xffff0000u);
}
__device__ __forceinline__ void conv_phase(const Params& p, const bf16_t* U, bf16_t* Gb, int wv) {
    constexpr int NCH = DFF / 8, NTASK = (MHALF / 32) * NCH;
    const int tid = otid(wv);
    for (int task = blockIdx.x * 512 + tid; task < NTASK; task += gridDim.x * 512) {
        const int ch = task % NCH, strip = task / NCH, r0 = strip * 32, col = ch * 8;
        float wg[3][8], wv[3][8], bg[8], bv[8];
#pragma unroll
        for (int j = 0; j < 3; ++j)
#pragma unroll
            for (int e = 0; e < 8; ++e) { wg[j][e] = p.conv_w[j * NUP + col + e]; wv[j][e] = p.conv_w[j * NUP + DFF + col + e]; }
#pragma unroll
        for (int e = 0; e < 8; ++e) { bg[e] = p.conv_b[col + e]; bv[e] = p.conv_b[DFF + col + e]; }
        float g2[8], g1[8], v2[8], v1[8];
        if ((r0 & (SEQ - 1)) == 0) {
#pragma unroll
            for (int e = 0; e < 8; ++e) { g2[e] = 0.f; g1[e] = 0.f; v2[e] = 0.f; v1[e] = 0.f; }
        } else {
            unpack8(*(const u32x4*)(U + (size_t)(r0 - 2) * NUP + col), g2); unpack8(*(const u32x4*)(U + (size_t)(r0 - 1) * NUP + col), g1);
            unpack8(*(const u32x4*)(U + (size_t)(r0 - 2) * NUP + DFF + col), v2); unpack8(*(const u32x4*)(U + (size_t)(r0 - 1) * NUP + DFF + col), v1);
        }
        for (int r = 0; r < 32; ++r) {
            float g0[8], v0[8], o[8];
            unpack8(*(const u32x4*)(U + (size_t)(r0 + r) * NUP + col), g0); unpack8(*(const u32x4*)(U + (size_t)(r0 + r) * NUP + DFF + col), v0);
#pragma unroll
            for (int e = 0; e < 8; ++e) {
                const float yg = bg[e] + wg[0][e] * g2[e] + wg[1][e] * g1[e] + wg[2][e] * g0[e];
                const float yv = bv[e] + wv[0][e] * v2[e] + wv[1][e] * v1[e] + wv[2][e] * v0[e];
                o[e] = yg / (1.f + __expf(-yg)) * yv;
                g2[e] = g1[e]; g1[e] = g0[e]; v2[e] = v1[e]; v1[e] = v0[e]; }
            u32x4 w; w.x = cvt_pk_bf16(o[0], o[1]); w.y = cvt_pk_bf16(o[2], o[3]); w.z = cvt_pk_bf16(o[4], o[5]); w.w = cvt_pk_bf16(o[6], o[7]);
            *(u32x4*)(Gb + (size_t)(r0 + r) * DFF + col) = w;
        }
    }
}
#ifndef REPM
#define REPM 1
#endif
#ifndef REPK
#define REPK 1
#endif
#ifndef REPT
#define REPT 1
#endif
#ifndef REPA
#define REPA 1
#endif
#ifndef REPB
#define REPB 1
#endif
#ifndef PB
#define PB 7
#endif

constexpr int A_KROW = 272, A_VROW = 320, A_KBUF = 64 * A_KROW, A_VBUF = 64 * A_VROW, A_STG = A_KBUF + A_VBUF;
constexpr int A_TOFF = 2 * A_STG, A_LOFF = A_TOFF + 1280;
__device__ __forceinline__ void attnA_phase(const Params& p, LAS unsigned char* lds, int wv) {
    const int tid = otid(wv), lane = tid & 63, wid = __builtin_amdgcn_readfirstlane(tid >> 6), r32 = lane & 31, hi = lane >> 5;
    const int c = wid >> 2, qg = wid & 3;
    float lam; { float a = p.lam[lane] * p.lam[64 + lane], b2 = p.lam[128 + lane] * p.lam[192 + lane]; a = wave_sum(a); b2 = wave_sum(b2); lam = expf(a) - expf(b2) + 0.2f; }
    const float Mq = wave_max(fabsf(p.qna[lane])), Mk = wave_max(fabsf(p.kna[lane]));
    const unsigned char* AQ = p.ws + WS_AQ; const unsigned char* AK = p.ws + WS_AK; const unsigned char* AV = p.ws + WS_AV;
    bf16_t* CAT = (bf16_t*)(p.ws + WS_CAT);
    LAS float* T = (LAS float*)(lds + A_TOFF);
    LAS float* linv = (LAS float*)(lds + A_LOFF) + wid * 32;
    const int vblkA = (gridDim.x == 256) ? (int)((blockIdx.x & 7) * 32 + (blockIdx.x >> 3)) : (int)blockIdx.x;
    for (int ui = vblkA; ui < 2048 * REPA; ui += gridDim.x) {
        const int v = ui & 255, rnd = (ui >> 8) & 7, bh = v >> 2, pp = (v & 3) + 4 * (rnd >> 1), qb = (rnd & 1) ? 31 - pp : pp;
        const int b = bh >> 2, h = bh & 3, q0 = qb * 128, NT = 2 * qb + 2;
        const size_t tokbase = (size_t)b * SEQ;
        if (tid < 320) { const int d = 223 - tid;
            T[tid] = d < 0 ? -1e30f : (p.rel_bias[t5_bucket(min(d, 127)) * 12 + h] - p.rel_bias[31 * 12 + h]) * LOG2E; }
        bf16x8 qf[4];
        { const unsigned char* Qp = AQ + (tokbase + q0 + 32 * qg + r32) * 1024 + h * 256 + c * 128 + hi * 16;
#pragma unroll
          for (int ds = 0; ds < 4; ++ds) qf[ds] = *(const bf16x8*)(Qp + 32 * ds); }
        const int qpos = q0 + 32 * qg + r32, qw0 = q0 + 32 * qg;
        f32x16 O[4];
#pragma unroll
        for (int e = 0; e < 4; ++e)
#pragma unroll
            for (int r = 0; r < 16; ++r) O[e][r] = 0.f;
        float l = 0.f;
        u32x4 kreg[2], vreg[2];
        const int srow = tid >> 4, sch = tid & 15;
#define A_LOAD(t) do { _Pragma("unroll") for (int i = 0; i < 2; ++i) { const size_t g = (tokbase + 64 * (t) + srow + 32 * i) * 1024 + h * 256 + sch * 16; \
        kreg[i] = *(const u32x4*)(AK + g); vreg[i] = *(const u32x4*)(AV + g); } } while (0)
#define A_WRITE(st) do { _Pragma("unroll") for (int i = 0; i < 2; ++i) { *(LAS u32x4*)(lds + (st) * A_STG + (srow + 32 * i) * A_KROW + sch * 16) = kreg[i]; \
        *(LAS u32x4*)(lds + (st) * A_STG + A_KBUF + (srow + 32 * i) * A_VROW + sch * 16) = vreg[i]; } } while (0)
        A_LOAD(0); A_WRITE(0);
        __syncthreads();
        for (int t = 0; t < NT; ++t) {
            if (t + 1 < NT) A_LOAD(t + 1);
            const int k0 = 64 * t;
            if (k0 <= qw0 + 31) {
                const bool near = (k0 + 63 + 113 > qw0);
                const LAS unsigned char* Kb = lds + (t & 1) * A_STG; const LAS unsigned char* Vb = Kb + A_KBUF;
                f32x16 s0, s1;
#pragma unroll
                for (int r = 0; r < 16; ++r) { s0[r] = 0.f; s1[r] = 0.f; }
                {
                    const LAS unsigned char* kp0 = Kb + (pi32(r32)) * A_KROW + c * 128 + hi * 16;
                    const LAS unsigned char* kp1 = kp0 + 32 * A_KROW;
#pragma unroll
                    for (int ds = 0; ds < 4; ++ds) { const bf16x8 ka = *(const LAS bf16x8*)(kp0 + 32 * ds), kb = *(const LAS bf16x8*)(kp1 + 32 * ds);
                        s0 = __builtin_amdgcn_mfma_f32_32x32x16_bf16(ka, qf[ds], s0, 0, 0, 0); s1 = __builtin_amdgcn_mfma_f32_32x32x16_bf16(kb, qf[ds], s1, 0, 0, 0); }
                }
                __builtin_amdgcn_sched_barrier(0);
                float sacc = 0.f;
#define A_SOFTMAX(S, HF) do { \
                    if (!near) { _Pragma("unroll") for (int r = 0; r < 16; ++r) S[r] = __builtin_amdgcn_exp2f(S[r]); } \
                    else { int ib = 223 - (qpos - k0 - 8 * hi - 32 * (HF)); asm volatile("" : "+v"(ib)); const LAS float* tp = T + ib; \
                        _Pragma("unroll") for (int r = 0; r < 16; ++r) S[r] = __builtin_amdgcn_exp2f(S[r] + tp[16 * (r >> 3) + (r & 7)]); } \
                    _Pragma("unroll") for (int r = 0; r < 16; ++r) sacc += S[r]; } while (0)
#define A_PV(S, HF) do { \
                    _Pragma("unroll") for (int jj = 0; jj < 2; ++jj) { \
                        const int j = 2 * (HF) + jj, rb = 8 * jj; \
                        u32x4 pw; pw.x = cvt_pk_bf16(S[rb], S[rb + 1]); pw.y = cvt_pk_bf16(S[rb + 2], S[rb + 3]); pw.z = cvt_pk_bf16(S[rb + 4], S[rb + 5]); pw.w = cvt_pk_bf16(S[rb + 6], S[rb + 7]); \
                        const bf16x8 pa = __builtin_bit_cast(bf16x8, pw); \
                        const LAS unsigned char* vp = Vb + (16 * j + 8 * hi + ((lane & 15) >> 2)) * A_VROW + (16 * ((lane >> 4) & 1) + 4 * (lane & 3)) * 2; \
                        _Pragma("unroll") for (int eb = 0; eb < 4; ++eb) { \
                            const s16x4 lo = vtr(vp + eb * 64), hh = vtr(vp + 4 * A_VROW + eb * 64); \
                            const bf16x8 vf = (bf16x8){lo[0], lo[1], lo[2], lo[3], hh[0], hh[1], hh[2], hh[3]}; \
                            O[eb] = __builtin_amdgcn_mfma_f32_32x32x16_bf16(pa, vf, O[eb], 0, 0, 0); } } } while (0)
                A_SOFTMAX(s0, 0);
                __builtin_amdgcn_sched_barrier(0);
                A_PV(s0, 0);
                A_SOFTMAX(s1, 1);
                __builtin_amdgcn_sched_barrier(0);
                A_PV(s1, 1);
#undef A_SOFTMAX
#undef A_PV
                l += sacc;
            }
            if (t + 1 < NT) A_WRITE((t + 1) & 1);
            __syncthreads();
        }
#undef A_LOAD
#undef A_WRITE
        l += __shfl_xor(l, 32);
        if (hi == 0) linv[r32] = (c == 1 ? lam : 1.f) / l;
        LAS float* comb = (LAS float*)lds + qg * (32 * 128);
        float f[16];
#pragma unroll
        for (int r = 0; r < 16; ++r) f[r] = linv[crow(r, hi)];
#pragma unroll
        for (int eb = 0; eb < 4; ++eb)
#pragma unroll
            for (int r = 0; r < 16; ++r) O[eb][r] *= f[r];
        if (c == 1) {
#pragma unroll
            for (int eb = 0; eb < 4; ++eb)
#pragma unroll
                for (int r = 0; r < 16; ++r) comb[crow(r, hi) * 128 + 32 * eb + r32] = O[eb][r];
        }
        __syncthreads();
        if (c == 0) {
            float gl[4];
#pragma unroll
            for (int eb = 0; eb < 4; ++eb) gl[eb] = p.subln[32 * eb + r32] * 0.8f;
#pragma unroll
            for (int r = 0; r < 16; ++r) {
                const int qr = crow(r, hi); float ss = 0.f;
#pragma unroll
                for (int eb = 0; eb < 4; ++eb) { O[eb][r] -= comb[qr * 128 + 32 * eb + r32]; ss += O[eb][r] * O[eb][r]; }
                ss += __shfl_xor(ss, 1); ss += __shfl_xor(ss, 2); ss += __shfl_xor(ss, 4); ss += __shfl_xor(ss, 8); ss += __shfl_xor(ss, 16);
                const float rs = 1.0f / sqrtf(ss * (1.f / 128.f) + EPS);
                bf16_t* op = CAT + (tokbase + q0 + 32 * qg + qr) * 1024 + h * 128 + r32;
#pragma unroll
                for (int eb = 0; eb < 4; ++eb) op[32 * eb] = (bf16_t)(cvt_pk_bf16(O[eb][r] * rs * gl[eb], 0.f) & 0xffffu);
            }
        }
        __syncthreads();
    }
}

#ifndef SKIP
#define SKIP 0
#endif
constexpr int B_QROW = 1040;
constexpr int B_HIST = 66560, B_HROW = 257;
constexpr int B_TOFF = B_HIST + 64 * B_HROW * 4;
constexpr int B_DT = 75776;
constexpr int B_INFO = B_TOFF + 4096;
constexpr int B_LINV = B_INFO + 1024;
constexpr int B_MASK = 98304, B_MROW = 130;
__device__ __forceinline__ unsigned ord_key(float f) { const unsigned u = __float_as_uint(f); return u ^ ((u >> 31) ? 0xffffffffu : 0x80000000u); }
__device__ __forceinline__ void phaseB(const Params& p, LAS unsigned char* lds, int wv) {
    const _Float16* IQ = (const _Float16*)(p.ws + WS_IQ); const _Float16* IK = (const _Float16*)(p.ws + WS_IK); const float* IW = (const float*)(p.ws + WS_IW);
    const unsigned char* BQ = p.ws + WS_BQ; const unsigned char* BK = p.ws + WS_BK; const unsigned char* BV = p.ws + WS_BV;
    bf16_t* CAT = (bf16_t*)(p.ws + WS_CAT);
    float* SC = (float*)(p.ws + WS_SC + (size_t)blockIdx.x * MiB);
    LAS float* Tb = (LAS float*)(lds + B_DT);
    LAS unsigned* hist = (LAS unsigned*)(lds + B_HIST);
    LAS unsigned* pfx = (LAS unsigned*)(lds + B_INFO); LAS int* needv = (LAS int*)(lds + B_INFO + 256); LAS unsigned* ceqv = (LAS unsigned*)(lds + B_INFO + 512); LAS int* cutv = (LAS int*)(lds + B_INFO + 768);
    const int vblkB = (gridDim.x == 256) ? (int)((blockIdx.x & 7) * 32 + (blockIdx.x >> 3)) : (int)blockIdx.x;
    for (int ui = vblkB; ui < 1024 * REPB; ui += gridDim.x) {
        const int v = ui & 255, rnd = (ui >> 8) & 3, b = v >> 4, pp = (v & 15) + 16 * (rnd >> 1), qb = (rnd & 1) ? 63 - pp : pp;
        const int q0 = 64 * qb, NT = qb + 1;
        const size_t tokbase = (size_t)b * SEQ;
        {
        const int tid = otid(wv);
        const int lane = tid & 63, wid = __builtin_amdgcn_readfirstlane(tid >> 6), r32 = lane & 31, hi = lane >> 5; (void)r32; (void)hi; (void)wid;
#pragma unroll
        for (int i = 0; i < 8; ++i) { const int id = tid + 512 * i, row = id >> 6, ch = id & 63;
            *(LAS u32x4*)(lds + row * B_QROW + ch * 16) = *(const u32x4*)((const unsigned char*)IQ + (tokbase + q0 + row) * 1024 + ch * 16); }
        for (int i = tid; i < 64 * B_HROW; i += 512) hist[i] = 0u;
        if (tid < 64) { const int n = q0 + tid + 1; pfx[tid] = 0u; needv[tid] = (n > 256) ? 256 : -1; ceqv[tid] = 0u; cutv[tid] = 4096; }
        __syncthreads();
#if !(SKIP & 1)
        {
            const int qg = wid & 1, ks = wid >> 1;
            const float* wp = IW + (tokbase + q0 + 32 * qg + r32) * 8;
            const LAS unsigned char* qp = lds + (32 * qg + r32) * B_QROW + hi * 16;
            LAS unsigned* hrow = hist + (32 * qg + r32) * B_HROW;
            const int tq = q0 + 32 * qg + r32;
#pragma unroll 1
            for (int rep1 = 0; rep1 < REPK; ++rep1)
#pragma unroll 1
            for (int kt = ks; kt < NT; kt += 4) {
                const int k0 = 64 * kt;
                f16x8 kf[2][4];
#pragma unroll
                for (int hf = 0; hf < 2; ++hf)
#pragma unroll
                    for (int ds = 0; ds < 4; ++ds) kf[hf][ds] = *(const f16x8*)(IK + (tokbase + k0 + 32 * hf + pi32(r32)) * 64 + 16 * ds + 8 * hi);
                f32x16 acc0, acc1;
#pragma unroll
                for (int r = 0; r < 16; ++r) { acc0[r] = 0.f; acc1[r] = 0.f; }
#pragma unroll 2
                for (int hh = 0; hh < 8; ++hh) {
                    const float wh = wp[hh];
                    f32x16 s0, s1;
#pragma unroll
                    for (int r = 0; r < 16; ++r) { s0[r] = 0.f; s1[r] = 0.f; }
#pragma unroll
                    for (int ds = 0; ds < 4; ++ds) { const f16x8 qfr = *(const LAS f16x8*)(qp + hh * 128 + ds * 32);
                        s0 = __builtin_amdgcn_mfma_f32_32x32x16_f16(kf[0][ds], qfr, s0, 0, 0, 0); s1 = __builtin_amdgcn_mfma_f32_32x32x16_f16(kf[1][ds], qfr, s1, 0, 0, 0); }
#pragma unroll
                    for (int r = 0; r < 16; ++r) { acc0[r] += wh * fmaxf(s0[r], 0.f); acc1[r] += wh * fmaxf(s1[r], 0.f); }
                }
                float* sp = SC + (size_t)(32 * qg + r32) * SEQ + k0 + 8 * hi;
                *(f32x4*)(sp) = (f32x4){acc0[0], acc0[1], acc0[2], acc0[3]}; *(f32x4*)(sp + 4) = (f32x4){acc0[4], acc0[5], acc0[6], acc0[7]};
                *(f32x4*)(sp + 16) = (f32x4){acc0[8], acc0[9], acc0[10], acc0[11]}; *(f32x4*)(sp + 20) = (f32x4){acc0[12], acc0[13], acc0[14], acc0[15]};
                *(f32x4*)(sp + 32) = (f32x4){acc1[0], acc1[1], acc1[2], acc1[3]}; *(f32x4*)(sp + 36) = (f32x4){acc1[4], acc1[5], acc1[6], acc1[7]};
                *(f32x4*)(sp + 48) = (f32x4){acc1[8], acc1[9], acc1[10], acc1[11]}; *(f32x4*)(sp + 52) = (f32x4){acc1[12], acc1[13], acc1[14], acc1[15]};
                if (q0 + 63 > 255 && rep1 == 0) {
                    int e0 = k0 + 8 * hi; asm volatile("" : "+v"(e0));
#pragma unroll
                    for (int r = 0; r < 16; ++r) { const int kp0 = e0 + 16 * (r >> 3) + (r & 7);
                        if (kp0 <= tq) atomicAdd((unsigned*)&hrow[ord_key(acc0[r]) >> 24], 1u);
                        if (kp0 + 32 <= tq) atomicAdd((unsigned*)&hrow[ord_key(acc1[r]) >> 24], 1u); }
                }
            }
        }
#endif
        }
        __builtin_amdgcn_fence(__ATOMIC_RELEASE, "workgroup");
        __syncthreads();
        __builtin_amdgcn_fence(__ATOMIC_ACQUIRE, "workgroup");
        {
        const int tid = otid(wv);
        const int lane = tid & 63, wid = __builtin_amdgcn_readfirstlane(tid >> 6);
#pragma unroll 1
        for (int rr = 0; rr < 8; ++rr) {
            const int row = wid * 8 + rr; const int need = needv[row];
            if (need > 0) {
                const LAS unsigned* hr = hist + row * B_HROW + 4 * lane;
                const unsigned c0 = hr[0], c1 = hr[1], c2 = hr[2], c3 = hr[3];
                const unsigned sl = c0 + c1 + c2 + c3; unsigned suf = sl;
#pragma unroll
                for (int o = 1; o < 64; o <<= 1) { const unsigned tv = __shfl_down(suf, o); if (lane + o < 64) suf += tv; }
                unsigned cum = suf - sl; int fbin = -1; unsigned fabove = 0u, fcnt = 0u;
                { if ((int)cum < need && (int)(cum + c3) >= need) { fbin = 4 * lane + 3; fabove = cum; fcnt = c3; } cum += c3;
                  if ((int)cum < need && (int)(cum + c2) >= need) { fbin = 4 * lane + 2; fabove = cum; fcnt = c2; } cum += c2;
                  if ((int)cum < need && (int)(cum + c1) >= need) { fbin = 4 * lane + 1; fabove = cum; fcnt = c1; } cum += c1;
                  if ((int)cum < need && (int)(cum + c0) >= need) { fbin = 4 * lane + 0; fabove = cum; fcnt = c0; } }
                if (fbin >= 0) { pfx[row] = (unsigned)fbin << 24; needv[row] = need - (int)fabove; ceqv[row] = fcnt; }
            }
        }
        }
        __syncthreads();
        {
            const int tid = otid(wv);
            for (int i = tid; i < 2560; i += 512) { const int hh = i / 320, d = 223 - (i - 320 * hh);
                Tb[i] = d < 0 ? -1e30f : (p.rel_bias[t5_bucket(min(d, 127)) * 12 + 4 + hh] - p.rel_bias[31 * 12 + 4 + hh]) * LOG2E; }
        }
        {
        const int tid = otid(wv);
        const int lane = tid & 63, wid = __builtin_amdgcn_readfirstlane(tid >> 6);
        LAS unsigned* wh = (LAS unsigned*)lds + wid * 320;
        const int nwords = 2 * NT;
        u32x4 bufA[16], bufB[16];
#define ROW_LOAD(buf, rowi) do { const float* sr_ = SC + (size_t)(rowi) * SEQ + 4 * lane; _Pragma("unroll") for (int i = 0; i < 16; ++i) { buf[i] = (u32x4){0u, 0u, 0u, 0u}; if (256 * i <= q0 + 63) buf[i] = *(const u32x4*)(sr_ + 256 * i); } } while (0)
#define OKEY(u) ((u) ^ (((u) >> 31) ? 0xffffffffu : 0x80000000u))
#define ROW_PROC(key, rowi) do { \
            const int row = (rowi), tr = q0 + row; \
            unsigned thr = 0u; int cut = -1; \
            int need = needv[row]; \
            _Pragma("unroll") for (int i = 0; i < 16; ++i) { const int e = 256 * i + 4 * lane; \
                key[i].x = (e <= tr) ? OKEY(key[i].x) : 0u; key[i].y = (e + 1 <= tr) ? OKEY(key[i].y) : 0u; key[i].z = (e + 2 <= tr) ? OKEY(key[i].z) : 0u; key[i].w = (e + 3 <= tr) ? OKEY(key[i].w) : 0u; } \
            if (need > 0) { \
                unsigned prefix = pfx[row]; unsigned cnt = ceqv[row]; bool done = false; \
                if (need == (int)cnt) { thr = prefix - 1u; done = true; } \
                _Pragma("unroll 1") for (int pass = 1; pass < 4 && !done; ++pass) { \
                    const int shift = 24 - 8 * pass; const unsigned msk = 0xffffffffu << (shift + 8); \
                    wh[lane] = 0u; wh[64 + lane] = 0u; wh[128 + lane] = 0u; wh[192 + lane] = 0u; \
                    _Pragma("unroll") for (int i = 0; i < 16; ++i) { \
                        { const unsigned k = key[i].x; atomicAdd((unsigned*)&wh[((k & msk) == prefix) ? ((k >> shift) & 255u) : (256u + lane)], 1u); } \
                        { const unsigned k = key[i].y; atomicAdd((unsigned*)&wh[((k & msk) == prefix) ? ((k >> shift) & 255u) : (256u + lane)], 1u); } \
                        { const unsigned k = key[i].z; atomicAdd((unsigned*)&wh[((k & msk) == prefix) ? ((k >> shift) & 255u) : (256u + lane)], 1u); } \
                        { const unsigned k = key[i].w; atomicAdd((unsigned*)&wh[((k & msk) == prefix) ? ((k >> shift) & 255u) : (256u + lane)], 1u); } } \
                    const unsigned c0 = wh[4 * lane], c1 = wh[4 * lane + 1], c2 = wh[4 * lane + 2], c3 = wh[4 * lane + 3]; \
                    const unsigned sl = c0 + c1 + c2 + c3; unsigned suf = sl; \
                    _Pragma("unroll") for (int o = 1; o < 64; o <<= 1) { const unsigned tv = __shfl_down(suf, o); if (lane + o < 64) suf += tv; } \
                    unsigned cum = suf - sl; int fbin = -1; unsigned fabove = 0u, fcnt = 0u; \
                    { if ((int)cum < need && (int)(cum + c3) >= need) { fbin = 4 * lane + 3; fabove = cum; fcnt = c3; } cum += c3; \
                      if ((int)cum < need && (int)(cum + c2) >= need) { fbin = 4 * lane + 2; fabove = cum; fcnt = c2; } cum += c2; \
                      if ((int)cum < need && (int)(cum + c1) >= need) { fbin = 4 * lane + 1; fabove = cum; fcnt = c1; } cum += c1; \
                      if ((int)cum < need && (int)(cum + c0) >= need) { fbin = 4 * lane + 0; fabove = cum; fcnt = c0; } } \
                    const unsigned long long bm = __ballot(fbin >= 0); const int src = __ffsll((long long)bm) - 1; \
                    const int bin = __shfl(fbin, src); const unsigned above = __shfl(fabove, src); cnt = __shfl(fcnt, src); \
                    prefix |= (unsigned)bin << shift; need -= (int)above; \
                    if (pass < 3 && need == (int)cnt) { thr = prefix - 1u; done = true; } \
                } \
                if (!done) { thr = prefix; cut = 4096; \
                    if (need < (int)cnt) {        \
                        const float* srow = SC + (size_t)row * SEQ; int tbase = 0; \
                        for (int j = 0; j * 64 <= tr; ++j) { const int e = 64 * j + lane; const bool eq = (e <= tr) && (ord_key(srow[e]) == thr); \
                            const unsigned long long be = __ballot(eq); \
                            const int tpos = tbase + (int)__builtin_amdgcn_mbcnt_hi((unsigned)(be >> 32), __builtin_amdgcn_mbcnt_lo((unsigned)be, 0u)); \
                            const unsigned long long bh = __ballot(eq && tpos == need - 1); \
                            if (bh) { cut = 64 * j + (__ffsll((long long)bh) - 1); break; } \
                            tbase += __popcll(be); } \
                    } \
                } \
            } \
            LAS unsigned* mw = (LAS unsigned*)(lds + B_MASK) + row * B_MROW; \
            _Pragma("unroll") for (int i = 0; i < 16; ++i) if (256 * i <= q0 + 63) { const int e = 256 * i + 4 * lane; \
                unsigned nib = 0u; \
                nib |= (key[i].x > thr || (key[i].x == thr && e <= cut)) ? 1u : 0u; nib |= (key[i].y > thr || (key[i].y == thr && e + 1 <= cut)) ? 2u : 0u; \
                nib |= (key[i].z > thr || (key[i].z == thr && e + 2 <= cut)) ? 4u : 0u; nib |= (key[i].w > thr || (key[i].w == thr && e + 3 <= cut)) ? 8u : 0u; \
                unsigned v = nib << (4 * (lane & 7)); v |= __shfl_xor(v, 1); v |= __shfl_xor(v, 2); v |= __shfl_xor(v, 4); \
                const int w = 8 * i + (lane >> 3); if ((lane & 7) == 0 && w < nwords) mw[w] = v; } \
        } while (0)
        ROW_LOAD(bufA, wid * 8);
#pragma unroll 1
        for (int rr = 0; rr < 8; rr += 2) {
            ROW_LOAD(bufB, wid * 8 + rr + 1);
            ROW_PROC(bufA, wid * 8 + rr);
            if (rr + 2 < 8) ROW_LOAD(bufA, wid * 8 + rr + 2);
            ROW_PROC(bufB, wid * 8 + rr + 1);
        }
#undef ROW_LOAD
#undef ROW_PROC
#undef OKEY
        }
        __syncthreads();
#pragma unroll 1
        for (int rep3 = 0; rep3 < ((SKIP & 8) ? 0 : REPT); ++rep3) {
        const int tid = otid(wv);
        const int lane = tid & 63, wid = __builtin_amdgcn_readfirstlane(tid >> 6), r32 = lane & 31, hi = lane >> 5; (void)r32; (void)hi; (void)wid;
            LAS float* linv = (LAS float*)(lds + B_LINV) + wid * 64;
            const int qg = wid & 1, hp = wid >> 1, g = hp >> 1;
            const int qpos = q0 + 32 * qg + r32, qw0 = q0 + 32 * qg;
            const unsigned char* Qp0 = BQ + (tokbase + qpos) * 1024 + (2 * hp) * 128 + hi * 16;
            const LAS unsigned* mrow = (const LAS unsigned*)(lds + B_MASK) + (32 * qg + r32) * B_MROW;
            f32x16 O[2][2];
#pragma unroll
            for (int hh = 0; hh < 2; ++hh)
#pragma unroll
                for (int db = 0; db < 2; ++db)
#pragma unroll
                    for (int r = 0; r < 16; ++r) O[hh][db][r] = 0.f;
            float l0 = 0.f, l1 = 0.f;
            u32x4 kreg[2], vreg[2];
            const int srow_ = tid >> 4, sch = tid & 15;
#define B_LOAD(t) do { _Pragma("unroll") for (int i = 0; i < 2; ++i) { const size_t gofs = (tokbase + 64 * (t) + srow_ + 32 * i) * 256 + sch * 16; \
            kreg[i] = *(const u32x4*)(BK + gofs); vreg[i] = *(const u32x4*)(BV + gofs); } } while (0)
#define B_WRITE(st) do { _Pragma("unroll") for (int i = 0; i < 2; ++i) { *(LAS u32x4*)(lds + (st) * A_STG + (srow_ + 32 * i) * A_KROW + sch * 16) = kreg[i]; \
            *(LAS u32x4*)(lds + (st) * A_STG + A_KBUF + (srow_ + 32 * i) * A_VROW + sch * 16) = vreg[i]; } } while (0)
            B_LOAD(0); B_WRITE(0);
            __syncthreads();
#pragma unroll 1
            for (int t = 0; t < NT; ++t) {
                if (t + 1 < NT) B_LOAD(t + 1);
                const int k0 = 64 * t;
                const bool near = (k0 + 63 + 113 > qw0);
                const LAS unsigned char* Kb = lds + (t & 1) * A_STG; const LAS unsigned char* Vb = Kb + A_KBUF;
                unsigned selm;
                { const unsigned w0 = mrow[2 * t] >> (8 * hi), w1 = mrow[2 * t + 1] >> (8 * hi);
                  selm = (w0 & 0xffu) | ((w0 >> 8) & 0xff00u) | ((w1 & 0xffu) << 16) | ((w1 << 8) & 0xff000000u); }
                bf16x8 qf2[2][4];
#pragma unroll
                for (int hh = 0; hh < 2; ++hh)
#pragma unroll
                    for (int ds = 0; ds < 4; ++ds) qf2[hh][ds] = *(const bf16x8*)(Qp0 + hh * 128 + 32 * ds);
                float sacc0 = 0.f, sacc1 = 0.f;
#pragma unroll
                for (int hf = 0; hf < 2; ++hf) {
                    f32x16 s0, s1;
#pragma unroll
                    for (int r = 0; r < 16; ++r) { const float cm = ((selm >> (16 * hf + r)) & 1u) ? 0.f : -1e30f; s0[r] = cm; s1[r] = cm; }
                    const LAS unsigned char* kp = Kb + (32 * hf + pi32(r32)) * A_KROW + g * 128 + hi * 16;
#pragma unroll
                    for (int ds = 0; ds < 4; ++ds) { const bf16x8 kf = *(const LAS bf16x8*)(kp + 32 * ds);
                        s0 = __builtin_amdgcn_mfma_f32_32x32x16_bf16(kf, qf2[0][ds], s0, 0, 0, 0); s1 = __builtin_amdgcn_mfma_f32_32x32x16_bf16(kf, qf2[1][ds], s1, 0, 0, 0); }
                    if (!near) {
#pragma unroll
                        for (int r = 0; r < 16; ++r) { s0[r] = __builtin_amdgcn_exp2f(s0[r]); s1[r] = __builtin_amdgcn_exp2f(s1[r]); }
                    } else {
                        int ib = 223 - (qpos - k0 - 8 * hi - 32 * hf); asm volatile("" : "+v"(ib));
                        const LAS float* tp0 = Tb + (2 * hp) * 320 + ib; const LAS float* tp1 = tp0 + 320;
#pragma unroll
                        for (int r = 0; r < 16; ++r) { s0[r] = __builtin_amdgcn_exp2f(s0[r] + tp0[16 * (r >> 3) + (r & 7)]); s1[r] = __builtin_amdgcn_exp2f(s1[r] + tp1[16 * (r >> 3) + (r & 7)]); }
                    }
#pragma unroll
                    for (int r = 0; r < 16; ++r) { sacc0 += s0[r]; sacc1 += s1[r]; }
#pragma unroll
                    for (int jj = 0; jj < 2; ++jj) {
                        const int j = 2 * hf + jj, rb = 8 * jj;
                        u32x4 pw0, pw1;
                        pw0.x = cvt_pk_bf16(s0[rb], s0[rb + 1]); pw0.y = cvt_pk_bf16(s0[rb + 2], s0[rb + 3]); pw0.z = cvt_pk_bf16(s0[rb + 4], s0[rb + 5]); pw0.w = cvt_pk_bf16(s0[rb + 6], s0[rb + 7]);
                        pw1.x = cvt_pk_bf16(s1[rb], s1[rb + 1]); pw1.y = cvt_pk_bf16(s1[rb + 2], s1[rb + 3]); pw1.z = cvt_pk_bf16(s1[rb + 4], s1[rb + 5]); pw1.w = cvt_pk_bf16(s1[rb + 6], s1[rb + 7]);
                        const bf16x8 pa0 = __builtin_bit_cast(bf16x8, pw0), pa1 = __builtin_bit_cast(bf16x8, pw1);
                        const LAS unsigned char* vp = Vb + (16 * j + 8 * hi + ((lane & 15) >> 2)) * A_VROW + (g * 64 + 16 * ((lane >> 4) & 1) + 4 * (lane & 3)) * 2;
#pragma unroll
                        for (int db = 0; db < 2; ++db) {
                            const s16x4 lo = vtr(vp + db * 64), hv = vtr(vp + 4 * A_VROW + db * 64);
                            const bf16x8 vf = (bf16x8){lo[0], lo[1], lo[2], lo[3], hv[0], hv[1], hv[2], hv[3]};
                            O[0][db] = __builtin_amdgcn_mfma_f32_32x32x16_bf16(pa0, vf, O[0][db], 0, 0, 0);
                            O[1][db] = __builtin_amdgcn_mfma_f32_32x32x16_bf16(pa1, vf, O[1][db], 0, 0, 0);
                        }
                    }
                    __builtin_amdgcn_sched_barrier(0);
                }
                l0 += sacc0; l1 += sacc1;
                if (t + 1 < NT) B_WRITE((t + 1) & 1);
                __syncthreads();
            }
#undef B_LOAD
#undef B_WRITE
            l0 += __shfl_xor(l0, 32); l1 += __shfl_xor(l1, 32);
            if (hi == 0) { linv[r32] = 1.0f / l0; linv[32 + r32] = 1.0f / l1; }
#pragma unroll
            for (int hh = 0; hh < 2; ++hh)
#pragma unroll
                for (int r = 0; r < 16; ++r) { const int qr = crow(r, hi); const float f = linv[32 * hh + qr];
                    bf16_t* op = CAT + (tokbase + q0 + 32 * qg + qr) * 1024 + 512 + (2 * hp + hh) * 64 + r32;
#pragma unroll
                    for (int db = 0; db < 2; ++db) op[32 * db] = (bf16_t)(cvt_pk_bf16(O[hh][db][r] * f, 0.f) & 0xffffu); }
            if (REPT > 1) __syncthreads();
        }
        __syncthreads();
    }
}
#ifndef REPG1
#define REPG1 1
#endif
#ifndef REPG2
#define REPG2 1
#endif
#ifndef REPG3
#define REPG3 1
#endif
#ifndef PH
#define PH 255
#endif

#define XB_TMO      128
#define XB_XCNT(j)  (256  + 64 * (j))
#define XB_XSUB(j)  (1280 + 64 * (j))
#define XB_XGEN(j)  (2304 + 64 * (j))
#define XB_TOP      3328
#define XB_TOPGEN   3392
#define XCD_BAR_WORDS 3456
#define XB_SPIN_CAP (1u << 18)

__device__ __forceinline__ unsigned xb_ld(unsigned* p)              { return __hip_atomic_load(p, __ATOMIC_RELAXED, __HIP_MEMORY_SCOPE_AGENT); }
__device__ __forceinline__ unsigned xb_add(unsigned* p, unsigned v) { return __hip_atomic_fetch_add(p, v, __ATOMIC_RELAXED, __HIP_MEMORY_SCOPE_AGENT); }
__device__ __forceinline__ unsigned xb_xcc_id() { return (unsigned)__builtin_amdgcn_s_getreg((3 << 11) | 20) & 0xFu; }
#define XB_SPIN(cond, bar) do { unsigned _sp = 0; while (cond) { __builtin_amdgcn_s_sleep(1); \
    if ((++_sp & 255u) == 0u) { if (xb_ld(&(bar)[XB_TMO])) break; if (_sp > XB_SPIN_CAP) { atomicAdd(&(bar)[XB_TMO], 1u); break; } } } } while (0)

struct XcdBarrier {
    unsigned* bar; unsigned x;
    volatile LAS unsigned* st;
};

__device__ __forceinline__ XcdBarrier xcd_barrier_post(unsigned* bar, volatile LAS unsigned* st) {
    XcdBarrier b; b.bar = bar; b.x = xb_xcc_id(); b.st = st;
    if (threadIdx.x == 0) (void)xb_add(&bar[XB_XCNT(b.x)], 1u);
    return b;
}
__device__ __forceinline__ void xcd_barrier_complete(unsigned* bar, unsigned x, unsigned& nloc, unsigned& nx) {
    const unsigned G = gridDim.x * gridDim.y * gridDim.z;
    unsigned sum, cnt, mine, sp = 0u;
    for (;;) {
        sum = 0u; cnt = 0u; mine = 0u;
#pragma unroll
        for (unsigned j = 0; j < 16; ++j) { const unsigned c = xb_ld(&bar[XB_XCNT(j)]); sum += c; cnt += (c > 0u) ? 1u : 0u; mine = (j == x) ? c : mine; }
        if (sum == G) break;
        __builtin_amdgcn_s_sleep(1);
        if ((++sp & 255u) == 0u) { if (xb_ld(&bar[XB_TMO])) break; if (sp > XB_SPIN_CAP) { atomicAdd(&bar[XB_TMO], 1u); break; } }
    }
    nloc = mine > 0u ? mine : 1u; nx = cnt > 0u ? cnt : 1u;
}

__device__ __forceinline__ void xcd_barrier(const XcdBarrier& b) {
    asm volatile("s_waitcnt vmcnt(0)" ::: "memory");
    __syncthreads();
    if (threadIdx.x == 0) {
        unsigned* bar = b.bar;
        __builtin_amdgcn_s_waitcnt(0);
        unsigned nloc = b.st[0], nx = b.st[1];
        if (nloc == 0u) { xcd_barrier_complete(bar, b.x, nloc, nx); b.st[0] = nloc; b.st[1] = nx; }
        const unsigned old = xb_add(&bar[XB_XSUB(b.x)], 1u);
        const unsigned gen = old / nloc;
        if (old + 1u == (gen + 1u) * nloc) {
            __builtin_amdgcn_fence(__ATOMIC_RELEASE, "agent");
            asm volatile("s_waitcnt vmcnt(0)" ::: "memory");
            const unsigned og = xb_add(&bar[XB_TOP], 1u);
            const unsigned tg = og / nx;
            if (og + 1u == (tg + 1u) * nx) xb_add(&bar[XB_TOPGEN], 1u);
            else XB_SPIN(xb_ld(&bar[XB_TOPGEN]) == tg, bar);
            __builtin_amdgcn_fence(__ATOMIC_ACQUIRE, "agent");
            xb_add(&bar[XB_XGEN(b.x)], 1u);
            asm volatile("s_waitcnt vmcnt(0)" ::: "memory");
        } else {
            XB_SPIN(xb_ld(&bar[XB_XGEN(b.x)]) == gen, bar);
            __builtin_amdgcn_fence(__ATOMIC_ACQUIRE, "agent");
            asm volatile("s_waitcnt vmcnt(0)" ::: "memory");
        }
    }
    __syncthreads();
}

constexpr size_t WS_BAR = 786432;
constexpr int XB_LDS_OFF = LDS_BYTES - 16;
typedef const __attribute__((address_space(4))) Params* KParamsPtr;
__device__ __forceinline__ Params load_params(KParamsPtr q) {
    Params r; r.x = q->x; r.c = q->c; r.w_ada = q->w_ada; r.b_ada = q->b_ada; r.g_attn = q->g_attn; r.w_in = q->w_in; r.qna = q->qna; r.kna = q->kna; r.qnb = q->qnb; r.knb = q->knb;
    r.lam = q->lam; r.subln = q->subln; r.w_out = q->w_out; r.g_ffn = q->g_ffn; r.w_up = q->w_up; r.conv_w = q->conv_w; r.conv_b = q->conv_b; r.w_down = q->w_down; r.rel_bias = q->rel_bias;
    r.out = q->out; r.ws = q->ws; return r;
}
#define FRESH_PARAMS() KParamsPtr pp_ = (KParamsPtr)__builtin_amdgcn_kernarg_segment_ptr(); asm volatile("" : "+s"(pp_)); const Params p = load_params(pp_); \
    float* mod = (float*)(p.ws + WS_MOD); bf16_t* H = (bf16_t*)(p.ws + WS_H); const int G = (int)gridDim.x, cb = (int)blockIdx.x; (void)mod; (void)H; (void)G; (void)cb
__global__ void __launch_bounds__(512, 2) hybrid_block_fwd(Params p_unused) {
    extern __shared__ __attribute__((aligned(16))) unsigned char lds_raw[];
    LAS unsigned char* lds = (LAS unsigned char*)lds_raw;
    cg::grid_group grid = cg::this_grid();
    if (threadIdx.x < 4) ((LAS unsigned*)(lds + XB_LDS_OFF))[threadIdx.x] = 0u;
    __syncthreads();
    const int wv = __builtin_amdgcn_readfirstlane((int)threadIdx.x >> 6);
    { FRESH_PARAMS(); if (blockIdx.x == 0) { unsigned* bw = (unsigned*)(p.ws + WS_BAR); for (int i = threadIdx.x; i < XCD_BAR_WORDS; i += 512) bw[i] = 0u; }
      phase0(p, lds, wv); }
    grid.sync();
    XcdBarrier bar;
    { FRESH_PARAMS(); bar = xcd_barrier_post((unsigned*)(p.ws + WS_BAR), (volatile LAS unsigned*)(lds + XB_LDS_OFF)); }
    { FRESH_PARAMS(); norm_phase(p.x, p.g_attn, mod, 1024, 0, H, wv); }
    xcd_barrier(bar);
    {
        FRESH_PARAMS();
        pg8::Gemm g{H, (const bf16_t*)(p.ws + WS_WIN), MTOK, NPROJ, DM}; pg8::StaticOrder S; S.init(MTOK, NPROJ, G, cb);
        EpiProj E{p.ws, p.qna, p.kna, p.qnb, p.knb};
#pragma unroll 1
        for (int rep = 0; rep < REPG1; ++rep) pg8::gemm_phase<EpiProj, pg8::StaticOrder, true, true>(lds, g, S, E, wv);
    }
    xcd_barrier(bar);
    { FRESH_PARAMS(); attnA_phase(p, lds, wv); }
    __syncthreads();
    { FRESH_PARAMS(); phaseB(p, lds, wv); }
    xcd_barrier(bar);
    {
        FRESH_PARAMS();
        pg8::Gemm g{(const bf16_t*)(p.ws + WS_CAT), (const bf16_t*)(p.ws + WS_WOUT), MTOK, DM, DM}; pg8::StaticOrder S; S.init(MTOK, DM, G, cb);
        EpiOut E{p.x, mod + 2048, p.out};
#pragma unroll 1
        for (int rep = 0; rep < REPG2; ++rep) pg8::gemm_phase<EpiOut, pg8::StaticOrder, true, true>(lds, g, S, E, wv);
    }
    xcd_barrier(bar);
    { FRESH_PARAMS(); norm_phase(p.out, p.g_ffn, mod, 4096, 3072, H, wv); }
    xcd_barrier(bar);
    {
        FRESH_PARAMS();
        pg8::Gemm g{H - 2 * DM, (const bf16_t*)(p.ws + WS_WUP), 259 * 256, NUP, DM, 254}; pg8::StaticOrder S; S.init(259 * 256, NUP, G, cb);
        EpiUpConv E{(bf16_t*)(p.ws + WS_U), p.conv_w, p.conv_b, (LAS float*)(lds + HALO_OFF)};
#pragma unroll 1
        for (int rep = 0; rep < REPG3; ++rep) pg8::gemm_phase<EpiUpConv, pg8::StaticOrder, true, true>(lds, g, S, E, wv);
    }
    xcd_barrier(bar);
    {
        FRESH_PARAMS();
        pg8::Gemm g{(const bf16_t*)(p.ws + WS_U), (const bf16_t*)(p.ws + WS_WDN), MTOK, DM, DFF}; pg8::StaticOrder S; S.init(MTOK, DM, G, cb);
        EpiDown E{mod + 5120, p.out, 0};
        pg8::gemm_phase<EpiDown, pg8::StaticOrder, true, true>(lds, g, S, E, wv);
    }
}

extern "C" void kernel_launch(void* const* d_in, const int* in_sizes, int n_in, void* d_out, int out_size, void* d_ws, size_t ws_size, hipStream_t stream) {
    static int grid_blocks = 0;
    if (grid_blocks == 0) {
        if (n_in != 19 || ws_size < WS_END) { fprintf(stderr, "kernel_launch: unexpected n_in %d / ws %zu\n", n_in, ws_size); grid_blocks = -1; return; }
        int dev = 0, cus = 0, per_cu = 0;
        hipGetDevice(&dev);
        hipDeviceGetAttribute(&cus, hipDeviceAttributeMultiprocessorCount, dev);
        if (hipFuncSetAttribute((const void*)hybrid_block_fwd, hipFuncAttributeMaxDynamicSharedMemorySize, LDS_BYTES) != hipSuccess) { fprintf(stderr, "hipFuncSetAttribute failed\n"); }
        if (hipOccupancyMaxActiveBlocksPerMultiprocessor(&per_cu, (const void*)hybrid_block_fwd, 512, LDS_BYTES) != hipSuccess || per_cu < 1) { fprintf(stderr, "occupancy query: %d\n", per_cu); per_cu = 1; }
        (void)hipGetLastError();
        grid_blocks = cus * (per_cu > 1 ? 1 : per_cu);
        if (grid_blocks > 256) grid_blocks = 256;
    }
    if (grid_blocks < 0) return;
    Params p{};
    const float** f = (const float**)&p;
    for (int i = 0; i < 19; ++i) f[i] = (const float*)d_in[i];
    p.out = (float*)d_out; p.ws = (unsigned char*)d_ws;
    void* args[] = {&p};
    hipError_t e = hipLaunchCooperativeKernel((const void*)hybrid_block_fwd, dim3(grid_blocks), dim3(512), args, LDS_BYTES, stream);
    if (e != hipSuccess) fprintf(stderr, "cooperative launch failed: %s (grid %d)\n", hipGetErrorString(e), grid_blocks);
}
```

```cpp
#include <hip/hip_runtime.h>
#include <hip/hip_cooperative_groups.h>
#include <cstdio>
#include <cstdint>
#include <cmath>
namespace cg = cooperative_groups;

namespace pg8 {
#define PG8_LAS __attribute__((address_space(3)))
typedef unsigned short bf16_t;
typedef short bf16x8 __attribute__((ext_vector_type(8)));
typedef float f32x4 __attribute__((ext_vector_type(4)));
typedef unsigned u32x4 __attribute__((ext_vector_type(4)));
constexpr int BM = 256, BK = 64, HALF = 128, HTB = HALF * BK * 2  , STAGE_BYTES = 8 * HTB, NXCD = 8, WGM = 8;

__host__ __device__ __forceinline__ int lds_byte(int r, int c) { const int st = (r >> 4) * 2 + (c >> 5), rr = r & 15, cc = c & 31, ob = rr * 64 + cc * 2; return st * 1024 + (ob ^ (((ob >> 9) & 1) << 5)); }
__host__ __device__ __forceinline__ void stage_rc(int b, int& R, int& C) { const int st = b / 1024, sb = b % 1024, swz = sb ^ (((sb >> 9) & 1) << 5); R = (st >> 1) * 16 + swz / 64; C = (st & 1) * 32 + (swz % 64) / 2; }
__host__ __device__ __forceinline__ int perm32(int rho) { const int n = rho >> 4, i = rho & 15; return 8 * (i >> 2) + 4 * n + (i & 3); }

struct Unit { int pm, pn; };
struct Gemm { const bf16_t* A; const bf16_t* Bt; int M, N, K; int a_rows = 256; };

struct StaticOrder {
    int nM, nN, nwg, G, c;
    __host__ __device__ void init(int M, int N, int G_, int c_) { nM = M / BM; nN = N / BM; nwg = nM * nN; G = G_; c = c_; }
    __host__ __device__ bool next(int i, Unit& u) const {
        const long L = (long)i * G + c; if (L >= nwg) return false;
        int wgid = (int)L; { const int q = nwg / NXCD, r = nwg % NXCD, xcd = wgid % NXCD, off = wgid / NXCD; wgid = (xcd < r ? xcd * (q + 1) : r * (q + 1) + (xcd - r) * q) + off; }
        const int nig = WGM * nN, gid = wgid / nig, fm = gid * WGM, gsz = (nM - fm) < WGM ? (nM - fm) : WGM;
        u.pm = fm + ((wgid % nig) % gsz); u.pn = (wgid % nig) / gsz; return true;
    }
    __device__ __forceinline__ void a_ready(const Unit&) const {}
    __device__ __forceinline__ void done(const Unit&) const {}
};

__device__ __forceinline__ unsigned cvt_pk_bf16(float lo, float hi) { unsigned r; asm volatile("v_cvt_pk_bf16_f32 %0, %1, %2" : "=v"(r) : "v"(lo), "v"(hi)); return r; }
template <class Epi, class Sched, bool ALIGN_EPI = false, bool SP2 = false>
__device__ __forceinline__ void gemm_phase(PG8_LAS unsigned char* lds, const Gemm g, const Sched& S, const Epi& E, const int wv) {
    int tid_; asm volatile("v_mbcnt_lo_u32_b32 %0, -1, 0\n\tv_mbcnt_hi_u32_b32 %0, -1, %0" : "=v"(tid_)); tid_ += wv * 64;
    const int tid = tid_, wid = __builtin_amdgcn_readfirstlane(tid >> 6), lane = tid & 63, wr = wid >> 2, wc = wid & 3, fr = lane & 15, fq = lane >> 4;
    const int K = g.K, nt = K / BK;
    unsigned voffA[2], voffB[2];
#pragma unroll
    for (int i = 0; i < 2; ++i) { int R, C; stage_rc(tid * 16 + i * 8192, R, C); const int Rb = Epi::PERM ? ((R & ~31) + perm32(R & 31)) : R;
        voffA[i] = (unsigned)(R * K + C) * 2u; voffB[i] = (unsigned)(Rb * K + C) * 2u; }
    const size_t kstep = (size_t)(BK * 2);
    const size_t hstep = (size_t)HALF * K * 2;
    const size_t tstep = 2 * hstep; const size_t tstepA = (size_t)g.a_rows * K * 2;
    const unsigned ldsw = (unsigned)wid * 1024u;
    const int aoff = lds_byte(wr * 64 + fr, fq * 8), boff = lds_byte(wc * 32 + fr, fq * 8);
#define PG8_SA(b, h) (((b) * 2 + (h)) * HTB)
#define PG8_SB(b, h) ((4 + (b) * 2 + (h)) * HTB)
#define PG8_STAGE(bufoff, gbase, voff) do { _Pragma("unroll") for (int _i = 0; _i < 2; ++_i) \
        __builtin_amdgcn_global_load_lds((const unsigned*)((const char*)(gbase) + (voff)[_i]), (PG8_LAS unsigned*)(lds + (bufoff) + ldsw + _i * 8192), 16, 0, 0); } while (0)
#define PG8_LDA(dst, b, h) do { _Pragma("unroll") for (int m = 0; m < 4; ++m) _Pragma("unroll") for (int k = 0; k < 2; ++k) dst[m][k] = *(const PG8_LAS bf16x8*)(lds + PG8_SA(b, h) + aoff + m * 2048 + k * 1024); } while (0)
#define PG8_LDB(dst, b, h) do { _Pragma("unroll") for (int n = 0; n < 2; ++n) _Pragma("unroll") for (int k = 0; k < 2; ++k) dst[n][k] = *(const PG8_LAS bf16x8*)(lds + PG8_SB(b, h) + boff + n * 2048 + k * 1024); } while (0)
#define PG8_MMA(ai, bj, At, Bt) do { __builtin_amdgcn_s_setprio(1); _Pragma("unroll") for (int m = 0; m < 4; ++m) _Pragma("unroll") for (int n = 0; n < 2; ++n) _Pragma("unroll") for (int k = 0; k < 2; ++k) \
        acc[ai][bj][m][n] = __builtin_amdgcn_mfma_f32_16x16x32_bf16(Bt[n][k], At[m][k], acc[ai][bj][m][n], 0, 0, 0); __builtin_amdgcn_s_setprio(0); } while (0)
#define PG8_WAIT_V(n) asm volatile("s_waitcnt vmcnt(" #n ")" ::: "memory")
#define PG8_WAIT_L(n) asm volatile("s_waitcnt lgkmcnt(" #n ")" ::: "memory")
#define PG8_BAR __builtin_amdgcn_s_barrier()
#define PG8_SCHED __builtin_amdgcn_sched_barrier(0)
    Unit cur, nxt; int ui = 0;
    if (!S.next(0, cur)) return;
    f32x4 acc[2][2][4][2];
#pragma unroll
    for (int a = 0; a < 2; ++a)
#pragma unroll
        for (int b = 0; b < 2; ++b)
#pragma unroll
            for (int m = 0; m < 4; ++m)
#pragma unroll
                for (int n = 0; n < 2; ++n) acc[a][b][m][n] = (f32x4){0.f, 0.f, 0.f, 0.f};
    bf16x8 At[4][2], B0[2][2], B1[2][2];
    const char* cA = (const char*)g.A + (size_t)cur.pm * tstepA; const char* cB = (const char*)g.Bt + (size_t)cur.pn * tstep;
    S.a_ready(cur);
    if constexpr (SP2) {
        PG8_STAGE(PG8_SB(0, 0), cB, voffB); PG8_STAGE(PG8_SB(0, 1), cB + hstep, voffB); PG8_STAGE(PG8_SA(0, 0), cA, voffA); PG8_STAGE(PG8_SA(0, 1), cA + hstep, voffA);
        if (wr == 1) PG8_BAR;
        PG8_WAIT_V(2); PG8_BAR;
        PG8_STAGE(PG8_SB(1, 0), cB + kstep, voffB); PG8_STAGE(PG8_SA(1, 0), cA + kstep, voffA); PG8_STAGE(PG8_SB(1, 1), cB + hstep + kstep, voffB);
        PG8_WAIT_V(6); PG8_BAR;
    } else {
        PG8_STAGE(PG8_SB(0, 0), cB, voffB); PG8_STAGE(PG8_SA(0, 0), cA, voffA); PG8_STAGE(PG8_SB(0, 1), cB + hstep, voffB); PG8_STAGE(PG8_SA(0, 1), cA + hstep, voffA);
        if (wr == 1) PG8_BAR;
        PG8_WAIT_V(4); PG8_BAR;
        PG8_STAGE(PG8_SB(1, 0), cB + kstep, voffB); PG8_STAGE(PG8_SA(1, 0), cA + kstep, voffA); PG8_STAGE(PG8_SB(1, 1), cB + hstep + kstep, voffB);
        PG8_WAIT_V(6); PG8_BAR;
    }
    for (;;) {
        const bool has_next = S.next(ui + 1, nxt);
        const char* nA = has_next ? (const char*)g.A + (size_t)nxt.pm * tstepA : cA; const char* nB = has_next ? (const char*)g.Bt + (size_t)nxt.pn * tstep : cB;
        for (int t = 0; t < nt; t += 2) {
            const bool last = (t == nt - 2);
            const char* a1 = cA + (size_t)(t + 1) * kstep;
            const char* a2 = last ? nA : cA + (size_t)(t + 2) * kstep; const char* b2 = last ? nB : cB + (size_t)(t + 2) * kstep;
            const char* a3 = a2 + kstep; const char* b3 = b2 + kstep;
            if (last && has_next) S.a_ready(nxt);
            if constexpr (SP2) {
            PG8_LDB(B0, 0, 0); PG8_LDB(B1, 0, 1); PG8_SCHED; PG8_LDA(At, 0, 0); PG8_STAGE(PG8_SA(1, 1), a1 + hstep, voffA);
            PG8_WAIT_V(8); PG8_WAIT_L(0); PG8_BAR; PG8_MMA(0, 0, At, B0); PG8_MMA(0, 1, At, B1); PG8_BAR; PG8_SCHED;
            PG8_LDA(At, 0, 1); PG8_STAGE(PG8_SB(0, 0), b2, voffB); PG8_STAGE(PG8_SB(0, 1), b2 + hstep, voffB); PG8_STAGE(PG8_SA(0, 0), a2, voffA);
            PG8_WAIT_V(8); PG8_WAIT_L(0); PG8_BAR; PG8_MMA(1, 0, At, B0); PG8_MMA(1, 1, At, B1); PG8_BAR; PG8_SCHED;
            PG8_LDB(B0, 1, 0); PG8_LDB(B1, 1, 1); PG8_SCHED; PG8_LDA(At, 1, 0); PG8_STAGE(PG8_SA(0, 1), a2 + hstep, voffA);
            PG8_WAIT_V(8); PG8_WAIT_L(0); PG8_BAR; PG8_MMA(0, 0, At, B0); PG8_MMA(0, 1, At, B1); PG8_BAR; PG8_SCHED;
            PG8_LDA(At, 1, 1); PG8_STAGE(PG8_SB(1, 0), b3, voffB); PG8_STAGE(PG8_SB(1, 1), b3 + hstep, voffB); PG8_STAGE(PG8_SA(1, 0), a3, voffA);
            PG8_WAIT_V(8); PG8_WAIT_L(0); PG8_BAR; PG8_MMA(1, 0, At, B0); PG8_MMA(1, 1, At, B1); PG8_BAR; PG8_SCHED;
            } else {
            PG8_LDB(B0, 0, 0); PG8_SCHED; PG8_LDA(At, 0, 0); PG8_STAGE(PG8_SA(1, 1), a1 + hstep, voffA);
            PG8_WAIT_L(8); PG8_BAR; PG8_WAIT_L(0); PG8_MMA(0, 0, At, B0); PG8_BAR; PG8_SCHED;
            PG8_LDB(B1, 0, 1); PG8_STAGE(PG8_SB(0, 0), b2, voffB);
            PG8_BAR; PG8_WAIT_L(0); PG8_MMA(0, 1, At, B1); PG8_BAR;
            PG8_LDA(At, 0, 1); PG8_STAGE(PG8_SA(0, 0), a2, voffA);
            PG8_BAR; PG8_WAIT_L(0); PG8_MMA(1, 0, At, B0); PG8_BAR; PG8_SCHED;
            PG8_STAGE(PG8_SB(0, 1), b2 + hstep, voffB);
            PG8_WAIT_V(6); PG8_BAR; PG8_MMA(1, 1, At, B1); PG8_BAR;
            PG8_LDB(B0, 1, 0); PG8_SCHED; PG8_LDA(At, 1, 0); PG8_STAGE(PG8_SA(0, 1), a2 + hstep, voffA);
            PG8_WAIT_L(8); PG8_BAR; PG8_WAIT_L(0); PG8_MMA(0, 0, At, B0); PG8_BAR; PG8_SCHED;
            PG8_LDB(B1, 1, 1); PG8_STAGE(PG8_SB(1, 0), b3, voffB);
            PG8_BAR; PG8_WAIT_L(0); PG8_MMA(0, 1, At, B1); PG8_BAR;
            PG8_LDA(At, 1, 1); PG8_STAGE(PG8_SA(1, 0), a3, voffA);
            PG8_BAR; PG8_WAIT_L(0); PG8_MMA(1, 0, At, B0); PG8_BAR; PG8_SCHED;
            PG8_STAGE(PG8_SB(1, 1), b3 + hstep, voffB);
            PG8_WAIT_V(6); PG8_BAR; PG8_MMA(1, 1, At, B1); PG8_BAR;
            }
        }
        if constexpr (ALIGN_EPI) { if (wr == 0) PG8_BAR; }
        if constexpr (!Epi::AFTER_DRAIN) { E(acc, cur, wr, wc, fr, fq); S.done(cur); }
        if (!has_next) break;
#pragma unroll
        for (int a = 0; a < 2; ++a)
#pragma unroll
            for (int b = 0; b < 2; ++b)
#pragma unroll
                for (int m = 0; m < 4; ++m)
#pragma unroll
                    for (int n = 0; n < 2; ++n) acc[a][b][m][n] = (f32x4){0.f, 0.f, 0.f, 0.f};
        cur = nxt; cA = nA; cB = nB; ++ui;
        if constexpr (ALIGN_EPI) { if (wr == 1) PG8_BAR; }
    }
    PG8_WAIT_V(0);
    if constexpr (!ALIGN_EPI) { if (wr == 0) PG8_BAR; }
    PG8_BAR;
    if constexpr (Epi::AFTER_DRAIN) { E.fused(acc, cur, wr, wc, fr, fq, lds, wid, lane); S.done(cur); }
#undef PG8_SA
#undef PG8_SB
#undef PG8_STAGE
#undef PG8_LDA
#undef PG8_LDB
#undef PG8_MMA
#undef PG8_WAIT_V
#undef PG8_WAIT_L
#undef PG8_BAR
#undef PG8_SCHED
}
}

using pg8::bf16_t; using pg8::f32x4; using pg8::Unit; using pg8::cvt_pk_bf16;
typedef short bf16x8 __attribute__((ext_vector_type(8)));
typedef _Float16 f16x8 __attribute__((ext_vector_type(8)));
typedef float f32x16 __attribute__((ext_vector_type(16)));
typedef unsigned u32x4 __attribute__((ext_vector_type(4)));
typedef unsigned u32x2 __attribute__((ext_vector_type(2)));
typedef short s16x4 __attribute__((ext_vector_type(4)));
#define LAS __attribute__((address_space(3)))

constexpr int BATCH = 16, SEQ = 4096, DM = 1024, MTOK = BATCH * SEQ;
constexpr int NPROJ = 3072, NREAL = 2888, DFF = 2816, NUP = 5632, MODW = 6144;
constexpr int MHALF = MTOK / 2;
constexpr float EPS = 1e-6f, LOG2E = 1.4426950408889634f, QSCALE = 0.125f * LOG2E;
constexpr size_t MiB = 1u << 20;
constexpr size_t WS_MOD = 0, WS_WIN = 1 * MiB, WS_WOUT = 7 * MiB, WS_WUP = 9 * MiB, WS_WDN = 20 * MiB, WS_H = 26 * MiB;
constexpr size_t WS_AQ = 154 * MiB, WS_AK = 218 * MiB, WS_AV = 282 * MiB, WS_BQ = 346 * MiB, WS_BK = 410 * MiB, WS_BV = 426 * MiB;
constexpr size_t WS_IQ = 442 * MiB, WS_IK = 506 * MiB, WS_IW = 514 * MiB, WS_CAT = 516 * MiB, WS_SC = 644 * MiB;
constexpr size_t WS_U = 154 * MiB, WS_G = 506 * MiB, WS_END = 1024 * MiB;
constexpr int LDS_BYTES = 147456;

struct Params {
    const float *x, *c, *w_ada, *b_ada, *g_attn, *w_in, *qna, *kna, *qnb, *knb, *lam, *subln, *w_out, *g_ffn, *w_up, *conv_w, *conv_b, *w_down, *rel_bias;
    float* out; unsigned char* ws;
};

__device__ __forceinline__ int otid(int wv) { int l; asm volatile("v_mbcnt_lo_u32_b32 %0, -1, 0\n\tv_mbcnt_hi_u32_b32 %0, -1, %0" : "=v"(l)); return wv * 64 + l; }
__device__ __forceinline__ float wave_sum(float v) {
#pragma unroll
    for (int o = 1; o < 64; o <<= 1) v += __shfl_xor(v, o);
    return v;
}
__device__ __forceinline__ float wave_max(float v) {
#pragma unroll
    for (int o = 1; o < 64; o <<= 1) v = fmaxf(v, __shfl_xor(v, o));
    return v;
}
__device__ __forceinline__ unsigned pk_f16(float a, float b) {
    _Float16 x = (_Float16)a, y = (_Float16)b;
    return (unsigned)__builtin_bit_cast(unsigned short, x) | ((unsigned)__builtin_bit_cast(unsigned short, y) << 16);
}
__device__ __forceinline__ int pi32(int m) { const int a = m >> 3, h = (m >> 2) & 1, c = m & 3; return 16 * (a >> 1) + 8 * h + 4 * (a & 1) + c; }
__device__ __forceinline__ int crow(int r, int hi) { return (r & 3) + 8 * (r >> 2) + 4 * hi; }
__device__ __forceinline__ int t5_bucket(int n) {
    if (n < 16) return n;
    return 16 + (n >= 19) + (n >= 21) + (n >= 24) + (n >= 27) + (n >= 31) + (n >= 35) + (n >= 40) + (n >= 46) + (n >= 52) + (n >= 59) + (n >= 67) + (n >= 77) + (n >= 87) + (n >= 99) + (n >= 113);
}
__device__ __forceinline__ s16x4 vtr(const LAS unsigned char* p) {
    return __builtin_bit_cast(s16x4, __builtin_amdgcn_ds_read_tr16_b64_v4i16((LAS s16x4*)p));
}

__device__ __forceinline__ int perm_inv(int n) { return (n & ~255) + 128 * ((n >> 5) & 1) + 32 * ((n >> 6) & 3) + (n & 31); }
__device__ __forceinline__ int perm_up(int n) { const int v = n >= DFF, m = n - (v ? DFF : 0); return (m >> 7) * 256 + 128 * v + (m & 127); }
__device__ __forceinline__ void transpose_tile(const float* W, int K, int N, int nreal, bf16_t* Bt, int k0, int n0, int permute, LAS float* scr, int tid) {
#pragma unroll
    for (int i = 0; i < 8; ++i) { const int kk = (tid >> 6) + 8 * i, nn = tid & 63, n = n0 + nn; scr[kk * 65 + nn] = (n < nreal) ? W[(size_t)(k0 + kk) * N + n] : 0.f; }
    __syncthreads();
    { const int nn = tid >> 3, c = tid & 7, n = n0 + nn, drow = permute == 1 ? perm_inv(n) : (permute == 2 ? perm_up(n) : n); const LAS float* s = scr + (8 * c) * 65 + nn;
      u32x4 o; o.x = cvt_pk_bf16(s[0], s[65]); o.y = cvt_pk_bf16(s[130], s[195]); o.z = cvt_pk_bf16(s[260], s[325]); o.w = cvt_pk_bf16(s[390], s[455]);
      *(u32x4*)(Bt + (size_t)drow * K + k0 + 8 * c) = o; }
    __syncthreads();
}
__device__ __forceinline__ void phase0(const Params& p, LAS unsigned char* lds, int wv) {
    const int tid = otid(wv);
    LAS float* sc = (LAS float*)lds;
    LAS float* scr = (LAS float*)(lds + 65536);
    LAS float* red = (LAS float*)(lds + 65536 + 16640);
    constexpr int I_IN = 16 * 48, I_OUT = 16 * 16, I_UP = 16 * 88, I_DN = 44 * 16, NIT = I_IN + I_OUT + I_UP + I_DN;
    for (int it = blockIdx.x; it < NIT; it += gridDim.x) {
        int r = it;
        if (r < I_IN) { transpose_tile(p.w_in, 1024, NREAL, NREAL, (bf16_t*)(p.ws + WS_WIN), 64 * (r / 48), 64 * (r % 48), 1, scr, tid); continue; } r -= I_IN;
        if (r < I_OUT) { transpose_tile(p.w_out, 1024, 1024, 1024, (bf16_t*)(p.ws + WS_WOUT), 64 * (r / 16), 64 * (r % 16), 0, scr, tid); continue; } r -= I_OUT;
        if (r < I_UP) { transpose_tile(p.w_up, 1024, NUP, NUP, (bf16_t*)(p.ws + WS_WUP), 64 * (r / 88), 64 * (r % 88), 2, scr, tid); continue; } r -= I_UP;
        transpose_tile(p.w_down, DFF, 1024, 1024, (bf16_t*)(p.ws + WS_WDN), 64 * (r / 16), 64 * (r % 16), 0, scr, tid);
    }
    if (blockIdx.x < 192) {
        for (int i = tid; i < 16 * 1024; i += 512) { const float v = p.c[i]; sc[i] = v / (1.f + __expf(-v)); }
        __syncthreads();
        float* mod = (float*)(p.ws + WS_MOD);
        for (int g = blockIdx.x; g < 192; g += gridDim.x) {
            const int kq = tid >> 5, col = tid & 31;
            float acc[16];
#pragma unroll
            for (int b = 0; b < 16; ++b) acc[b] = 0.f;
#pragma unroll 1
            for (int kb = 0; kb < 64; kb += 16) {
                float wv16[16];
#pragma unroll
                for (int i = 0; i < 16; ++i) wv16[i] = p.w_ada[(size_t)(kq * 64 + kb + i) * MODW + g * 32 + col];
#pragma unroll
                for (int i = 0; i < 16; ++i) { const int k = kq * 64 + kb + i;
#pragma unroll
                    for (int b = 0; b < 16; ++b) acc[b] += sc[b * 1024 + k] * wv16[i]; } }
#pragma unroll
            for (int b = 0; b < 16; ++b) red[(kq * 16 + b) * 32 + col] = acc[b];
            __syncthreads();
            { const int b = tid >> 5; float s = p.b_ada[g * 32 + col];
#pragma unroll
              for (int q = 0; q < 16; ++q) s += red[(q * 16 + b) * 32 + col];
              mod[b * MODW + g * 32 + col] = s; }
            __syncthreads();
        }
    }
}

__device__ __forceinline__ void norm_phase(const float* X, const float* gvec, const float* mod, int sc_off, int sh_off, bf16_t* H, int wv) {
    const int tid = otid(wv); const int lane = tid & 63, gw = blockIdx.x * 8 + (tid >> 6), NGW = gridDim.x * 8;
    for (int row0 = gw; row0 < MTOK; row0 += 4 * NGW) {
        f32x4 v[4][4];
#pragma unroll
        for (int q = 0; q < 4; ++q) { const int row = min(row0 + q * NGW, MTOK - 1); const f32x4* xr = (const f32x4*)(X + (size_t)row * DM) + lane;
#pragma unroll
            for (int j = 0; j < 4; ++j) v[q][j] = xr[64 * j]; }
#pragma unroll
        for (int q = 0; q < 4; ++q) {
            const int row = row0 + q * NGW;
            float ss = 0.f;
#pragma unroll
            for (int j = 0; j < 4; ++j) ss += (v[q][j].x * v[q][j].x + v[q][j].y * v[q][j].y) + (v[q][j].z * v[q][j].z + v[q][j].w * v[q][j].w);
            const float rs = 1.0f / sqrtf(wave_sum(ss) * (1.f / DM) + EPS);
            if (row < MTOK) { const int b = row >> 12;
#pragma unroll
                for (int j = 0; j < 4; ++j) { const int col = (lane + 64 * j) * 4;
                    const f32x4 g4 = *(const f32x4*)(gvec + col), s4 = *(const f32x4*)(mod + b * MODW + sc_off + col), h4 = *(const f32x4*)(mod + b * MODW + sh_off + col);
                    const f32x4 y = (v[q][j] * rs) * g4 * (s4 + 1.0f) + h4; u32x2 o; o.x = cvt_pk_bf16(y.x, y.y); o.y = cvt_pk_bf16(y.z, y.w);
                    *(u32x2*)(H + (size_t)row * DM + col) = o; } }
        }
    }
}

struct EpiProj {
    static constexpr bool PERM = true, AFTER_DRAIN = false;
    unsigned char* ws; const float *qa, *ka, *qb, *kb;
    __device__ __forceinline__ void operator()(const f32x4 (&acc)[2][2][4][2], const Unit& u, int wr, int wc, int fr, int fq) const {
        const int G = u.pn * 4 + wc;
        if (G >= 46) return;
        int kind = 0, ld = 512, coloff = 0; unsigned char* base = ws; const float* gn = nullptr; float scale = 1.f;
        if (G < 8) { base = ws + WS_AQ; coloff = 64 * G; gn = qa; scale = QSCALE; }
        else if (G < 16) { base = ws + WS_AK; coloff = 64 * (G - 8); gn = ka; }
        else if (G < 24) { base = ws + WS_AV; coloff = 64 * (G - 16); }
        else if (G < 32) { base = ws + WS_BQ; coloff = 64 * (G - 24); gn = qb; scale = QSCALE; }
        else if (G < 34) { base = ws + WS_BK; ld = 128; coloff = 64 * (G - 32); gn = kb; }
        else if (G < 36) { base = ws + WS_BV; ld = 128; coloff = 64 * (G - 34); }
        else if (G < 44) { base = ws + WS_IQ; kind = 1; coloff = 64 * (G - 36); }
        else if (G == 44) { base = ws + WS_IK; kind = 1; ld = 64; }
        else { base = ws + WS_IW; kind = 2; }
        const int row0 = u.pm * 256 + wr * 64 + fr;
        f32x4 gv[2][2];
#pragma unroll
        for (int bj = 0; bj < 2; ++bj)
#pragma unroll
            for (int n = 0; n < 2; ++n) { gv[bj][n] = gn ? *(const f32x4*)(gn + 32 * bj + 8 * fq + 4 * n) : (f32x4){1.f, 1.f, 1.f, 1.f}; gv[bj][n] = gv[bj][n] * scale; }
#pragma unroll
        for (int ai = 0; ai < 2; ++ai)
#pragma unroll
            for (int m = 0; m < 4; ++m) {
                const size_t row = (size_t)(row0 + 128 * ai + 16 * m);
                float rs = 1.f;
                if (gn) { float ss = 0.f;
#pragma unroll
                    for (int bj = 0; bj < 2; ++bj)
#pragma unroll
                        for (int n = 0; n < 2; ++n) { const f32x4 v = acc[ai][bj][m][n]; ss += (v.x * v.x + v.y * v.y) + (v.z * v.z + v.w * v.w); }
                    ss += __shfl_xor(ss, 16); ss += __shfl_xor(ss, 32);
                    rs = __builtin_amdgcn_rsqf(ss * (1.f / 64.f) + EPS); }
                if (kind == 2) { if (fq == 0) { *(f32x4*)((float*)base + row * 8) = acc[ai][0][m][0] * 0.04419417382415922f; *(f32x4*)((float*)base + row * 8 + 4) = acc[ai][0][m][1] * 0.04419417382415922f; } }
                else {
#pragma unroll
                    for (int bj = 0; bj < 2; ++bj) { const f32x4 v0 = acc[ai][bj][m][0] * rs * gv[bj][0], v1 = acc[ai][bj][m][1] * rs * gv[bj][1]; u32x4 w;
                        if (kind == 0) { w.x = cvt_pk_bf16(v0.x, v0.y); w.y = cvt_pk_bf16(v0.z, v0.w); w.z = cvt_pk_bf16(v1.x, v1.y); w.w = cvt_pk_bf16(v1.z, v1.w); }
                        else { w.x = pk_f16(v0.x, v0.y); w.y = pk_f16(v0.z, v0.w); w.z = pk_f16(v1.x, v1.y); w.w = pk_f16(v1.z, v1.w); }
                        *(u32x4*)((bf16_t*)base + row * ld + coloff + 32 * bj + 8 * fq) = w; }
                }
            }
    }
};
struct EpiOut {
    static constexpr bool PERM = true, AFTER_DRAIN = false;
    const float* x; const float* gate; float* out;
    __device__ __forceinline__ void operator()(const f32x4 (&acc)[2][2][4][2], const Unit& u, int wr, int wc, int fr, int fq) const {
        const int row0 = u.pm * 256 + wr * 64 + fr, col0 = u.pn * 256 + wc * 32 + 8 * fq;
#pragma unroll
        for (int ai = 0; ai < 2; ++ai)
#pragma unroll
            for (int m = 0; m < 4; ++m) { const int row = row0 + 128 * ai + 16 * m, b = row >> 12;
#pragma unroll
                for (int bj = 0; bj < 2; ++bj)
#pragma unroll
                    for (int n = 0; n < 2; ++n) { const int col = col0 + 128 * bj + 4 * n; const size_t off = (size_t)row * DM + col;
                        const f32x4 g = *(const f32x4*)(gate + b * MODW + col), xv = *(const f32x4*)(x + off);
                        *(f32x4*)(out + off) = xv + g * acc[ai][bj][m][n]; } }
    }
};
struct EpiUp {
    static constexpr bool PERM = false, AFTER_DRAIN = false;
    bf16_t* U;
    __device__ __forceinline__ void operator()(const f32x4 (&acc)[2][2][4][2], const Unit& u, int wr, int wc, int fr, int fq) const {
        const int row0 = u.pm * 256 + wr * 64 + fr, col0 = u.pn * 256 + wc * 32 + 4 * fq;
#pragma unroll
        for (int ai = 0; ai < 2; ++ai)
#pragma unroll
            for (int m = 0; m < 4; ++m) { const size_t row = (size_t)(row0 + 128 * ai + 16 * m);
#pragma unroll
                for (int bj = 0; bj < 2; ++bj)
#pragma unroll
                    for (int n = 0; n < 2; ++n) { const f32x4 v = acc[ai][bj][m][n]; u32x2 w; w.x = cvt_pk_bf16(v.x, v.y); w.y = cvt_pk_bf16(v.z, v.w);
                        *(u32x2*)(U + row * NUP + col0 + 128 * bj + 16 * n) = w; } }
    }
};
constexpr int HALO_OFF = 131072;
__device__ __forceinline__ f32x4 dpp_ror(const f32x4 v, const int which) {
    f32x4 r;
    if (which == 1) { r.x = __int_as_float(__builtin_amdgcn_update_dpp(0, __float_as_int(v.x), 0x121, 0xf, 0xf, false)); r.y = __int_as_float(__builtin_amdgcn_update_dpp(0, __float_as_int(v.y), 0x121, 0xf, 0xf, false));
                      r.z = __int_as_float(__builtin_amdgcn_update_dpp(0, __float_as_int(v.z), 0x121, 0xf, 0xf, false)); r.w = __int_as_float(__builtin_amdgcn_update_dpp(0, __float_as_int(v.w), 0x121, 0xf, 0xf, false)); }
    else { r.x = __int_as_float(__builtin_amdgcn_update_dpp(0, __float_as_int(v.x), 0x122, 0xf, 0xf, false)); r.y = __int_as_float(__builtin_amdgcn_update_dpp(0, __float_as_int(v.y), 0x122, 0xf, 0xf, false));
           r.z = __int_as_float(__builtin_amdgcn_update_dpp(0, __float_as_int(v.z), 0x122, 0xf, 0xf, false)); r.w = __int_as_float(__builtin_amdgcn_update_dpp(0, __float_as_int(v.w), 0x122, 0xf, 0xf, false)); }
    return r;
}
struct EpiUpConv {
    static constexpr bool PERM = true, AFTER_DRAIN = false;
    bf16_t* Gout; const float* cw; const float* cb; LAS float* halo;
    __device__ __forceinline__ void operator()(const f32x4 (&acc)[2][2][4][2], const Unit& u, int wr, int wc, int fr_, int fq_) const {
        int fr = fr_, fq = fq_; asm volatile("" : "+v"(fr), "+v"(fq));
        if (fr >= 14) {
#pragma unroll
            for (int ai = 0; ai < 2; ++ai)
#pragma unroll
                for (int bj = 0; bj < 2; ++bj)
#pragma unroll
                    for (int n = 0; n < 2; ++n) *(LAS f32x4*)(halo + ((2 * ai + wr) * 2 + (fr - 14)) * 256 + 128 * bj + 32 * wc + 8 * fq + 4 * n) = acc[ai][bj][3][n];
        }
        asm volatile("s_waitcnt lgkmcnt(0)" ::: "memory"); __builtin_amdgcn_s_barrier(); asm volatile("" ::: "memory");
        const int R0 = u.pm * 254 - 2;
#pragma unroll
        for (int n = 0; n < 2; ++n) {
            const int cr = u.pn * 128 + wc * 32 + 8 * fq + 4 * n;
            const f32x4 g0 = *(const f32x4*)(cw + cr), g1 = *(const f32x4*)(cw + NUP + cr), g2 = *(const f32x4*)(cw + 2 * NUP + cr), gb = *(const f32x4*)(cb + cr);
            const f32x4 v0 = *(const f32x4*)(cw + DFF + cr), v1 = *(const f32x4*)(cw + NUP + DFF + cr), v2 = *(const f32x4*)(cw + 2 * NUP + DFF + cr), vb = *(const f32x4*)(cb + DFF + cr);
#pragma unroll
            for (int ai = 0; ai < 2; ++ai) {
                const int seg = 2 * ai + wr;
                f32x4 pr1[2], pr2[2];
#pragma unroll
                for (int bj = 0; bj < 2; ++bj) {
                    pr1[bj] = (f32x4){0.f, 0.f, 0.f, 0.f}; pr2[bj] = (f32x4){0.f, 0.f, 0.f, 0.f};
                    if (seg > 0) { const LAS float* hp = halo + ((seg - 1) * 2) * 256 + 128 * bj + 32 * wc + 8 * fq + 4 * n;
                        pr1[bj] = *(const LAS f32x4*)(hp + 256); pr2[bj] = *(const LAS f32x4*)(hp + ((fr & 1) ? 256 : 0)); }
                }
#pragma unroll
                for (int m = 0; m < 4; ++m) {
                    const int r = 128 * ai + 64 * wr + 16 * m + fr, R = R0 + r, t = R & (SEQ - 1);
                    f32x4 y[2];
#pragma unroll
                    for (int bj = 0; bj < 2; ++bj) {
                        const f32x4 X = acc[ai][bj][m][n]; const f32x4 r1 = dpp_ror(X, 1), r2 = dpp_ror(X, 2);
                        f32x4 p1 = (fr == 0) ? pr1[bj] : r1, p2 = (fr < 2) ? pr2[bj] : r2;
                        pr1[bj] = r1; pr2[bj] = r2;
                        if (t == 0) p1 = (f32x4){0.f, 0.f, 0.f, 0.f};
                        if (t <= 1) p2 = (f32x4){0.f, 0.f, 0.f, 0.f};
                        y[bj] = bj == 0 ? (gb + g0 * p2 + g1 * p1 + g2 * X) : (vb + v0 * p2 + v1 * p1 + v2 * X);
                    }
                    f32x4 o;
                    o.x = y[0].x * __builtin_amdgcn_rcpf(1.f + __builtin_amdgcn_exp2f(-LOG2E * y[0].x)) * y[1].x; o.y = y[0].y * __builtin_amdgcn_rcpf(1.f + __builtin_amdgcn_exp2f(-LOG2E * y[0].y)) * y[1].y;
                    o.z = y[0].z * __builtin_amdgcn_rcpf(1.f + __builtin_amdgcn_exp2f(-LOG2E * y[0].z)) * y[1].z; o.w = y[0].w * __builtin_amdgcn_rcpf(1.f + __builtin_amdgcn_exp2f(-LOG2E * y[0].w)) * y[1].w;
                    if (r >= 2 && R < MTOK) { u32x2 w; w.x = cvt_pk_bf16(o.x, o.y); w.y = cvt_pk_bf16(o.z, o.w); *(u32x2*)(Gout + (size_t)R * DFF + cr) = w; }
                }
            }
        }
    }
};
struct EpiDown {
    static constexpr bool PERM = true, AFTER_DRAIN = false;
    const float* gate; float* out; int rowoff;
    __device__ __forceinline__ void operator()(const f32x4 (&acc)[2][2][4][2], const Unit& u, int wr, int wc, int fr, int fq) const {
        const int row0 = rowoff + u.pm * 256 + wr * 64 + fr, col0 = u.pn * 256 + wc * 32 + 8 * fq;
#pragma unroll
        for (int ai = 0; ai < 2; ++ai)
#pragma unroll
            for (int m = 0; m < 4; ++m) { const int row = row0 + 128 * ai + 16 * m, b = row >> 12;
#pragma unroll
                for (int bj = 0; bj < 2; ++bj)
#pragma unroll
                    for (int n = 0; n < 2; ++n) { const int col = col0 + 128 * bj + 4 * n; const size_t off = (size_t)row * DM + col;
                        const f32x4 g = *(const f32x4*)(gate + b * MODW + col), xv = *(const f32x4*)(out + off);
                        *(f32x4*)(out + off) = xv + g * acc[ai][bj][m][n]; } }
    }
};

__device__ __forceinline__ void unpack8(const u32x4 w, float* f) {
    f[0] = __uint_as_float(w.x << 16); f[1] = __uint_as_float(w.x & 0xffff0000u); f[2] = __uint_as_float(w.y << 16); f[3] = __uint_as_float(w.y & 0xffff0000u);
    f[4] = __uint_as_float(w.z << 16); f[5] = __uint_as_float(w.z & 0xffff0000u); f[6] = __uint_as_float(w.w << 16); f[7] = __uint_as_float(w.w & 0xffff0000u);
}
__device__ __forceinline__ void conv_phase(const Params& p, const bf16_t* U, bf16_t* Gb, int wv) {
    constexpr int NCH = DFF / 8, NTASK = (MHALF / 32) * NCH;
    const int tid = otid(wv);
    for (int task = blockIdx.x * 512 + tid; task < NTASK; task += gridDim.x * 512) {
        const int ch = task % NCH, strip = task / NCH, r0 = strip * 32, col = ch * 8;
        float wg[3][8], wv[3][8], bg[8], bv[8];
#pragma unroll
        for (int j = 0; j < 3; ++j)
#pragma unroll
            for (int e = 0; e < 8; ++e) { wg[j][e] = p.conv_w[j * NUP + col + e]; wv[j][e] = p.conv_w[j * NUP + DFF + col + e]; }
#pragma unroll
        for (int e = 0; e < 8; ++e) { bg[e] = p.conv_b[col + e]; bv[e] = p.conv_b[DFF + col + e]; }
        float g2[8], g1[8], v2[8], v1[8];
        if ((r0 & (SEQ - 1)) == 0) {
#pragma unroll
            for (int e = 0; e < 8; ++e) { g2[e] = 0.f; g1[e] = 0.f; v2[e] = 0.f; v1[e] = 0.f; }
        } else {
            unpack8(*(const u32x4*)(U + (size_t)(r0 - 2) * NUP + col), g2); unpack8(*(const u32x4*)(U + (size_t)(r0 - 1) * NUP + col), g1);
            unpack8(*(const u32x4*)(U + (size_t)(r0 - 2) * NUP + DFF + col), v2); unpack8(*(const u32x4*)(U + (size_t)(r0 - 1) * NUP + DFF + col), v1);
        }
        for (int r = 0; r < 32; ++r) {
            float g0[8], v0[8], o[8];
            unpack8(*(const u32x4*)(U + (size_t)(r0 + r) * NUP + col), g0); unpack8(*(const u32x4*)(U + (size_t)(r0 + r) * NUP + DFF + col), v0);
#pragma unroll
            for (int e = 0; e < 8; ++e) {
                const float yg = bg[e] + wg[0][e] * g2[e] + wg[1][e] * g1[e] + wg[2][e] * g0[e];
                const float yv = bv[e] + wv[0][e] * v2[e] + wv[1][e] * v1[e] + wv[2][e] * v0[e];
                o[e] = yg / (1.f + __expf(-yg)) * yv;
                g2[e] = g1[e]; g1[e] = g0[e]; v2[e] = v1[e]; v1[e] = v0[e]; }
            u32x4 w; w.x = cvt_pk_bf16(o[0], o[1]); w.y = cvt_pk_bf16(o[2], o[3]); w.z = cvt_pk_bf16(o[4], o[5]); w.w = cvt_pk_bf16(o[6], o[7]);
            *(u32x4*)(Gb + (size_t)(r0 + r) * DFF + col) = w;
        }
    }
}
#ifndef REPM
#define REPM 1
#endif
#ifndef REPK
#define REPK 1
#endif
#ifndef REPT
#define REPT 1
#endif
#ifndef REPA
#define REPA 1
#endif
#ifndef REPB
#define REPB 1
#endif
#ifndef PB
#define PB 7
#endif

constexpr int A_KROW = 272, A_VROW = 320, A_KBUF = 64 * A_KROW, A_VBUF = 64 * A_VROW, A_STG = A_KBUF + A_VBUF;
constexpr int A_TOFF = 2 * A_STG, A_LOFF = A_TOFF + 1280;
__device__ __forceinline__ void attnA_phase(const Params& p, LAS unsigned char* lds, int wv) {
    const int tid = otid(wv), lane = tid & 63, wid = __builtin_amdgcn_readfirstlane(tid >> 6), r32 = lane & 31, hi = lane >> 5;
    const int c = wid >> 2, qg = wid & 3;
    float lam; { float a = p.lam[lane] * p.lam[64 + lane], b2 = p.lam[128 + lane] * p.lam[192 + lane]; a = wave_sum(a); b2 = wave_sum(b2); lam = expf(a) - expf(b2) + 0.2f; }
    const float Mq = wave_max(fabsf(p.qna[lane])), Mk = wave_max(fabsf(p.kna[lane]));
    const unsigned char* AQ = p.ws + WS_AQ; const unsigned char* AK = p.ws + WS_AK; const unsigned char* AV = p.ws + WS_AV;
    bf16_t* CAT = (bf16_t*)(p.ws + WS_CAT);
    LAS float* T = (LAS float*)(lds + A_TOFF);
    LAS float* linv = (LAS float*)(lds + A_LOFF) + wid * 32;
    const int vblkA = (gridDim.x == 256) ? (int)((blockIdx.x & 7) * 32 + (blockIdx.x >> 3)) : (int)blockIdx.x;
    for (int ui = vblkA; ui < 2048 * REPA; ui += gridDim.x) {
        const int v = ui & 255, rnd = (ui >> 8) & 7, bh = v >> 2, pp = (v & 3) + 4 * (rnd >> 1), qb = (rnd & 1) ? 31 - pp : pp;
        const int b = bh >> 2, h = bh & 3, q0 = qb * 128, NT = 2 * qb + 2;
        const size_t tokbase = (size_t)b * SEQ;
        if (tid < 320) { const int d = 223 - tid;
            T[tid] = d < 0 ? -1e30f : (p.rel_bias[t5_bucket(min(d, 127)) * 12 + h] - p.rel_bias[31 * 12 + h]) * LOG2E; }
        bf16x8 qf[4];
        { const unsigned char* Qp = AQ + (tokbase + q0 + 32 * qg + r32) * 1024 + h * 256 + c * 128 + hi * 16;
#pragma unroll
          for (int ds = 0; ds < 4; ++ds) qf[ds] = *(const bf16x8*)(Qp + 32 * ds); }
        const int qpos = q0 + 32 * qg + r32, qw0 = q0 + 32 * qg;
        f32x16 O[4];
#pragma unroll
        for (int e = 0; e < 4; ++e)
#pragma unroll
            for (int r = 0; r < 16; ++r) O[e][r] = 0.f;
        float l = 0.f;
        u32x4 kreg[2], vreg[2];
        const int srow = tid >> 4, sch = tid & 15;
#define A_LOAD(t) do { _Pragma("unroll") for (int i = 0; i < 2; ++i) { const size_t g = (tokbase + 64 * (t) + srow + 32 * i) * 1024 + h * 256 + sch * 16; \
        kreg[i] = *(const u32x4*)(AK + g); vreg[i] = *(const u32x4*)(AV + g); } } while (0)
#define A_WRITE(st) do { _Pragma("unroll") for (int i = 0; i < 2; ++i) { *(LAS u32x4*)(lds + (st) * A_STG + (srow + 32 * i) * A_KROW + sch * 16) = kreg[i]; \
        *(LAS u32x4*)(lds + (st) * A_STG + A_KBUF + (srow + 32 * i) * A_VROW + sch * 16) = vreg[i]; } } while (0)
        A_LOAD(0); A_WRITE(0);
        __syncthreads();
        for (int t = 0; t < NT; ++t) {
            if (t + 1 < NT) A_LOAD(t + 1);
            const int k0 = 64 * t;
            if (k0 <= qw0 + 31) {
                const bool near = (k0 + 63 + 113 > qw0);
                const LAS unsigned char* Kb = lds + (t & 1) * A_STG; const LAS unsigned char* Vb = Kb + A_KBUF;
                f32x16 s0, s1;
#pragma unroll
                for (int r = 0; r < 16; ++r) { s0[r] = 0.f; s1[r] = 0.f; }
                {
                    const LAS unsigned char* kp0 = Kb + (pi32(r32)) * A_KROW + c * 128 + hi * 16;
                    const LAS unsigned char* kp1 = kp0 + 32 * A_KROW;
#pragma unroll
                    for (int ds = 0; ds < 4; ++ds) { const bf16x8 ka = *(const LAS bf16x8*)(kp0 + 32 * ds), kb = *(const LAS bf16x8*)(kp1 + 32 * ds);
                        s0 = __builtin_amdgcn_mfma_f32_32x32x16_bf16(ka, qf[ds], s0, 0, 0, 0); s1 = __builtin_amdgcn_mfma_f32_32x32x16_bf16(kb, qf[ds], s1, 0, 0, 0); }
                }
                __builtin_amdgcn_sched_barrier(0);
                float sacc = 0.f;
#define A_SOFTMAX(S, HF) do { \
                    if (!near) { _Pragma("unroll") for (int r = 0; r < 16; ++r) S[r] = __builtin_amdgcn_exp2f(S[r]); } \
                    else { int ib = 223 - (qpos - k0 - 8 * hi - 32 * (HF)); asm volatile("" : "+v"(ib)); const LAS float* tp = T + ib; \
                        _Pragma("unroll") for (int r = 0; r < 16; ++r) S[r] = __builtin_amdgcn_exp2f(S[r] + tp[16 * (r >> 3) + (r & 7)]); } \
                    _Pragma("unroll") for (int r = 0; r < 16; ++r) sacc += S[r]; } while (0)
#define A_PV(S, HF) do { \
                    _Pragma("unroll") for (int jj = 0; jj < 2; ++jj) { \
                        const int j = 2 * (HF) + jj, rb = 8 * jj; \
                        u32x4 pw; pw.x = cvt_pk_bf16(S[rb], S[rb + 1]); pw.y = cvt_pk_bf16(S[rb + 2], S[rb + 3]); pw.z = cvt_pk_bf16(S[rb + 4], S[rb + 5]); pw.w = cvt_pk_bf16(S[rb + 6], S[rb + 7]); \
                        const bf16x8 pa = __builtin_bit_cast(bf16x8, pw); \
                        const LAS unsigned char* vp = Vb + (16 * j + 8 * hi + ((lane & 15) >> 2)) * A_VROW + (16 * ((lane >> 4) & 1) + 4 * (lane & 3)) * 2; \
                        _Pragma("unroll") for (int eb = 0; eb < 4; ++eb) { \
                            const s16x4 lo = vtr(vp + eb * 64), hh = vtr(vp + 4 * A_VROW + eb * 64); \
                            const bf16x8 vf = (bf16x8){lo[0], lo[1], lo[2], lo[3], hh[0], hh[1], hh[2], hh[3]}; \
                            O[eb] = __builtin_amdgcn_mfma_f32_32x32x16_bf16(pa, vf, O[eb], 0, 0, 0); } } } while (0)
                A_SOFTMAX(s0, 0);
                __builtin_amdgcn_sched_barrier(0);
                A_PV(s0, 0);
                A_SOFTMAX(s1, 1);
                __builtin_amdgcn_sched_barrier(0);
                A_PV(s1, 1);
#undef A_SOFTMAX
#undef A_PV
                l += sacc;
            }
            if (t + 1 < NT) A_WRITE((t + 1) & 1);
            __syncthreads();
        }
#undef A_LOAD
#undef A_WRITE
        l += __shfl_xor(l, 32);
        if (hi == 0) linv[r32] = (c == 1 ? lam : 1.f) / l;
        LAS float* comb = (LAS float*)lds + qg * (32 * 128);
        float f[16];
#pragma unroll
        for (int r = 0; r < 16; ++r) f[r] = linv[crow(r, hi)];
#pragma unroll
        for (int eb = 0; eb < 4; ++eb)
#pragma unroll
            for (int r = 0; r < 16; ++r) O[eb][r] *= f[r];
        if (c == 1) {
#pragma unroll
            for (int eb = 0; eb < 4; ++eb)
#pragma unroll
                for (int r = 0; r < 16; ++r) comb[crow(r, hi) * 128 + 32 * eb + r32] = O[eb][r];
        }
        __syncthreads();
        if (c == 0) {
            float gl[4];
#pragma unroll
            for (int eb = 0; eb < 4; ++eb) gl[eb] = p.subln[32 * eb + r32] * 0.8f;
#pragma unroll
            for (int r = 0; r < 16; ++r) {
                const int qr = crow(r, hi); float ss = 0.f;
#pragma unroll
                for (int eb = 0; eb < 4; ++eb) { O[eb][r] -= comb[qr * 128 + 32 * eb + r32]; ss += O[eb][r] * O[eb][r]; }
                ss += __shfl_xor(ss, 1); ss += __shfl_xor(ss, 2); ss += __shfl_xor(ss, 4); ss += __shfl_xor(ss, 8); ss += __shfl_xor(ss, 16);
                const float rs = 1.0f / sqrtf(ss * (1.f / 128.f) + EPS);
                bf16_t* op = CAT + (tokbase + q0 + 32 * qg + qr) * 1024 + h * 128 + r32;
#pragma unroll
                for (int eb = 0; eb < 4; ++eb) op[32 * eb] = (bf16_t)(cvt_pk_bf16(O[eb][r] * rs * gl[eb], 0.f) & 0xffffu);
            }
        }
        __syncthreads();
    }
}

#ifndef SKIP
#define SKIP 0
#endif
constexpr int B_QROW = 1040;
constexpr int B_HIST = 66560, B_HROW = 257;
constexpr int B_TOFF = B_HIST + 64 * B_HROW * 4;
constexpr int B_DT = 75776;
constexpr int B_INFO = B_TOFF + 4096;
constexpr int B_LINV = B_INFO + 1024;
constexpr int B_MASK = 98304, B_MROW = 130;
__device__ __forceinline__ unsigned ord_key(float f) { const unsigned u = __float_as_uint(f); return u ^ ((u >> 31) ? 0xffffffffu : 0x80000000u); }
__device__ __forceinline__ void phaseB(const Params& p, LAS unsigned char* lds, int wv) {
    const _Float16* IQ = (const _Float16*)(p.ws + WS_IQ); const _Float16* IK = (const _Float16*)(p.ws + WS_IK); const float* IW = (const float*)(p.ws + WS_IW);
    const unsigned char* BQ = p.ws + WS_BQ; const unsigned char* BK = p.ws + WS_BK; const unsigned char* BV = p.ws + WS_BV;
    bf16_t* CAT = (bf16_t*)(p.ws + WS_CAT);
    float* SC = (float*)(p.ws + WS_SC + (size_t)blockIdx.x * MiB);
    LAS float* Tb = (LAS float*)(lds + B_DT);
    LAS unsigned* hist = (LAS unsigned*)(lds + B_HIST);
    LAS unsigned* pfx = (LAS unsigned*)(lds + B_INFO); LAS int* needv = (LAS int*)(lds + B_INFO + 256); LAS unsigned* ceqv = (LAS unsigned*)(lds + B_INFO + 512); LAS int* cutv = (LAS int*)(lds + B_INFO + 768);
    const int vblkB = (gridDim.x == 256) ? (int)((blockIdx.x & 7) * 32 + (blockIdx.x >> 3)) : (int)blockIdx.x;
    for (int ui = vblkB; ui < 1024 * REPB; ui += gridDim.x) {
        const int v = ui & 255, rnd = (ui >> 8) & 3, b = v >> 4, pp = (v & 15) + 16 * (rnd >> 1), qb = (rnd & 1) ? 63 - pp : pp;
        const int q0 = 64 * qb, NT = qb + 1;
        const size_t tokbase = (size_t)b * SEQ;
        {
        const int tid = otid(wv);
        const int lane = tid & 63, wid = __builtin_amdgcn_readfirstlane(tid >> 6), r32 = lane & 31, hi = lane >> 5; (void)r32; (void)hi; (void)wid;
#pragma unroll
        for (int i = 0; i < 8; ++i) { const int id = tid + 512 * i, row = id >> 6, ch = id & 63;
            *(LAS u32x4*)(lds + row * B_QROW + ch * 16) = *(const u32x4*)((const unsigned char*)IQ + (tokbase + q0 + row) * 1024 + ch * 16); }
        for (int i = tid; i < 64 * B_HROW; i += 512) hist[i] = 0u;
        if (tid < 64) { const int n = q0 + tid + 1; pfx[tid] = 0u; needv[tid] = (n > 256) ? 256 : -1; ceqv[tid] = 0u; cutv[tid] = 4096; }
        __syncthreads();
#if !(SKIP & 1)
        {
            const int qg = wid & 1, ks = wid >> 1;
            const float* wp = IW + (tokbase + q0 + 32 * qg + r32) * 8;
            const LAS unsigned char* qp = lds + (32 * qg + r32) * B_QROW + hi * 16;
            LAS unsigned* hrow = hist + (32 * qg + r32) * B_HROW;
            const int tq = q0 + 32 * qg + r32;
#pragma unroll 1
            for (int rep1 = 0; rep1 < REPK; ++rep1)
#pragma unroll 1
            for (int kt = ks; kt < NT; kt += 4) {
                const int k0 = 64 * kt;
                f16x8 kf[2][4];
#pragma unroll
                for (int hf = 0; hf < 2; ++hf)
#pragma unroll
                    for (int ds = 0; ds < 4; ++ds) kf[hf][ds] = *(const f16x8*)(IK + (tokbase + k0 + 32 * hf + pi32(r32)) * 64 + 16 * ds + 8 * hi);
                f32x16 acc0, acc1;
#pragma unroll
                for (int r = 0; r < 16; ++r) { acc0[r] = 0.f; acc1[r] = 0.f; }
#pragma unroll 2
                for (int hh = 0; hh < 8; ++hh) {
                    const float wh = wp[hh];
                    f32x16 s0, s1;
#pragma unroll
                    for (int r = 0; r < 16; ++r) { s0[r] = 0.f; s1[r] = 0.f; }
#pragma unroll
                    for (int ds = 0; ds < 4; ++ds) { const f16x8 qfr = *(const LAS f16x8*)(qp + hh * 128 + ds * 32);
                        s0 = __builtin_amdgcn_mfma_f32_32x32x16_f16(kf[0][ds], qfr, s0, 0, 0, 0); s1 = __builtin_amdgcn_mfma_f32_32x32x16_f16(kf[1][ds], qfr, s1, 0, 0, 0); }
#pragma unroll
                    for (int r = 0; r < 16; ++r) { acc0[r] += wh * fmaxf(s0[r], 0.f); acc1[r] += wh * fmaxf(s1[r], 0.f); }
                }
                float* sp = SC + (size_t)(32 * qg + r32) * SEQ + k0 + 8 * hi;
                *(f32x4*)(sp) = (f32x4){acc0[0], acc0[1], acc0[2], acc0[3]}; *(f32x4*)(sp + 4) = (f32x4){acc0[4], acc0[5], acc0[6], acc0[7]};
                *(f32x4*)(sp + 16) = (f32x4){acc0[8], acc0[9], acc0[10], acc0[11]}; *(f32x4*)(sp + 20) = (f32x4){acc0[12], acc0[13], acc0[14], acc0[15]};
                *(f32x4*)(sp + 32) = (f32x4){acc1[0], acc1[1], acc1[2], acc1[3]}; *(f32x4*)(sp + 36) = (f32x4){acc1[4], acc1[5], acc1[6], acc1[7]};
                *(f32x4*)(sp + 48) = (f32x4){acc1[8], acc1[9], acc1[10], acc1[11]}; *(f32x4*)(sp + 52) = (f32x4){acc1[12], acc1[13], acc1[14], acc1[15]};
                if (q0 + 63 > 255 && rep1 == 0) {
                    int e0 = k0 + 8 * hi; asm volatile("" : "+v"(e0));
#pragma unroll
                    for (int r = 0; r < 16; ++r) { const int kp0 = e0 + 16 * (r >> 3) + (r & 7);
                        if (kp0 <= tq) atomicAdd((unsigned*)&hrow[ord_key(acc0[r]) >> 24], 1u);
                        if (kp0 + 32 <= tq) atomicAdd((unsigned*)&hrow[ord_key(acc1[r]) >> 24], 1u); }
                }
            }
        }
#endif
        }
        __builtin_amdgcn_fence(__ATOMIC_RELEASE, "workgroup");
        __syncthreads();
        __builtin_amdgcn_fence(__ATOMIC_ACQUIRE, "workgroup");
        {
        const int tid = otid(wv);
        const int lane = tid & 63, wid = __builtin_amdgcn_readfirstlane(tid >> 6);
#pragma unroll 1
        for (int rr = 0; rr < 8; ++rr) {
            const int row = wid * 8 + rr; const int need = needv[row];
            if (need > 0) {
                const LAS unsigned* hr = hist + row * B_HROW + 4 * lane;
                const unsigned c0 = hr[0], c1 = hr[1], c2 = hr[2], c3 = hr[3];
                const unsigned sl = c0 + c1 + c2 + c3; unsigned suf = sl;
#pragma unroll
                for (int o = 1; o < 64; o <<= 1) { const unsigned tv = __shfl_down(suf, o); if (lane + o < 64) suf += tv; }
                unsigned cum = suf - sl; int fbin = -1; unsigned fabove = 0u, fcnt = 0u;
                { if ((int)cum < need && (int)(cum + c3) >= need) { fbin = 4 * lane + 3; fabove = cum; fcnt = c3; } cum += c3;
                  if ((int)cum < need && (int)(cum + c2) >= need) { fbin = 4 * lane + 2; fabove = cum; fcnt = c2; } cum += c2;
                  if ((int)cum < need && (int)(cum + c1) >= need) { fbin = 4 * lane + 1; fabove = cum; fcnt = c1; } cum += c1;
                  if ((int)cum < need && (int)(cum + c0) >= need) { fbin = 4 * lane + 0; fabove = cum; fcnt = c0; } }
                if (fbin >= 0) { pfx[row] = (unsigned)fbin << 24; needv[row] = need - (int)fabove; ceqv[row] = fcnt; }
            }
        }
        }
        __syncthreads();
        {
            const int tid = otid(wv);
            for (int i = tid; i < 2560; i += 512) { const int hh = i / 320, d = 223 - (i - 320 * hh);
                Tb[i] = d < 0 ? -1e30f : (p.rel_bias[t5_bucket(min(d, 127)) * 12 + 4 + hh] - p.rel_bias[31 * 12 + 4 + hh]) * LOG2E; }
        }
        {
        const int tid = otid(wv);
        const int lane = tid & 63, wid = __builtin_amdgcn_readfirstlane(tid >> 6);
        LAS unsigned* wh = (LAS unsigned*)lds + wid * 320;
        const int nwords = 2 * NT;
        u32x4 bufA[16], bufB[16];
#define ROW_LOAD(buf, rowi) do { const float* sr_ = SC + (size_t)(rowi) * SEQ + 4 * lane; _Pragma("unroll") for (int i = 0; i < 16; ++i) { buf[i] = (u32x4){0u, 0u, 0u, 0u}; if (256 * i <= q0 + 63) buf[i] = *(const u32x4*)(sr_ + 256 * i); } } while (0)
#define OKEY(u) ((u) ^ (((u) >> 31) ? 0xffffffffu : 0x80000000u))
#define ROW_PROC(key, rowi) do { \
            const int row = (rowi), tr = q0 + row; \
            unsigned thr = 0u; int cut = -1; \
            int need = needv[row]; \
            _Pragma("unroll") for (int i = 0; i < 16; ++i) { const int e = 256 * i + 4 * lane; \
                key[i].x = (e <= tr) ? OKEY(key[i].x) : 0u; key[i].y = (e + 1 <= tr) ? OKEY(key[i].y) : 0u; key[i].z = (e + 2 <= tr) ? OKEY(key[i].z) : 0u; key[i].w = (e + 3 <= tr) ? OKEY(key[i].w) : 0u; } \
            if (need > 0) { \
                unsigned prefix = pfx[row]; unsigned cnt = ceqv[row]; bool done = false; \
                if (need == (int)cnt) { thr = prefix - 1u; done = true; } \
                _Pragma("unroll 1") for (int pass = 1; pass < 4 && !done; ++pass) { \
                    const int shift = 24 - 8 * pass; const unsigned msk = 0xffffffffu << (shift + 8); \
                    wh[lane] = 0u; wh[64 + lane] = 0u; wh[128 + lane] = 0u; wh[192 + lane] = 0u; \
                    _Pragma("unroll") for (int i = 0; i < 16; ++i) { \
                        { const unsigned k = key[i].x; atomicAdd((unsigned*)&wh[((k & msk) == prefix) ? ((k >> shift) & 255u) : (256u + lane)], 1u); } \
                        { const unsigned k = key[i].y; atomicAdd((unsigned*)&wh[((k & msk) == prefix) ? ((k >> shift) & 255u) : (256u + lane)], 1u); } \
                        { const unsigned k = key[i].z; atomicAdd((unsigned*)&wh[((k & msk) == prefix) ? ((k >> shift) & 255u) : (256u + lane)], 1u); } \
                        { const unsigned k = key[i].w; atomicAdd((unsigned*)&wh[((k & msk) == prefix) ? ((k >> shift) & 255u) : (256u + lane)], 1u); } } \
                    const unsigned c0 = wh[4 * lane], c1 = wh[4 * lane + 1], c2 = wh[4 * lane + 2], c3 = wh[4 * lane + 3]; \
                    const unsigned sl = c0 + c1 + c2 + c3; unsigned suf = sl; \
                    _Pragma("unroll") for (int o = 1; o < 64; o <<= 1) { const unsigned tv = __shfl_down(suf, o); if (lane + o < 64) suf += tv; } \
                    unsigned cum = suf - sl; int fbin = -1; unsigned fabove = 0u, fcnt = 0u; \
                    { if ((int)cum < need && (int)(cum + c3) >= need) { fbin = 4 * lane + 3; fabove = cum; fcnt = c3; } cum += c3; \
                      if ((int)cum < need && (int)(cum + c2) >= need) { fbin = 4 * lane + 2; fabove = cum; fcnt = c2; } cum += c2; \
                      if ((int)cum < need && (int)(cum + c1) >= need) { fbin = 4 * lane + 1; fabove = cum; fcnt = c1; } cum += c1; \
                      if ((int)cum < need && (int)(cum + c0) >= need) { fbin = 4 * lane + 0; fabove = cum; fcnt = c0; } } \
                    const unsigned long long bm = __ballot(fbin >= 0); const int src = __ffsll((long long)bm) - 1; \
                    const int bin = __shfl(fbin, src); const unsigned above = __shfl(fabove, src); cnt = __shfl(fcnt, src); \
                    prefix |= (unsigned)bin << shift; need -= (int)above; \
                    if (pass < 3 && need == (int)cnt) { thr = prefix - 1u; done = true; } \
                } \
                if (!done) { thr = prefix; cut = 4096; \
                    if (need < (int)cnt) {        \
                        const float* srow = SC + (size_t)row * SEQ; int tbase = 0; \
                        for (int j = 0; j * 64 <= tr; ++j) { const int e = 64 * j + lane; const bool eq = (e <= tr) && (ord_key(srow[e]) == thr); \
                            const unsigned long long be = __ballot(eq); \
                            const int tpos = tbase + (int)__builtin_amdgcn_mbcnt_hi((unsigned)(be >> 32), __builtin_amdgcn_mbcnt_lo((unsigned)be, 0u)); \
                            const unsigned long long bh = __ballot(eq && tpos == need - 1); \
                            if (bh) { cut = 64 * j + (__ffsll((long long)bh) - 1); break; } \
                            tbase += __popcll(be); } \
                    } \
                } \
            } \
            LAS unsigned* mw = (LAS unsigned*)(lds + B_MASK) + row * B_MROW; \
            _Pragma("unroll") for (int i = 0; i < 16; ++i) if (256 * i <= q0 + 63) { const int e = 256 * i + 4 * lane; \
                unsigned nib = 0u; \
                nib |= (key[i].x > thr || (key[i].x == thr && e <= cut)) ? 1u : 0u; nib |= (key[i].y > thr || (key[i].y == thr && e + 1 <= cut)) ? 2u : 0u; \
                nib |= (key[i].z > thr || (key[i].z == thr && e + 2 <= cut)) ? 4u : 0u; nib |= (key[i].w > thr || (key[i].w == thr && e + 3 <= cut)) ? 8u : 0u; \
                unsigned v = nib << (4 * (lane & 7)); v |= __shfl_xor(v, 1); v |= __shfl_xor(v, 2); v |= __shfl_xor(v, 4); \
                const int w = 8 * i + (lane >> 3); if ((lane & 7) == 0 && w < nwords) mw[w] = v; } \
        } while (0)
        ROW_LOAD(bufA, wid * 8);
#pragma unroll 1
        for (int rr = 0; rr < 8; rr += 2) {
            ROW_LOAD(bufB, wid * 8 + rr + 1);
            ROW_PROC(bufA, wid * 8 + rr);
            if (rr + 2 < 8) ROW_LOAD(bufA, wid * 8 + rr + 2);
            ROW_PROC(bufB, wid * 8 + rr + 1);
        }
#undef ROW_LOAD
#undef ROW_PROC
#undef OKEY
        }
        __syncthreads();
#pragma unroll 1
        for (int rep3 = 0; rep3 < ((SKIP & 8) ? 0 : REPT); ++rep3) {
        const int tid = otid(wv);
        const int lane = tid & 63, wid = __builtin_amdgcn_readfirstlane(tid >> 6), r32 = lane & 31, hi = lane >> 5; (void)r32; (void)hi; (void)wid;
            LAS float* linv = (LAS float*)(lds + B_LINV) + wid * 64;
            const int qg = wid & 1, hp = wid >> 1, g = hp >> 1;
            const int qpos = q0 + 32 * qg + r32, qw0 = q0 + 32 * qg;
            const unsigned char* Qp0 = BQ + (tokbase + qpos) * 1024 + (2 * hp) * 128 + hi * 16;
            const LAS unsigned* mrow = (const LAS unsigned*)(lds + B_MASK) + (32 * qg + r32) * B_MROW;
            bf16x8 qf2[2][4];
#pragma unroll
            for (int hh = 0; hh < 2; ++hh)
#pragma unroll
                for (int ds = 0; ds < 4; ++ds) qf2[hh][ds] = *(const bf16x8*)(Qp0 + hh * 128 + 32 * ds);
            f32x16 O[2][2];
#pragma unroll
            for (int hh = 0; hh < 2; ++hh)
#pragma unroll
                for (int db = 0; db < 2; ++db)
#pragma unroll
                    for (int r = 0; r < 16; ++r) O[hh][db][r] = 0.f;
            float l0 = 0.f, l1 = 0.f;
            u32x4 kreg[2], vreg[2];
            const int srow_ = tid >> 4, sch = tid & 15;
#define B_LOAD(t) do { _Pragma("unroll") for (int i = 0; i < 2; ++i) { const size_t gofs = (tokbase + 64 * (t) + srow_ + 32 * i) * 256 + sch * 16; \
            kreg[i] = *(const u32x4*)(BK + gofs); vreg[i] = *(const u32x4*)(BV + gofs); } } while (0)
#define B_WRITE(st) do { _Pragma("unroll") for (int i = 0; i < 2; ++i) { *(LAS u32x4*)(lds + (st) * A_STG + (srow_ + 32 * i) * A_KROW + sch * 16) = kreg[i]; \
            *(LAS u32x4*)(lds + (st) * A_STG + A_KBUF + (srow_ + 32 * i) * A_VROW + sch * 16) = vreg[i]; } } while (0)
            B_LOAD(0); B_WRITE(0);
            __syncthreads();
#pragma unroll 1
            for (int t = 0; t < NT; ++t) {
                if (t + 1 < NT) B_LOAD(t + 1);
                const int k0 = 64 * t;
                const bool near = (k0 + 63 + 113 > qw0);
                const LAS unsigned char* Kb = lds + (t & 1) * A_STG; const LAS unsigned char* Vb = Kb + A_KBUF;
                unsigned selm;
                { const unsigned w0 = mrow[2 * t] >> (8 * hi), w1 = mrow[2 * t + 1] >> (8 * hi);
                  selm = (w0 & 0xffu) | ((w0 >> 8) & 0xff00u) | ((w1 & 0xffu) << 16) | ((w1 << 8) & 0xff000000u); }
                float sacc0 = 0.f, sacc1 = 0.f;
#pragma unroll
                for (int hf = 0; hf < 2; ++hf) {
                    f32x16 s0, s1;
#pragma unroll
                    for (int r = 0; r < 16; ++r) { const float cm = ((selm >> (16 * hf + r)) & 1u) ? 0.f : -1e30f; s0[r] = cm; s1[r] = cm; }
                    const LAS unsigned char* kp = Kb + (32 * hf + pi32(r32)) * A_KROW + g * 128 + hi * 16;
#pragma unroll
                    for (int ds = 0; ds < 4; ++ds) { const bf16x8 kf = *(const LAS bf16x8*)(kp + 32 * ds);
                        s0 = __builtin_amdgcn_mfma_f32_32x32x16_bf16(kf, qf2[0][ds], s0, 0, 0, 0); s1 = __builtin_amdgcn_mfma_f32_32x32x16_bf16(kf, qf2[1][ds], s1, 0, 0, 0); }
                    if (!near) {
#pragma unroll
                        for (int r = 0; r < 16; ++r) { s0[r] = __builtin_amdgcn_exp2f(s0[r]); s1[r] = __builtin_amdgcn_exp2f(s1[r]); }
                    } else {
                        int ib = 223 - (qpos - k0 - 8 * hi - 32 * hf); asm volatile("" : "+v"(ib));
                        const LAS float* tp0 = Tb + (2 * hp) * 320 + ib; const LAS float* tp1 = tp0 + 320;
#pragma unroll
                        for (int r = 0; r < 16; ++r) { s0[r] = __builtin_amdgcn_exp2f(s0[r] + tp0[16 * (r >> 3) + (r & 7)]); s1[r] = __builtin_amdgcn_exp2f(s1[r] + tp1[16 * (r >> 3) + (r & 7)]); }
                    }
#pragma unroll
                    for (int r = 0; r < 16; ++r) { sacc0 += s0[r]; sacc1 += s1[r]; }
#pragma unroll
                    for (int jj = 0; jj < 2; ++jj) {
                        const int j = 2 * hf + jj, rb = 8 * jj;
                        u32x4 pw0, pw1;
                        pw0.x = cvt_pk_bf16(s0[rb], s0[rb + 1]); pw0.y = cvt_pk_bf16(s0[rb + 2], s0[rb + 3]); pw0.z = cvt_pk_bf16(s0[rb + 4], s0[rb + 5]); pw0.w = cvt_pk_bf16(s0[rb + 6], s0[rb + 7]);
                        pw1.x = cvt_pk_bf16(s1[rb], s1[rb + 1]); pw1.y = cvt_pk_bf16(s1[rb + 2], s1[rb + 3]); pw1.z = cvt_pk_bf16(s1[rb + 4], s1[rb + 5]); pw1.w = cvt_pk_bf16(s1[rb + 6], s1[rb + 7]);
                        const bf16x8 pa0 = __builtin_bit_cast(bf16x8, pw0), pa1 = __builtin_bit_cast(bf16x8, pw1);
                        const LAS unsigned char* vp = Vb + (16 * j + 8 * hi + ((lane & 15) >> 2)) * A_VROW + (g * 64 + 16 * ((lane >> 4) & 1) + 4 * (lane & 3)) * 2;
#pragma unroll
                        for (int db = 0; db < 2; ++db) {
                            const s16x4 lo = vtr(vp + db * 64), hv = vtr(vp + 4 * A_VROW + db * 64);
                            const bf16x8 vf = (bf16x8){lo[0], lo[1], lo[2], lo[3], hv[0], hv[1], hv[2], hv[3]};
                            O[0][db] = __builtin_amdgcn_mfma_f32_32x32x16_bf16(pa0, vf, O[0][db], 0, 0, 0);
                            O[1][db] = __builtin_amdgcn_mfma_f32_32x32x16_bf16(pa1, vf, O[1][db], 0, 0, 0);
                        }
                    }
                    __builtin_amdgcn_sched_barrier(0);
                }
                l0 += sacc0; l1 += sacc1;
                if (t + 1 < NT) B_WRITE((t + 1) & 1);
                __syncthreads();
            }
#undef B_LOAD
#undef B_WRITE
            l0 += __shfl_xor(l0, 32); l1 += __shfl_xor(l1, 32);
            if (hi == 0) { linv[r32] = 1.0f / l0; linv[32 + r32] = 1.0f / l1; }
#pragma unroll
            for (int hh = 0; hh < 2; ++hh)
#pragma unroll
                for (int r = 0; r < 16; ++r) { const int qr = crow(r, hi); const float f = linv[32 * hh + qr];
                    bf16_t* op = CAT + (tokbase + q0 + 32 * qg + qr) * 1024 + 512 + (2 * hp + hh) * 64 + r32;
#pragma unroll
                    for (int db = 0; db < 2; ++db) op[32 * db] = (bf16_t)(cvt_pk_bf16(O[hh][db][r] * f, 0.f) & 0xffffu); }
            if (REPT > 1) __syncthreads();
        }
        __syncthreads();
    }
}
#ifndef REPG1
#define REPG1 1
#endif
#ifndef REPG2
#define REPG2 1
#endif
#ifndef REPG3
#define REPG3 1
#endif
#ifndef PH
#define PH 255
#endif

#define XB_TMO      128
#define XB_XCNT(j)  (256  + 64 * (j))
#define XB_XSUB(j)  (1280 + 64 * (j))
#define XB_XGEN(j)  (2304 + 64 * (j))
#define XB_TOP      3328
#define XB_TOPGEN   3392
#define XCD_BAR_WORDS 3456
#define XB_SPIN_CAP (1u << 18)

__device__ __forceinline__ unsigned xb_ld(unsigned* p)              { return __hip_atomic_load(p, __ATOMIC_RELAXED, __HIP_MEMORY_SCOPE_AGENT); }
__device__ __forceinline__ unsigned xb_add(unsigned* p, unsigned v) { return __hip_atomic_fetch_add(p, v, __ATOMIC_RELAXED, __HIP_MEMORY_SCOPE_AGENT); }
__device__ __forceinline__ unsigned xb_xcc_id() { return (unsigned)__builtin_amdgcn_s_getreg((3 << 11) | 20) & 0xFu; }
#define XB_SPIN(cond, bar) do { unsigned _sp = 0; while (cond) { __builtin_amdgcn_s_sleep(1); \
    if ((++_sp & 255u) == 0u) { if (xb_ld(&(bar)[XB_TMO])) break; if (_sp > XB_SPIN_CAP) { atomicAdd(&(bar)[XB_TMO], 1u); break; } } } } while (0)

struct XcdBarrier {
    unsigned* bar; unsigned x;
    volatile LAS unsigned* st;
};

__device__ __forceinline__ XcdBarrier xcd_barrier_post(unsigned* bar, volatile LAS unsigned* st) {
    XcdBarrier b; b.bar = bar; b.x = xb_xcc_id(); b.st = st;
    if (threadIdx.x == 0) (void)xb_add(&bar[XB_XCNT(b.x)], 1u);
    return b;
}
__device__ __forceinline__ void xcd_barrier_complete(unsigned* bar, unsigned x, unsigned& nloc, unsigned& nx) {
    const unsigned G = gridDim.x * gridDim.y * gridDim.z;
    unsigned sum, cnt, mine, sp = 0u;
    for (;;) {
        sum = 0u; cnt = 0u; mine = 0u;
#pragma unroll
        for (unsigned j = 0; j < 16; ++j) { const unsigned c = xb_ld(&bar[XB_XCNT(j)]); sum += c; cnt += (c > 0u) ? 1u : 0u; mine = (j == x) ? c : mine; }
        if (sum == G) break;
        __builtin_amdgcn_s_sleep(1);
        if ((++sp & 255u) == 0u) { if (xb_ld(&bar[XB_TMO])) break; if (sp > XB_SPIN_CAP) { atomicAdd(&bar[XB_TMO], 1u); break; } }
    }
    nloc = mine > 0u ? mine : 1u; nx = cnt > 0u ? cnt : 1u;
}

__device__ __forceinline__ void xcd_barrier(const XcdBarrier& b) {
    asm volatile("s_waitcnt vmcnt(0)" ::: "memory");
    __syncthreads();
    if (threadIdx.x == 0) {
        unsigned* bar = b.bar;
        __builtin_amdgcn_s_waitcnt(0);
        unsigned nloc = b.st[0], nx = b.st[1];
        if (nloc == 0u) { xcd_barrier_complete(bar, b.x, nloc, nx); b.st[0] = nloc; b.st[1] = nx; }
        const unsigned old = xb_add(&bar[XB_XSUB(b.x)], 1u);
        const unsigned gen = old / nloc;
        if (old + 1u == (gen + 1u) * nloc) {
            __builtin_amdgcn_fence(__ATOMIC_RELEASE, "agent");
            asm volatile("s_waitcnt vmcnt(0)" ::: "memory");
            const unsigned og = xb_add(&bar[XB_TOP], 1u);
            const unsigned tg = og / nx;
            if (og + 1u == (tg + 1u) * nx) xb_add(&bar[XB_TOPGEN], 1u);
            else XB_SPIN(xb_ld(&bar[XB_TOPGEN]) == tg, bar);
            __builtin_amdgcn_fence(__ATOMIC_ACQUIRE, "agent");
            xb_add(&bar[XB_XGEN(b.x)], 1u);
            asm volatile("s_waitcnt vmcnt(0)" ::: "memory");
        } else {
            XB_SPIN(xb_ld(&bar[XB_XGEN(b.x)]) == gen, bar);
            __builtin_amdgcn_fence(__ATOMIC_ACQUIRE, "agent");
            asm volatile("s_waitcnt vmcnt(0)" ::: "memory");
        }
    }
    __syncthreads();
}

constexpr size_t WS_BAR = 786432;
constexpr int XB_LDS_OFF = LDS_BYTES - 16;
typedef const __attribute__((address_space(4))) Params* KParamsPtr;
__device__ __forceinline__ Params load_params(KParamsPtr q) {
    Params r; r.x = q->x; r.c = q->c; r.w_ada = q->w_ada; r.b_ada = q->b_ada; r.g_attn = q->g_attn; r.w_in = q->w_in; r.qna = q->qna; r.kna = q->kna; r.qnb = q->qnb; r.knb = q->knb;
    r.lam = q->lam; r.subln = q->subln; r.w_out = q->w_out; r.g_ffn = q->g_ffn; r.w_up = q->w_up; r.conv_w = q->conv_w; r.conv_b = q->conv_b; r.w_down = q->w_down; r.rel_bias = q->rel_bias;
    r.out = q->out; r.ws = q->ws; return r;
}
#define FRESH_PARAMS() KParamsPtr pp_ = (KParamsPtr)__builtin_amdgcn_kernarg_segment_ptr(); asm volatile("" : "+s"(pp_)); const Params p = load_params(pp_); \
    float* mod = (float*)(p.ws + WS_MOD); bf16_t* H = (bf16_t*)(p.ws + WS_H); const int G = (int)gridDim.x, cb = (int)blockIdx.x; (void)mod; (void)H; (void)G; (void)cb
__global__ void __launch_bounds__(512, 2) hybrid_block_fwd(Params p_unused) {
    extern __shared__ __attribute__((aligned(16))) unsigned char lds_raw[];
    LAS unsigned char* lds = (LAS unsigned char*)lds_raw;
    cg::grid_group grid = cg::this_grid();
    if (threadIdx.x < 4) ((LAS unsigned*)(lds + XB_LDS_OFF))[threadIdx.x] = 0u;
    __syncthreads();
    const int wv = __builtin_amdgcn_readfirstlane((int)threadIdx.x >> 6);
    { FRESH_PARAMS(); if (blockIdx.x == 0) { unsigned* bw = (unsigned*)(p.ws + WS_BAR); for (int i = threadIdx.x; i < XCD_BAR_WORDS; i += 512) bw[i] = 0u; }
      phase0(p, lds, wv); }
    grid.sync();
    XcdBarrier bar;
    { FRESH_PARAMS(); bar = xcd_barrier_post((unsigned*)(p.ws + WS_BAR), (volatile LAS unsigned*)(lds + XB_LDS_OFF)); }
    { FRESH_PARAMS(); norm_phase(p.x, p.g_attn, mod, 1024, 0, H, wv); }
    xcd_barrier(bar);
    {
        FRESH_PARAMS();
        pg8::Gemm g{H, (const bf16_t*)(p.ws + WS_WIN), MTOK, NPROJ, DM}; pg8::StaticOrder S; S.init(MTOK, NPROJ, G, cb);
        EpiProj E{p.ws, p.qna, p.kna, p.qnb, p.knb};
#pragma unroll 1
        for (int rep = 0; rep < REPG1; ++rep) pg8::gemm_phase<EpiProj, pg8::StaticOrder, true, true>(lds, g, S, E, wv);
    }
    xcd_barrier(bar);
    { FRESH_PARAMS(); attnA_phase(p, lds, wv); }
    __syncthreads();
    { FRESH_PARAMS(); phaseB(p, lds, wv); }
    xcd_barrier(bar);
    {
        FRESH_PARAMS();
        pg8::Gemm g{(const bf16_t*)(p.ws + WS_CAT), (const bf16_t*)(p.ws + WS_WOUT), MTOK, DM, DM}; pg8::StaticOrder S; S.init(MTOK, DM, G, cb);
        EpiOut E{p.x, mod + 2048, p.out};
#pragma unroll 1
        for (int rep = 0; rep < REPG2; ++rep) pg8::gemm_phase<EpiOut, pg8::StaticOrder, true, true>(lds, g, S, E, wv);
    }
    xcd_barrier(bar);
    { FRESH_PARAMS(); norm_phase(p.out, p.g_ffn, mod, 4096, 3072, H, wv); }
    xcd_barrier(bar);
    {
        FRESH_PARAMS();
        pg8::Gemm g{H - 2 * DM, (const bf16_t*)(p.ws + WS_WUP), 259 * 256, NUP, DM, 254}; pg8::StaticOrder S; S.init(259 * 256, NUP, G, cb);
        EpiUpConv E{(bf16_t*)(p.ws + WS_U), p.conv_w, p.conv_b, (LAS float*)(lds + HALO_OFF)};
#pragma unroll 1
        for (int rep = 0; rep < REPG3; ++rep) pg8::gemm_phase<EpiUpConv, pg8::StaticOrder, true, true>(lds, g, S, E, wv);
    }
    xcd_barrier(bar);
    {
        FRESH_PARAMS();
        pg8::Gemm g{(const bf16_t*)(p.ws + WS_U), (const bf16_t*)(p.ws + WS_WDN), MTOK, DM, DFF}; pg8::StaticOrder S; S.init(MTOK, DM, G, cb);
        EpiDown E{mod + 5120, p.out, 0};
        pg8::gemm_phase<EpiDown, pg8::StaticOrder, true, true>(lds, g, S, E, wv);
    }
}

extern "C" void kernel_launch(void* const* d_in, const int* in_sizes, int n_in, void* d_out, int out_size, void* d_ws, size_t ws_size, hipStream_t stream) {
    static int grid_blocks = 0;
    if (grid_blocks == 0) {
        if (n_in != 19 || ws_size < WS_END) { fprintf(stderr, "kernel_launch: unexpected n_in %d / ws %zu\n", n_in, ws_size); grid_blocks = -1; return; }
        int dev = 0, cus = 0, per_cu = 0;
        hipGetDevice(&dev);
        hipDeviceGetAttribute(&cus, hipDeviceAttributeMultiprocessorCount, dev);
        if (hipFuncSetAttribute((const void*)hybrid_block_fwd, hipFuncAttributeMaxDynamicSharedMemorySize, LDS_BYTES) != hipSuccess) { fprintf(stderr, "hipFuncSetAttribute failed\n"); }
        if (hipOccupancyMaxActiveBlocksPerMultiprocessor(&per_cu, (const void*)hybrid_block_fwd, 512, LDS_BYTES) != hipSuccess || per_cu < 1) { fprintf(stderr, "occupancy query: %d\n", per_cu); per_cu = 1; }
        (void)hipGetLastError();
        grid_blocks = cus * (per_cu > 1 ? 1 : per_cu);
        if (grid_blocks > 256) grid_blocks = 256;
    }
    if (grid_blocks < 0) return;
    Params p{};
    const float** f = (const float**)&p;
    for (int i = 0; i < 19; ++i) f[i] = (const float*)d_in[i];
    p.out = (float*)d_out; p.ws = (unsigned char*)d_ws;
    void* args[] = {&p};
    hipError_t e = hipLaunchCooperativeKernel((const void*)hybrid_block_fwd, dim3(grid_blocks), dim3(512), args, LDS_BYTES, stream);
    if (e != hipSuccess) fprintf(stderr, "cooperative launch failed: %s (grid %d)\n", hipGetErrorString(e), grid_blocks);
}
```

```cpp
#include <hip/hip_runtime.h>
#include <hip/hip_cooperative_groups.h>
#include <cstdio>
#include <cstdint>
#include <cmath>
namespace cg = cooperative_groups;

namespace pg8 {
#define PG8_LAS __attribute__((address_space(3)))
typedef unsigned short bf16_t;
typedef short bf16x8 __attribute__((ext_vector_type(8)));
typedef float f32x4 __attribute__((ext_vector_type(4)));
typedef unsigned u32x4 __attribute__((ext_vector_type(4)));
constexpr int BM = 256, BK = 64, HALF = 128, HTB = HALF * BK * 2  , STAGE_BYTES = 8 * HTB, NXCD = 8, WGM = 8;

__host__ __device__ __forceinline__ int lds_byte(int r, int c) { const int st = (r >> 4) * 2 + (c >> 5), rr = r & 15, cc = c & 31, ob = rr * 64 + cc * 2; return st * 1024 + (ob ^ (((ob >> 9) & 1) << 5)); }
__host__ __device__ __forceinline__ void stage_rc(int b, int& R, int& C) { const int st = b / 1024, sb = b % 1024, swz = sb ^ (((sb >> 9) & 1) << 5); R = (st >> 1) * 16 + swz / 64; C = (st & 1) * 32 + (swz % 64) / 2; }
__host__ __device__ __forceinline__ int perm32(int rho) { const int n = rho >> 4, i = rho & 15; return 8 * (i >> 2) + 4 * n + (i & 3); }

struct Unit { int pm, pn; };
struct Gemm { const bf16_t* A; const bf16_t* Bt; int M, N, K; int a_rows = 256; };

struct StaticOrder {
    int nM, nN, nwg, G, c;
    __host__ __device__ void init(int M, int N, int G_, int c_) { nM = M / BM; nN = N / BM; nwg = nM * nN; G = G_; c = c_; }
    __host__ __device__ bool next(int i, Unit& u) const {
        const long L = (long)i * G + c; if (L >= nwg) return false;
        int wgid = (int)L; { const int q = nwg / NXCD, r = nwg % NXCD, xcd = wgid % NXCD, off = wgid / NXCD; wgid = (xcd < r ? xcd * (q + 1) : r * (q + 1) + (xcd - r) * q) + off; }
        const int nig = WGM * nN, gid = wgid / nig, fm = gid * WGM, gsz = (nM - fm) < WGM ? (nM - fm) : WGM;
        u.pm = fm + ((wgid % nig) % gsz); u.pn = (wgid % nig) / gsz; return true;
    }
    __device__ __forceinline__ void a_ready(const Unit&) const {}
    __device__ __forceinline__ void done(const Unit&) const {}
};

__device__ __forceinline__ unsigned cvt_pk_bf16(float lo, float hi) { unsigned r; asm volatile("v_cvt_pk_bf16_f32 %0, %1, %2" : "=v"(r) : "v"(lo), "v"(hi)); return r; }
template <class Epi, class Sched, bool ALIGN_EPI = false, bool SP2 = false>
__device__ __forceinline__ void gemm_phase(PG8_LAS unsigned char* lds, const Gemm g, const Sched& S, const Epi& E, const int wv) {
    int tid_; asm volatile("v_mbcnt_lo_u32_b32 %0, -1, 0\n\tv_mbcnt_hi_u32_b32 %0, -1, %0" : "=v"(tid_)); tid_ += wv * 64;
    const int tid = tid_, wid = __builtin_amdgcn_readfirstlane(tid >> 6), lane = tid & 63, wr = wid >> 2, wc = wid & 3, fr = lane & 15, fq = lane >> 4;
    const int K = g.K, nt = K / BK;
    unsigned voffA[2], voffB[2];
#pragma unroll
    for (int i = 0; i < 2; ++i) { int R, C; stage_rc(tid * 16 + i * 8192, R, C); const int Rb = Epi::PERM ? ((R & ~31) + perm32(R & 31)) : R;
        voffA[i] = (unsigned)(R * K + C) * 2u; voffB[i] = (unsigned)(Rb * K + C) * 2u; }
    const size_t kstep = (size_t)(BK * 2);
    const size_t hstep = (size_t)HALF * K * 2;
    const size_t tstep = 2 * hstep; const size_t tstepA = (size_t)g.a_rows * K * 2;
    const unsigned ldsw = (unsigned)wid * 1024u;
    const int aoff = lds_byte(wr * 64 + fr, fq * 8), boff = lds_byte(wc * 32 + fr, fq * 8);
#define PG8_SA(b, h) (((b) * 2 + (h)) * HTB)
#define PG8_SB(b, h) ((4 + (b) * 2 + (h)) * HTB)
#define PG8_STAGE(bufoff, gbase, voff) do { _Pragma("unroll") for (int _i = 0; _i < 2; ++_i) \
        __builtin_amdgcn_global_load_lds((const unsigned*)((const char*)(gbase) + (voff)[_i]), (PG8_LAS unsigned*)(lds + (bufoff) + ldsw + _i * 8192), 16, 0, 0); } while (0)
#define PG8_LDA(dst, b, h) do { _Pragma("unroll") for (int m = 0; m < 4; ++m) _Pragma("unroll") for (int k = 0; k < 2; ++k) dst[m][k] = *(const PG8_LAS bf16x8*)(lds + PG8_SA(b, h) + aoff + m * 2048 + k * 1024); } while (0)
#define PG8_LDB(dst, b, h) do { _Pragma("unroll") for (int n = 0; n < 2; ++n) _Pragma("unroll") for (int k = 0; k < 2; ++k) dst[n][k] = *(const PG8_LAS bf16x8*)(lds + PG8_SB(b, h) + boff + n * 2048 + k * 1024); } while (0)
#define PG8_MMA(ai, bj, At, Bt) do { __builtin_amdgcn_s_setprio(1); _Pragma("unroll") for (int m = 0; m < 4; ++m) _Pragma("unroll") for (int n = 0; n < 2; ++n) _Pragma("unroll") for (int k = 0; k < 2; ++k) \
        acc[ai][bj][m][n] = __builtin_amdgcn_mfma_f32_16x16x32_bf16(Bt[n][k], At[m][k], acc[ai][bj][m][n], 0, 0, 0); __builtin_amdgcn_s_setprio(0); } while (0)
#define PG8_WAIT_V(n) asm volatile("s_waitcnt vmcnt(" #n ")" ::: "memory")
#define PG8_WAIT_L(n) asm volatile("s_waitcnt lgkmcnt(" #n ")" ::: "memory")
#define PG8_BAR __builtin_amdgcn_s_barrier()
#define PG8_SCHED __builtin_amdgcn_sched_barrier(0)
    Unit cur, nxt; int ui = 0;
    if (!S.next(0, cur)) return;
    f32x4 acc[2][2][4][2];
#pragma unroll
    for (int a = 0; a < 2; ++a)
#pragma unroll
        for (int b = 0; b < 2; ++b)
#pragma unroll
            for (int m = 0; m < 4; ++m)
#pragma unroll
                for (int n = 0; n < 2; ++n) acc[a][b][m][n] = (f32x4){0.f, 0.f, 0.f, 0.f};
    bf16x8 At[4][2], B0[2][2], B1[2][2];
    const char* cA = (const char*)g.A + (size_t)cur.pm * tstepA; const char* cB = (const char*)g.Bt + (size_t)cur.pn * tstep;
    S.a_ready(cur);
    if constexpr (SP2) {
        PG8_STAGE(PG8_SB(0, 0), cB, voffB); PG8_STAGE(PG8_SB(0, 1), cB + hstep, voffB); PG8_STAGE(PG8_SA(0, 0), cA, voffA); PG8_STAGE(PG8_SA(0, 1), cA + hstep, voffA);
        if (wr == 1) PG8_BAR;
        PG8_WAIT_V(2); PG8_BAR;
        PG8_STAGE(PG8_SB(1, 0), cB + kstep, voffB); PG8_STAGE(PG8_SA(1, 0), cA + kstep, voffA); PG8_STAGE(PG8_SB(1, 1), cB + hstep + kstep, voffB);
        PG8_WAIT_V(6); PG8_BAR;
    } else {
        PG8_STAGE(PG8_SB(0, 0), cB, voffB); PG8_STAGE(PG8_SA(0, 0), cA, voffA); PG8_STAGE(PG8_SB(0, 1), cB + hstep, voffB); PG8_STAGE(PG8_SA(0, 1), cA + hstep, voffA);
        if (wr == 1) PG8_BAR;
        PG8_WAIT_V(4); PG8_BAR;
        PG8_STAGE(PG8_SB(1, 0), cB + kstep, voffB); PG8_STAGE(PG8_SA(1, 0), cA + kstep, voffA); PG8_STAGE(PG8_SB(1, 1), cB + hstep + kstep, voffB);
        PG8_WAIT_V(6); PG8_BAR;
    }
    for (;;) {
        const bool has_next = S.next(ui + 1, nxt);
        const char* nA = has_next ? (const char*)g.A + (size_t)nxt.pm * tstepA : cA; const char* nB = has_next ? (const char*)g.Bt + (size_t)nxt.pn * tstep : cB;
        for (int t = 0; t < nt; t += 2) {
            const bool last = (t == nt - 2);
            const char* a1 = cA + (size_t)(t + 1) * kstep;
            const char* a2 = last ? nA : cA + (size_t)(t + 2) * kstep; const char* b2 = last ? nB : cB + (size_t)(t + 2) * kstep;
            const char* a3 = a2 + kstep; const char* b3 = b2 + kstep;
            if (last && has_next) S.a_ready(nxt);
            if constexpr (SP2) {
            PG8_LDB(B0, 0, 0); PG8_LDB(B1, 0, 1); PG8_SCHED; PG8_LDA(At, 0, 0); PG8_STAGE(PG8_SA(1, 1), a1 + hstep, voffA);
            PG8_WAIT_V(8); PG8_WAIT_L(0); PG8_BAR; PG8_MMA(0, 0, At, B0); PG8_MMA(0, 1, At, B1); PG8_BAR; PG8_SCHED;
            PG8_LDA(At, 0, 1); PG8_STAGE(PG8_SB(0, 0), b2, voffB); PG8_STAGE(PG8_SB(0, 1), b2 + hstep, voffB); PG8_STAGE(PG8_SA(0, 0), a2, voffA);
            PG8_WAIT_V(8); PG8_WAIT_L(0); PG8_BAR; PG8_MMA(1, 0, At, B0); PG8_MMA(1, 1, At, B1); PG8_BAR; PG8_SCHED;
            PG8_LDB(B0, 1, 0); PG8_LDB(B1, 1, 1); PG8_SCHED; PG8_LDA(At, 1, 0); PG8_STAGE(PG8_SA(0, 1), a2 + hstep, voffA);
            PG8_WAIT_V(8); PG8_WAIT_L(0); PG8_BAR; PG8_MMA(0, 0, At, B0); PG8_MMA(0, 1, At, B1); PG8_BAR; PG8_SCHED;
            PG8_LDA(At, 1, 1); PG8_STAGE(PG8_SB(1, 0), b3, voffB); PG8_STAGE(PG8_SB(1, 1), b3 + hstep, voffB); PG8_STAGE(PG8_SA(1, 0), a3, voffA);
            PG8_WAIT_V(8); PG8_WAIT_L(0); PG8_BAR; PG8_MMA(1, 0, At, B0); PG8_MMA(1, 1, At, B1); PG8_BAR; PG8_SCHED;
            } else {
            PG8_LDB(B0, 0, 0); PG8_SCHED; PG8_LDA(At, 0, 0); PG8_STAGE(PG8_SA(1, 1), a1 + hstep, voffA);
            PG8_WAIT_L(8); PG8_BAR; PG8_WAIT_L(0); PG8_MMA(0, 0, At, B0); PG8_BAR; PG8_SCHED;
            PG8_LDB(B1, 0, 1); PG8_STAGE(PG8_SB(0, 0), b2, voffB);
            PG8_BAR; PG8_WAIT_L(0); PG8_MMA(0, 1, At, B1); PG8_BAR;
            PG8_LDA(At, 0, 1); PG8_STAGE(PG8_SA(0, 0), a2, voffA);
            PG8_BAR; PG8_WAIT_L(0); PG8_MMA(1, 0, At, B0); PG8_BAR; PG8_SCHED;
            PG8_STAGE(PG8_SB(0, 1), b2 + hstep, voffB);
            PG8_WAIT_V(6); PG8_BAR; PG8_MMA(1, 1, At, B1); PG8_BAR;
            PG8_LDB(B0, 1, 0); PG8_SCHED; PG8_LDA(At, 1, 0); PG8_STAGE(PG8_SA(0, 1), a2 + hstep, voffA);
            PG8_WAIT_L(8); PG8_BAR; PG8_WAIT_L(0); PG8_MMA(0, 0, At, B0); PG8_BAR; PG8_SCHED;
            PG8_LDB(B1, 1, 1); PG8_STAGE(PG8_SB(1, 0), b3, voffB);
            PG8_BAR; PG8_WAIT_L(0); PG8_MMA(0, 1, At, B1); PG8_BAR;
            PG8_LDA(At, 1, 1); PG8_STAGE(PG8_SA(1, 0), a3, voffA);
            PG8_BAR; PG8_WAIT_L(0); PG8_MMA(1, 0, At, B0); PG8_BAR; PG8_SCHED;
            PG8_STAGE(PG8_SB(1, 1), b3 + hstep, voffB);
            PG8_WAIT_V(6); PG8_BAR; PG8_MMA(1, 1, At, B1); PG8_BAR;
            }
        }
        if constexpr (ALIGN_EPI) { if (wr == 0) PG8_BAR; }
        if constexpr (!Epi::AFTER_DRAIN) { E(acc, cur, wr, wc, fr, fq); S.done(cur); }
        if (!has_next) break;
#pragma unroll
        for (int a = 0; a < 2; ++a)
#pragma unroll
            for (int b = 0; b < 2; ++b)
#pragma unroll
                for (int m = 0; m < 4; ++m)
#pragma unroll
                    for (int n = 0; n < 2; ++n) acc[a][b][m][n] = (f32x4){0.f, 0.f, 0.f, 0.f};
        cur = nxt; cA = nA; cB = nB; ++ui;
        if constexpr (ALIGN_EPI) { if (wr == 1) PG8_BAR; }
    }
    PG8_WAIT_V(0);
    if constexpr (!ALIGN_EPI) { if (wr == 0) PG8_BAR; }
    PG8_BAR;
    if constexpr (Epi::AFTER_DRAIN) { E.fused(acc, cur, wr, wc, fr, fq, lds, wid, lane); S.done(cur); }
#undef PG8_SA
#undef PG8_SB
#undef PG8_STAGE
#undef PG8_LDA
#undef PG8_LDB
#undef PG8_MMA
#undef PG8_WAIT_V
#undef PG8_WAIT_L
#undef PG8_BAR
#undef PG8_SCHED
}
}

using pg8::bf16_t; using pg8::f32x4; using pg8::Unit; using pg8::cvt_pk_bf16;
typedef short bf16x8 __attribute__((ext_vector_type(8)));
typedef _Float16 f16x8 __attribute__((ext_vector_type(8)));
typedef float f32x16 __attribute__((ext_vector_type(16)));
typedef unsigned u32x4 __attribute__((ext_vector_type(4)));
typedef unsigned u32x2 __attribute__((ext_vector_type(2)));
typedef short s16x4 __attribute__((ext_vector_type(4)));
#define LAS __attribute__((address_space(3)))

constexpr int BATCH = 16, SEQ = 4096, DM = 1024, MTOK = BATCH * SEQ;
constexpr int NPROJ = 3072, NREAL = 2888, DFF = 2816, NUP = 5632, MODW = 6144;
constexpr int MHALF = MTOK / 2;
constexpr float EPS = 1e-6f, LOG2E = 1.4426950408889634f, QSCALE = 0.125f * LOG2E;
constexpr size_t MiB = 1u << 20;
constexpr size_t WS_MOD = 0, WS_WIN = 1 * MiB, WS_WOUT = 7 * MiB, WS_WUP = 9 * MiB, WS_WDN = 20 * MiB, WS_H = 26 * MiB;
constexpr size_t WS_AQ = 154 * MiB, WS_AK = 218 * MiB, WS_AV = 282 * MiB, WS_BQ = 346 * MiB, WS_BK = 410 * MiB, WS_BV = 426 * MiB;
constexpr size_t WS_IQ = 442 * MiB, WS_IK = 506 * MiB, WS_IW = 514 * MiB, WS_CAT = 516 * MiB, WS_SC = 644 * MiB;
constexpr size_t WS_U = 154 * MiB, WS_G = 506 * MiB, WS_END = 1024 * MiB;
constexpr int LDS_BYTES = 147456;

struct Params {
    const float *x, *c, *w_ada, *b_ada, *g_attn, *w_in, *qna, *kna, *qnb, *knb, *lam, *subln, *w_out, *g_ffn, *w_up, *conv_w, *conv_b, *w_down, *rel_bias;
    float* out; unsigned char* ws;
};

__device__ __forceinline__ int otid(int wv) { int l; asm volatile("v_mbcnt_lo_u32_b32 %0, -1, 0\n\tv_mbcnt_hi_u32_b32 %0, -1, %0" : "=v"(l)); return wv * 64 + l; }
__device__ __forceinline__ float wave_sum(float v) {
#pragma unroll
    for (int o = 1; o < 64; o <<= 1) v += __shfl_xor(v, o);
    return v;
}
__device__ __forceinline__ float wave_max(float v) {
#pragma unroll
    for (int o = 1; o < 64; o <<= 1) v = fmaxf(v, __shfl_xor(v, o));
    return v;
}
__device__ __forceinline__ unsigned pk_f16(float a, float b) {
    _Float16 x = (_Float16)a, y = (_Float16)b;
    return (unsigned)__builtin_bit_cast(unsigned short, x) | ((unsigned)__builtin_bit_cast(unsigned short, y) << 16);
}
__device__ __forceinline__ int pi32(int m) { const int a = m >> 3, h = (m >> 2) & 1, c = m & 3; return 16 * (a >> 1) + 8 * h + 4 * (a & 1) + c; }
__device__ __forceinline__ int crow(int r, int hi) { return (r & 3) + 8 * (r >> 2) + 4 * hi; }
__device__ __forceinline__ int t5_bucket(int n) {
    if (n < 16) return n;
    return 16 + (n >= 19) + (n >= 21) + (n >= 24) + (n >= 27) + (n >= 31) + (n >= 35) + (n >= 40) + (n >= 46) + (n >= 52) + (n >= 59) + (n >= 67) + (n >= 77) + (n >= 87) + (n >= 99) + (n >= 113);
}
__device__ __forceinline__ s16x4 vtr(const LAS unsigned char* p) {
    return __builtin_bit_cast(s16x4, __builtin_amdgcn_ds_read_tr16_b64_v4i16((LAS s16x4*)p));
}

__device__ __forceinline__ int perm_inv(int n) { return (n & ~255) + 128 * ((n >> 5) & 1) + 32 * ((n >> 6) & 3) + (n & 31); }
__device__ __forceinline__ int perm_up(int n) { const int v = n >= DFF, m = n - (v ? DFF : 0); return (m >> 7) * 256 + 128 * v + (m & 127); }
__device__ __forceinline__ void transpose_tile(const float* W, int K, int N, int nreal, bf16_t* Bt, int k0, int n0, int permute, LAS float* scr, int tid) {
#pragma unroll
    for (int i = 0; i < 8; ++i) { const int kk = (tid >> 6) + 8 * i, nn = tid & 63, n = n0 + nn; scr[kk * 65 + nn] = (n < nreal) ? W[(size_t)(k0 + kk) * N + n] : 0.f; }
    __syncthreads();
    { const int nn = tid >> 3, c = tid & 7, n = n0 + nn, drow = permute == 1 ? perm_inv(n) : (permute == 2 ? perm_up(n) : n); const LAS float* s = scr + (8 * c) * 65 + nn;
      u32x4 o; o.x = cvt_pk_bf16(s[0], s[65]); o.y = cvt_pk_bf16(s[130], s[195]); o.z = cvt_pk_bf16(s[260], s[325]); o.w = cvt_pk_bf16(s[390], s[455]);
      *(u32x4*)(Bt + (size_t)drow * K + k0 + 8 * c) = o; }
    __syncthreads();
}
__device__ __forceinline__ void phase0(const Params& p, LAS unsigned char* lds, int wv) {
    const int tid = otid(wv);
    LAS float* sc = (LAS float*)lds;
    LAS float* scr = (LAS float*)(lds + 65536);
    LAS float* red = (LAS float*)(lds + 65536 + 16640);
    constexpr int I_IN = 16 * 48, I_OUT = 16 * 16, I_UP = 16 * 88, I_DN = 44 * 16, NIT = I_IN + I_OUT + I_UP + I_DN;
    for (int it = blockIdx.x; it < NIT; it += gridDim.x) {
        int r = it;
        if (r < I_IN) { transpose_tile(p.w_in, 1024, NREAL, NREAL, (bf16_t*)(p.ws + WS_WIN), 64 * (r / 48), 64 * (r % 48), 1, scr, tid); continue; } r -= I_IN;
        if (r < I_OUT) { transpose_tile(p.w_out, 1024, 1024, 1024, (bf16_t*)(p.ws + WS_WOUT), 64 * (r / 16), 64 * (r % 16), 0, scr, tid); continue; } r -= I_OUT;
        if (r < I_UP) { transpose_tile(p.w_up, 1024, NUP, NUP, (bf16_t*)(p.ws + WS_WUP), 64 * (r / 88), 64 * (r % 88), 2, scr, tid); continue; } r -= I_UP;
        transpose_tile(p.w_down, DFF, 1024, 1024, (bf16_t*)(p.ws + WS_WDN), 64 * (r / 16), 64 * (r % 16), 0, scr, tid);
    }
    if (blockIdx.x < 192) {
        for (int i = tid; i < 16 * 1024; i += 512) { const float v = p.c[i]; sc[i] = v / (1.f + __expf(-v)); }
        __syncthreads();
        float* mod = (float*)(p.ws + WS_MOD);
        for (int g = blockIdx.x; g < 192; g += gridDim.x) {
            const int kq = tid >> 5, col = tid & 31;
            float acc[16];
#pragma unroll
            for (int b = 0; b < 16; ++b) acc[b] = 0.f;
#pragma unroll 1
            for (int kb = 0; kb < 64; kb += 16) {
                float wv16[16];
#pragma unroll
                for (int i = 0; i < 16; ++i) wv16[i] = p.w_ada[(size_t)(kq * 64 + kb + i) * MODW + g * 32 + col];
#pragma unroll
                for (int i = 0; i < 16; ++i) { const int k = kq * 64 + kb + i;
#pragma unroll
                    for (int b = 0; b < 16; ++b) acc[b] += sc[b * 1024 + k] * wv16[i]; } }
#pragma unroll
            for (int b = 0; b < 16; ++b) red[(kq * 16 + b) * 32 + col] = acc[b];
            __syncthreads();
            { const int b = tid >> 5; float s = p.b_ada[g * 32 + col];
#pragma unroll
              for (int q = 0; q < 16; ++q) s += red[(q * 16 + b) * 32 + col];
              mod[b * MODW + g * 32 + col] = s; }
            __syncthreads();
        }
    }
}

__device__ __forceinline__ void norm_phase(const float* X, const float* gvec, const float* mod, int sc_off, int sh_off, bf16_t* H, int wv) {
    const int tid = otid(wv); const int lane = tid & 63, gw = blockIdx.x * 8 + (tid >> 6), NGW = gridDim.x * 8;
    for (int row0 = gw; row0 < MTOK; row0 += 4 * NGW) {
        f32x4 v[4][4];
#pragma unroll
        for (int q = 0; q < 4; ++q) { const int row = min(row0 + q * NGW, MTOK - 1); const f32x4* xr = (const f32x4*)(X + (size_t)row * DM) + lane;
#pragma unroll
            for (int j = 0; j < 4; ++j) v[q][j] = xr[64 * j]; }
#pragma unroll
        for (int q = 0; q < 4; ++q) {
            const int row = row0 + q * NGW;
            float ss = 0.f;
#pragma unroll
            for (int j = 0; j < 4; ++j) ss += (v[q][j].x * v[q][j].x + v[q][j].y * v[q][j].y) + (v[q][j].z * v[q][j].z + v[q][j].w * v[q][j].w);
            const float rs = 1.0f / sqrtf(wave_sum(ss) * (1.f / DM) + EPS);
            if (row < MTOK) { const int b = row >> 12;
#pragma unroll
                for (int j = 0; j < 4; ++j) { const int col = (lane + 64 * j) * 4;
                    const f32x4 g4 = *(const f32x4*)(gvec + col), s4 = *(const f32x4*)(mod + b * MODW + sc_off + col), h4 = *(const f32x4*)(mod + b * MODW + sh_off + col);
                    const f32x4 y = (v[q][j] * rs) * g4 * (s4 + 1.0f) + h4; u32x2 o; o.x = cvt_pk_bf16(y.x, y.y); o.y = cvt_pk_bf16(y.z, y.w);
                    *(u32x2*)(H + (size_t)row * DM + col) = o; } }
        }
    }
}

struct EpiProj {
    static constexpr bool PERM = true, AFTER_DRAIN = false;
    unsigned char* ws; const float *qa, *ka, *qb, *kb;
    __device__ __forceinline__ void operator()(const f32x4 (&acc)[2][2][4][2], const Unit& u, int wr, int wc, int fr, int fq) const {
        const int G = u.pn * 4 + wc;
        if (G >= 46) return;
        int kind = 0, ld = 512, coloff = 0; unsigned char* base = ws; const float* gn = nullptr; float scale = 1.f;
        if (G < 8) { base = ws + WS_AQ; coloff = 64 * G; gn = qa; scale = QSCALE; }
        else if (G < 16) { base = ws + WS_AK; coloff = 64 * (G - 8); gn = ka; }
        else if (G < 24) { base = ws + WS_AV; coloff = 64 * (G - 16); }
        else if (G < 32) { base = ws + WS_BQ; coloff = 64 * (G - 24); gn = qb; scale = QSCALE; }
        else if (G < 34) { base = ws + WS_BK; ld = 128; coloff = 64 * (G - 32); gn = kb; }
        else if (G < 36) { base = ws + WS_BV; ld = 128; coloff = 64 * (G - 34); }
        else if (G < 44) { base = ws + WS_IQ; kind = 1; coloff = 64 * (G - 36); }
        else if (G == 44) { base = ws + WS_IK; kind = 1; ld = 64; }
        else { base = ws + WS_IW; kind = 2; }
        const int row0 = u.pm * 256 + wr * 64 + fr;
        f32x4 gv[2][2];
#pragma unroll
        for (int bj = 0; bj < 2; ++bj)
#pragma unroll
            for (int n = 0; n < 2; ++n) { gv[bj][n] = gn ? *(const f32x4*)(gn + 32 * bj + 8 * fq + 4 * n) : (f32x4){1.f, 1.f, 1.f, 1.f}; gv[bj][n] = gv[bj][n] * scale; }
#pragma unroll
        for (int ai = 0; ai < 2; ++ai)
#pragma unroll
            for (int m = 0; m < 4; ++m) {
                const size_t row = (size_t)(row0 + 128 * ai + 16 * m);
                float rs = 1.f;
                if (gn) { float ss = 0.f;
#pragma unroll
                    for (int bj = 0; bj < 2; ++bj)
#pragma unroll
                        for (int n = 0; n < 2; ++n) { const f32x4 v = acc[ai][bj][m][n]; ss += (v.x * v.x + v.y * v.y) + (v.z * v.z + v.w * v.w); }
                    ss += __shfl_xor(ss, 16); ss += __shfl_xor(ss, 32);
                    rs = __builtin_amdgcn_rsqf(ss * (1.f / 64.f) + EPS); }
                if (kind == 2) { if (fq == 0) { *(f32x4*)((float*)base + row * 8) = acc[ai][0][m][0] * 0.04419417382415922f; *(f32x4*)((float*)base + row * 8 + 4) = acc[ai][0][m][1] * 0.04419417382415922f; } }
                else {
#pragma unroll
                    for (int bj = 0; bj < 2; ++bj) { const f32x4 v0 = acc[ai][bj][m][0] * rs * gv[bj][0], v1 = acc[ai][bj][m][1] * rs * gv[bj][1]; u32x4 w;
                        if (kind == 0) { w.x = cvt_pk_bf16(v0.x, v0.y); w.y = cvt_pk_bf16(v0.z, v0.w); w.z = cvt_pk_bf16(v1.x, v1.y); w.w = cvt_pk_bf16(v1.z, v1.w); }
                        else { w.x = pk_f16(v0.x, v0.y); w.y = pk_f16(v0.z, v0.w); w.z = pk_f16(v1.x, v1.y); w.w = pk_f16(v1.z, v1.w); }
                        *(u32x4*)((bf16_t*)base + row * ld + coloff + 32 * bj + 8 * fq) = w; }
                }
            }
    }
};
struct EpiOut {
    static constexpr bool PERM = true, AFTER_DRAIN = false;
    const float* x; const float* gate; float* out;
    __device__ __forceinline__ void operator()(const f32x4 (&acc)[2][2][4][2], const Unit& u, int wr, int wc, int fr, int fq) const {
        const int row0 = u.pm * 256 + wr * 64 + fr, col0 = u.pn * 256 + wc * 32 + 8 * fq;
#pragma unroll
        for (int ai = 0; ai < 2; ++ai)
#pragma unroll
            for (int m = 0; m < 4; ++m) { const int row = row0 + 128 * ai + 16 * m, b = row >> 12;
#pragma unroll
                for (int bj = 0; bj < 2; ++bj)
#pragma unroll
                    for (int n = 0; n < 2; ++n) { const int col = col0 + 128 * bj + 4 * n; const size_t off = (size_t)row * DM + col;
                        const f32x4 g = *(const f32x4*)(gate + b * MODW + col), xv = *(const f32x4*)(x + off);
                        *(f32x4*)(out + off) = xv + g * acc[ai][bj][m][n]; } }
    }
};
struct EpiUp {
    static constexpr bool PERM = false, AFTER_DRAIN = false;
    bf16_t* U;
    __device__ __forceinline__ void operator()(const f32x4 (&acc)[2][2][4][2], const Unit& u, int wr, int wc, int fr, int fq) const {
        const int row0 = u.pm * 256 + wr * 64 + fr, col0 = u.pn * 256 + wc * 32 + 4 * fq;
#pragma unroll
        for (int ai = 0; ai < 2; ++ai)
#pragma unroll
            for (int m = 0; m < 4; ++m) { const size_t row = (size_t)(row0 + 128 * ai + 16 * m);
#pragma unroll
                for (int bj = 0; bj < 2; ++bj)
#pragma unroll
                    for (int n = 0; n < 2; ++n) { const f32x4 v = acc[ai][bj][m][n]; u32x2 w; w.x = cvt_pk_bf16(v.x, v.y); w.y = cvt_pk_bf16(v.z, v.w);
                        *(u32x2*)(U + row * NUP + col0 + 128 * bj + 16 * n) = w; } }
    }
};
constexpr int HALO_OFF = 131072;
__device__ __forceinline__ f32x4 dpp_ror(const f32x4 v, const int which) {
    f32x4 r;
    if (which == 1) { r.x = __int_as_float(__builtin_amdgcn_update_dpp(0, __float_as_int(v.x), 0x121, 0xf, 0xf, false)); r.y = __int_as_float(__builtin_amdgcn_update_dpp(0, __float_as_int(v.y), 0x121, 0xf, 0xf, false));
                      r.z = __int_as_float(__builtin_amdgcn_update_dpp(0, __float_as_int(v.z), 0x121, 0xf, 0xf, false)); r.w = __int_as_float(__builtin_amdgcn_update_dpp(0, __float_as_int(v.w), 0x121, 0xf, 0xf, false)); }
    else { r.x = __int_as_float(__builtin_amdgcn_update_dpp(0, __float_as_int(v.x), 0x122, 0xf, 0xf, false)); r.y = __int_as_float(__builtin_amdgcn_update_dpp(0, __float_as_int(v.y), 0x122, 0xf, 0xf, false));
           r.z = __int_as_float(__builtin_amdgcn_update_dpp(0, __float_as_int(v.z), 0x122, 0xf, 0xf, false)); r.w = __int_as_float(__builtin_amdgcn_update_dpp(0, __float_as_int(v.w), 0x122, 0xf, 0xf, false)); }
    return r;
}
struct EpiUpConv {
    static constexpr bool PERM = true, AFTER_DRAIN = false;
    bf16_t* Gout; const float* cw; const float* cb; LAS float* halo;
    __device__ __forceinline__ void operator()(const f32x4 (&acc)[2][2][4][2], const Unit& u, int wr, int wc, int fr_, int fq_) const {
        int fr = fr_, fq = fq_; asm volatile("" : "+v"(fr), "+v"(fq));
        if (fr >= 14) {
#pragma unroll
            for (int ai = 0; ai < 2; ++ai)
#pragma unroll
                for (int bj = 0; bj < 2; ++bj)
#pragma unroll
                    for (int n = 0; n < 2; ++n) *(LAS f32x4*)(halo + ((2 * ai + wr) * 2 + (fr - 14)) * 256 + 128 * bj + 32 * wc + 8 * fq + 4 * n) = acc[ai][bj][3][n];
        }
        asm volatile("s_waitcnt lgkmcnt(0)" ::: "memory"); __builtin_amdgcn_s_barrier(); asm volatile("" ::: "memory");
        const int R0 = u.pm * 254 - 2;
#pragma unroll
        for (int n = 0; n < 2; ++n) {
            const int cr = u.pn * 128 + wc * 32 + 8 * fq + 4 * n;
            const f32x4 g0 = *(const f32x4*)(cw + cr), g1 = *(const f32x4*)(cw + NUP + cr), g2 = *(const f32x4*)(cw + 2 * NUP + cr), gb = *(const f32x4*)(cb + cr);
            const f32x4 v0 = *(const f32x4*)(cw + DFF + cr), v1 = *(const f32x4*)(cw + NUP + DFF + cr), v2 = *(const f32x4*)(cw + 2 * NUP + DFF + cr), vb = *(const f32x4*)(cb + DFF + cr);
#pragma unroll
            for (int ai = 0; ai < 2; ++ai) {
                const int seg = 2 * ai + wr;
                f32x4 pr1[2], pr2[2];
#pragma unroll
                for (int bj = 0; bj < 2; ++bj) {
                    pr1[bj] = (f32x4){0.f, 0.f, 0.f, 0.f}; pr2[bj] = (f32x4){0.f, 0.f, 0.f, 0.f};
                    if (seg > 0) { const LAS float* hp = halo + ((seg - 1) * 2) * 256 + 128 * bj + 32 * wc + 8 * fq + 4 * n;
                        pr1[bj] = *(const LAS f32x4*)(hp + 256); pr2[bj] = *(const LAS f32x4*)(hp + ((fr & 1) ? 256 : 0)); }
                }
#pragma unroll
                for (int m = 0; m < 4; ++m) {
                    const int r = 128 * ai + 64 * wr + 16 * m + fr, R = R0 + r, t = R & (SEQ - 1);
                    f32x4 y[2];
#pragma unroll
                    for (int bj = 0; bj < 2; ++bj) {
                        const f32x4 X = acc[ai][bj][m][n]; const f32x4 r1 = dpp_ror(X, 1), r2 = dpp_ror(X, 2);
                        f32x4 p1 = (fr == 0) ? pr1[bj] : r1, p2 = (fr < 2) ? pr2[bj] : r2;
                        pr1[bj] = r1; pr2[bj] = r2;
                        if (t == 0) p1 = (f32x4){0.f, 0.f, 0.f, 0.f};
                        if (t <= 1) p2 = (f32x4){0.f, 0.f, 0.f, 0.f};
                        y[bj] = bj == 0 ? (gb + g0 * p2 + g1 * p1 + g2 * X) : (vb + v0 * p2 + v1 * p1 + v2 * X);
                    }
                    f32x4 o;
                    o.x = y[0].x * __builtin_amdgcn_rcpf(1.f + __builtin_amdgcn_exp2f(-LOG2E * y[0].x)) * y[1].x; o.y = y[0].y * __builtin_amdgcn_rcpf(1.f + __builtin_amdgcn_exp2f(-LOG2E * y[0].y)) * y[1].y;
                    o.z = y[0].z * __builtin_amdgcn_rcpf(1.f + __builtin_amdgcn_exp2f(-LOG2E * y[0].z)) * y[1].z; o.w = y[0].w * __builtin_amdgcn_rcpf(1.f + __builtin_amdgcn_exp2f(-LOG2E * y[0].w)) * y[1].w;
                    if (r >= 2 && R < MTOK) { u32x2 w; w.x = cvt_pk_bf16(o.x, o.y); w.y = cvt_pk_bf16(o.z, o.w); *(u32x2*)(Gout + (size_t)R * DFF + cr) = w; }
                }
            }
        }
    }
};
struct EpiDown {
    static constexpr bool PERM = true, AFTER_DRAIN = false;
    const float* gate; float* out; int rowoff;
    __device__ __forceinline__ void operator()(const f32x4 (&acc)[2][2][4][2], const Unit& u, int wr, int wc, int fr, int fq) const {
        const int row0 = rowoff + u.pm * 256 + wr * 64 + fr, col0 = u.pn * 256 + wc * 32 + 8 * fq;
#pragma unroll
        for (int ai = 0; ai < 2; ++ai)
#pragma unroll
            for (int m = 0; m < 4; ++m) { const int row = row0 + 128 * ai + 16 * m, b = row >> 12;
#pragma unroll
                for (int bj = 0; bj < 2; ++bj)
#pragma unroll
                    for (int n = 0; n < 2; ++n) { const int col = col0 + 128 * bj + 4 * n; const size_t off = (size_t)row * DM + col;
                        const f32x4 g = *(const f32x4*)(gate + b * MODW + col), xv = *(const f32x4*)(out + off);
                        *(f32x4*)(out + off) = xv + g * acc[ai][bj][m][n]; } }
    }
};

__device__ __forceinline__ void unpack8(const u32x4 w, float* f) {
    f[0] = __uint_as_float(w.x << 16); f[1] = __uint_as_float(w.x & 0xffff0000u); f[2] = __uint_as_float(w.y << 16); f[3] = __uint_as_float(w.y & 0xffff0000u);
    f[4] = __uint_as_float(w.z << 16); f[5] = __uint_as_float(w.z & 0xffff0000u); f[6] = __uint_as_float(w.w << 16); f[7] = __uint_as_float(w.w & 0xffff0000u);
}
__device__ __forceinline__ void conv_phase(const Params& p, const bf16_t* U, bf16_t* Gb, int wv) {
    constexpr int NCH = DFF / 8, NTASK = (MHALF / 32) * NCH;
    const int tid = otid(wv);
    for (int task = blockIdx.x * 512 + tid; task < NTASK; task += gridDim.x * 512) {
        const int ch = task % NCH, strip = task / NCH, r0 = strip * 32, col = ch * 8;
        float wg[3][8], wv[3][8], bg[8], bv[8];
#pragma unroll
        for (int j = 0; j < 3; ++j)
#pragma unroll
            for (int e = 0; e < 8; ++e) { wg[j][e] = p.conv_w[j * NUP + col + e]; wv[j][e] = p.conv_w[j * NUP + DFF + col + e]; }
#pragma unroll
        for (int e = 0; e < 8; ++e) { bg[e] = p.conv_b[col + e]; bv[e] = p.conv_b[DFF + col + e]; }
        float g2[8], g1[8], v2[8], v1[8];
        if ((r0 & (SEQ - 1)) == 0) {
#pragma unroll
            for (int e = 0; e < 8; ++e) { g2[e] = 0.f; g1[e] = 0.f; v2[e] = 0.f; v1[e] = 0.f; }
        } else {
            unpack8(*(const u32x4*)(U + (size_t)(r0 - 2) * NUP + col), g2); unpack8(*(const u32x4*)(U + (size_t)(r0 - 1) * NUP + col), g1);
            unpack8(*(const u32x4*)(U + (size_t)(r0 - 2) * NUP + DFF + col), v2); unpack8(*(const u32x4*)(U + (size_t)(r0 - 1) * NUP + DFF + col), v1);
        }
        for (int r = 0; r < 32; ++r) {
            float g0[8], v0[8], o[8];
            unpack8(*(const u32x4*)(U + (size_t)(r0 + r) * NUP + col), g0); unpack8(*(const u32x4*)(U + (size_t)(r0 + r) * NUP + DFF + col), v0);
#pragma unroll
            for (int e = 0; e < 8; ++e) {
                const float yg = bg[e] + wg[0][e] * g2[e] + wg[1][e] * g1[e] + wg[2][e] * g0[e];
                const float yv = bv[e] + wv[0][e] * v2[e] + wv[1][e] * v1[e] + wv[2][e] * v0[e];
                o[e] = yg / (1.f + __expf(-yg)) * yv;
                g2[e] = g1[e]; g1[e] = g0[e]; v2[e] = v1[e]; v1[e] = v0[e]; }
            u32x4 w; w.x = cvt_pk_bf16(o[0], o[1]); w.y = cvt_pk_bf16(o[2], o[3]); w.z = cvt_pk_bf16(o[4], o[5]); w.w = cvt_pk_bf16(o[6], o[7]);
            *(u32x4*)(Gb + (size_t)(r0 + r) * DFF + col) = w;
        }
    }
}
#ifndef REPM
#define REPM 1
#endif
#ifndef REPK
#define REPK 1
#endif
#ifndef REPT
#define REPT 1
#endif
#ifndef REPA
#define REPA 1
#endif
#ifndef REPB
#define REPB 1
#endif
#ifndef PB
#define PB 7
#endif

constexpr int A_KROW = 272, A_VROW = 320, A_KBUF = 64 * A_KROW, A_VBUF = 64 * A_VROW, A_STG = A_KBUF + A_VBUF;
constexpr int A_TOFF = 2 * A_STG, A_LOFF = A_TOFF + 1280;
__device__ __forceinline__ void attnA_phase(const Params& p, LAS unsigned char* lds, int wv) {
    const int tid = otid(wv), lane = tid & 63, wid = __builtin_amdgcn_readfirstlane(tid >> 6), r32 = lane & 31, hi = lane >> 5;
    const int c = wid >> 2, qg = wid & 3;
    float lam; { float a = p.lam[lane] * p.lam[64 + lane], b2 = p.lam[128 + lane] * p.lam[192 + lane]; a = wave_sum(a); b2 = wave_sum(b2); lam = expf(a) - expf(b2) + 0.2f; }
    const float Mq = wave_max(fabsf(p.qna[lane])), Mk = wave_max(fabsf(p.kna[lane]));
    const unsigned char* AQ = p.ws + WS_AQ; const unsigned char* AK = p.ws + WS_AK; const unsigned char* AV = p.ws + WS_AV;
    bf16_t* CAT = (bf16_t*)(p.ws + WS_CAT);
    LAS float* T = (LAS float*)(lds + A_TOFF);
    LAS float* linv = (LAS float*)(lds + A_LOFF) + wid * 32;
    const int vblkA = (gridDim.x == 256) ? (int)((blockIdx.x & 7) * 32 + (blockIdx.x >> 3)) : (int)blockIdx.x;
    for (int ui = vblkA; ui < 2048 * REPA; ui += gridDim.x) {
        const int v = ui & 255, rnd = (ui >> 8) & 7, bh = v >> 2, pp = (v & 3) + 4 * (rnd >> 1), qb = (rnd & 1) ? 31 - pp : pp;
        const int b = bh >> 2, h = bh & 3, q0 = qb * 128, NT = 2 * qb + 2;
        const size_t tokbase = (size_t)b * SEQ;
        if (tid < 320) { const int d = 223 - tid;
            T[tid] = d < 0 ? -1e30f : (p.rel_bias[t5_bucket(min(d, 127)) * 12 + h] - p.rel_bias[31 * 12 + h]) * LOG2E; }
        bf16x8 qf[4];
        { const unsigned char* Qp = AQ + (tokbase + q0 + 32 * qg + r32) * 1024 + h * 256 + c * 128 + hi * 16;
#pragma unroll
          for (int ds = 0; ds < 4; ++ds) qf[ds] = *(const bf16x8*)(Qp + 32 * ds); }
        const int qpos = q0 + 32 * qg + r32, qw0 = q0 + 32 * qg;
        f32x16 O[4];
#pragma unroll
        for (int e = 0; e < 4; ++e)
#pragma unroll
            for (int r = 0; r < 16; ++r) O[e][r] = 0.f;
        float l = 0.f;
        u32x4 kreg[2], vreg[2];
        const int srow = tid >> 4, sch = tid & 15;
#define A_LOAD(t) do { _Pragma("unroll") for (int i = 0; i < 2; ++i) { const size_t g = (tokbase + 64 * (t) + srow + 32 * i) * 1024 + h * 256 + sch * 16; \
        kreg[i] = *(const u32x4*)(AK + g); vreg[i] = *(const u32x4*)(AV + g); } } while (0)
#define A_WRITE(st) do { _Pragma("unroll") for (int i = 0; i < 2; ++i) { *(LAS u32x4*)(lds + (st) * A_STG + (srow + 32 * i) * A_KROW + sch * 16) = kreg[i]; \
        *(LAS u32x4*)(lds + (st) * A_STG + A_KBUF + (srow + 32 * i) * A_VROW + sch * 16) = vreg[i]; } } while (0)
        A_LOAD(0); A_WRITE(0);
        __syncthreads();
        for (int t = 0; t < NT; ++t) {
            if (t + 1 < NT) A_LOAD(t + 1);
            const int k0 = 64 * t;
            if (k0 <= qw0 + 31) {
                const bool near = (k0 + 63 + 113 > qw0);
                const LAS unsigned char* Kb = lds + (t & 1) * A_STG; const LAS unsigned char* Vb = Kb + A_KBUF;
                f32x16 s0, s1;
#pragma unroll
                for (int r = 0; r < 16; ++r) { s0[r] = 0.f; s1[r] = 0.f; }
                {
                    const LAS unsigned char* kp0 = Kb + (pi32(r32)) * A_KROW + c * 128 + hi * 16;
                    const LAS unsigned char* kp1 = kp0 + 32 * A_KROW;
#pragma unroll
                    for (int ds = 0; ds < 4; ++ds) { const bf16x8 ka = *(const LAS bf16x8*)(kp0 + 32 * ds), kb = *(const LAS bf16x8*)(kp1 + 32 * ds);
                        s0 = __builtin_amdgcn_mfma_f32_32x32x16_bf16(ka, qf[ds], s0, 0, 0, 0); s1 = __builtin_amdgcn_mfma_f32_32x32x16_bf16(kb, qf[ds], s1, 0, 0, 0); }
                }
                __builtin_amdgcn_sched_barrier(0);
                float sacc = 0.f;
#define A_SOFTMAX(S, HF) do { \
                    if (!near) { _Pragma("unroll") for (int r = 0; r < 16; ++r) S[r] = __builtin_amdgcn_exp2f(S[r]); } \
                    else { int ib = 223 - (qpos - k0 - 8 * hi - 32 * (HF)); asm volatile("" : "+v"(ib)); const LAS float* tp = T + ib; \
                        _Pragma("unroll") for (int r = 0; r < 16; ++r) S[r] = __builtin_amdgcn_exp2f(S[r] + tp[16 * (r >> 3) + (r & 7)]); } \
                    _Pragma("unroll") for (int r = 0; r < 16; ++r) sacc += S[r]; } while (0)
#define A_PV(S, HF) do { \
                    _Pragma("unroll") for (int jj = 0; jj < 2; ++jj) { \
                        const int j = 2 * (HF) + jj, rb = 8 * jj; \
                        u32x4 pw; pw.x = cvt_pk_bf16(S[rb], S[rb + 1]); pw.y = cvt_pk_bf16(S[rb + 2], S[rb + 3]); pw.z = cvt_pk_bf16(S[rb + 4], S[rb + 5]); pw.w = cvt_pk_bf16(S[rb + 6], S[rb + 7]); \
                        const bf16x8 pa = __builtin_bit_cast(bf16x8, pw); \
                        const LAS unsigned char* vp = Vb + (16 * j + 8 * hi + ((lane & 15) >> 2)) * A_VROW + (16 * ((lane >> 4) & 1) + 4 * (lane & 3)) * 2; \
                        _Pragma("unroll") for (int eb = 0; eb < 4; ++eb) { \
                            const s16x4 lo = vtr(vp + eb * 64), hh = vtr(vp + 4 * A_VROW + eb * 64); \
                            const bf16x8 vf = (bf16x8){lo[0], lo[1], lo[2], lo[3], hh[0], hh[1], hh[2], hh[3]}; \
                            O[eb] = __builtin_amdgcn_mfma_f32_32x32x16_bf16(pa, vf, O[eb], 0, 0, 0); } } } while (0)
                A_SOFTMAX(s0, 0);
                __builtin_amdgcn_sched_barrier(0);
                A_PV(s0, 0);
                A_SOFTMAX(s1, 1);
                __builtin_amdgcn_sched_barrier(0);
                A_PV(s1, 1);
#undef A_SOFTMAX
#undef A_PV
                l += sacc;
            }
            if (t + 1 < NT) A_WRITE((t + 1) & 1);
            __syncthreads();
        }
#undef A_LOAD
#undef A_WRITE
        l += __shfl_xor(l, 32);
        if (hi == 0) linv[r32] = (c == 1 ? lam : 1.f) / l;
        LAS float* comb = (LAS float*)lds + qg * (32 * 128);
        float f[16];
#pragma unroll
        for (int r = 0; r < 16; ++r) f[r] = linv[crow(r, hi)];
#pragma unroll
        for (int eb = 0; eb < 4; ++eb)
#pragma unroll
            for (int r = 0; r < 16; ++r) O[eb][r] *= f[r];
        if (c == 1) {
#pragma unroll
            for (int eb = 0; eb < 4; ++eb)
#pragma unroll
                for (int r = 0; r < 16; ++r) comb[crow(r, hi) * 128 + 32 * eb + r32] = O[eb][r];
        }
        __syncthreads();
        if (c == 0) {
            float gl[4];
#pragma unroll
            for (int eb = 0; eb < 4; ++eb) gl[eb] = p.subln[32 * eb + r32] * 0.8f;
#pragma unroll
            for (int r = 0; r < 16; ++r) {
                const int qr = crow(r, hi); float ss = 0.f;
#pragma unroll
                for (int eb = 0; eb < 4; ++eb) { O[eb][r] -= comb[qr * 128 + 32 * eb + r32]; ss += O[eb][r] * O[eb][r]; }
                ss += __shfl_xor(ss, 1); ss += __shfl_xor(ss, 2); ss += __shfl_xor(ss, 4); ss += __shfl_xor(ss, 8); ss += __shfl_xor(ss, 16);
                const float rs = 1.0f / sqrtf(ss * (1.f / 128.f) + EPS);
                bf16_t* op = CAT + (tokbase + q0 + 32 * qg + qr) * 1024 + h * 128 + r32;
#pragma unroll
                for (int eb = 0; eb < 4; ++eb) op[32 * eb] = (bf16_t)(cvt_pk_bf16(O[eb][r] * rs * gl[eb], 0.f) & 0xffffu);
            }
        }
        __syncthreads();
    }
}

#ifndef SKIP
#define SKIP 0
#endif
constexpr int B_QROW = 1040;
constexpr int B_HIST = 66560, B_HROW = 257;
constexpr int B_TOFF = B_HIST + 64 * B_HROW * 4;
constexpr int B_DT = 75776;
constexpr int B_INFO = B_TOFF + 4096;
constexpr int B_LINV = B_INFO + 1024;
constexpr int B_MASK = 98304, B_MROW = 130;
__device__ __forceinline__ unsigned ord_key(float f) { const unsigned u = __float_as_uint(f); return u ^ ((u >> 31) ? 0xffffffffu : 0x80000000u); }
__device__ __forceinline__ void phaseB(const Params& p, LAS unsigned char* lds, int wv) {
    const _Float16* IQ = (const _Float16*)(p.ws + WS_IQ); const _Float16* IK = (const _Float16*)(p.ws + WS_IK); const float* IW = (const float*)(p.ws + WS_IW);
    const unsigned char* BQ = p.ws + WS_BQ; const unsigned char* BK = p.ws + WS_BK; const unsigned char* BV = p.ws + WS_BV;
    bf16_t* CAT = (bf16_t*)(p.ws + WS_CAT);
    float* SC = (float*)(p.ws + WS_SC + (size_t)blockIdx.x * MiB);
    LAS float* Tb = (LAS float*)(lds + B_DT);
    LAS unsigned* hist = (LAS unsigned*)(lds + B_HIST);
    LAS unsigned* pfx = (LAS unsigned*)(lds + B_INFO); LAS int* needv = (LAS int*)(lds + B_INFO + 256); LAS unsigned* ceqv = (LAS unsigned*)(lds + B_INFO + 512); LAS int* cutv = (LAS int*)(lds + B_INFO + 768);
    const int vblkB = (gridDim.x == 256) ? (int)((blockIdx.x & 7) * 32 + (blockIdx.x >> 3)) : (int)blockIdx.x;
    for (int ui = vblkB; ui < 1024 * REPB; ui += gridDim.x) {
        const int v = ui & 255, rnd = (ui >> 8) & 3, b = v >> 4, pp = (v & 15) + 16 * (rnd >> 1), qb = (rnd & 1) ? 63 - pp : pp;
        const int q0 = 64 * qb, NT = qb + 1;
        const size_t tokbase = (size_t)b * SEQ;
        {
        const int tid = otid(wv);
        const int lane = tid & 63, wid = __builtin_amdgcn_readfirstlane(tid >> 6), r32 = lane & 31, hi = lane >> 5; (void)r32; (void)hi; (void)wid;
#pragma unroll
        for (int i = 0; i < 8; ++i) { const int id = tid + 512 * i, row = id >> 6, ch = id & 63;
            *(LAS u32x4*)(lds + row * B_QROW + ch * 16) = *(const u32x4*)((const unsigned char*)IQ + (tokbase + q0 + row) * 1024 + ch * 16); }
        for (int i = tid; i < 64 * B_HROW; i += 512) hist[i] = 0u;
        if (tid < 128) *(LAS f32x4*)(lds + B_TOFF + tid * 16) = *(const f32x4*)(IW + (tokbase + q0) * 8 + tid * 4);
        if (tid < 64) { const int n = q0 + tid + 1; pfx[tid] = 0u; needv[tid] = (n > 256) ? 256 : -1; ceqv[tid] = 0u; cutv[tid] = 4096; }
        __syncthreads();
#if !(SKIP & 1)
        {
            const int qg = wid & 1, ks = wid >> 1;
            const LAS float* wp = (const LAS float*)(lds + B_TOFF) + (32 * qg + r32) * 8;
            const LAS unsigned char* qp = lds + (32 * qg + r32) * B_QROW + hi * 16;
            LAS unsigned* hrow = hist + (32 * qg + r32) * B_HROW;
            const int tq = q0 + 32 * qg + r32;
#pragma unroll 1
            for (int rep1 = 0; rep1 < REPK; ++rep1)
#pragma unroll 1
            for (int kt = ks; kt < NT; kt += 4) {
                const int k0 = 64 * kt;
                f16x8 kf[2][4];
#pragma unroll
                for (int hf = 0; hf < 2; ++hf)
#pragma unroll
                    for (int ds = 0; ds < 4; ++ds) kf[hf][ds] = *(const f16x8*)(IK + (tokbase + k0 + 32 * hf + pi32(r32)) * 64 + 16 * ds + 8 * hi);
                f32x16 acc0, acc1;
#pragma unroll
                for (int r = 0; r < 16; ++r) { acc0[r] = 0.f; acc1[r] = 0.f; }
#pragma unroll 2
                for (int hh = 0; hh < 8; ++hh) {
                    const float wh = wp[hh];
                    f32x16 s0, s1;
#pragma unroll
                    for (int r = 0; r < 16; ++r) { s0[r] = 0.f; s1[r] = 0.f; }
#pragma unroll
                    for (int ds = 0; ds < 4; ++ds) { const f16x8 qfr = *(const LAS f16x8*)(qp + hh * 128 + ds * 32);
                        s0 = __builtin_amdgcn_mfma_f32_32x32x16_f16(kf[0][ds], qfr, s0, 0, 0, 0); s1 = __builtin_amdgcn_mfma_f32_32x32x16_f16(kf[1][ds], qfr, s1, 0, 0, 0); }
#pragma unroll
                    for (int r = 0; r < 16; ++r) { acc0[r] += wh * fmaxf(s0[r], 0.f); acc1[r] += wh * fmaxf(s1[r], 0.f); }
                }
                float* sp = SC + (size_t)(32 * qg + r32) * SEQ + k0 + 8 * hi;
                *(f32x4*)(sp) = (f32x4){acc0[0], acc0[1], acc0[2], acc0[3]}; *(f32x4*)(sp + 4) = (f32x4){acc0[4], acc0[5], acc0[6], acc0[7]};
                *(f32x4*)(sp + 16) = (f32x4){acc0[8], acc0[9], acc0[10], acc0[11]}; *(f32x4*)(sp + 20) = (f32x4){acc0[12], acc0[13], acc0[14], acc0[15]};
                *(f32x4*)(sp + 32) = (f32x4){acc1[0], acc1[1], acc1[2], acc1[3]}; *(f32x4*)(sp + 36) = (f32x4){acc1[4], acc1[5], acc1[6], acc1[7]};
                *(f32x4*)(sp + 48) = (f32x4){acc1[8], acc1[9], acc1[10], acc1[11]}; *(f32x4*)(sp + 52) = (f32x4){acc1[12], acc1[13], acc1[14], acc1[15]};
                if (q0 + 63 > 255 && rep1 == 0) {
                    int e0 = k0 + 8 * hi; asm volatile("" : "+v"(e0));
#pragma unroll
                    for (int r = 0; r < 16; ++r) { const int kp0 = e0 + 16 * (r >> 3) + (r & 7);
                        if (kp0 <= tq) atomicAdd((unsigned*)&hrow[ord_key(acc0[r]) >> 24], 1u);
                        if (kp0 + 32 <= tq) atomicAdd((unsigned*)&hrow[ord_key(acc1[r]) >> 24], 1u); }
                }
            }
        }
#endif
        }
        __builtin_amdgcn_fence(__ATOMIC_RELEASE, "workgroup");
        __syncthreads();
        __builtin_amdgcn_fence(__ATOMIC_ACQUIRE, "workgroup");
        {
        const int tid = otid(wv);
        const int lane = tid & 63, wid = __builtin_amdgcn_readfirstlane(tid >> 6);
#pragma unroll 1
        for (int rr = 0; rr < 8; ++rr) {
            const int row = wid * 8 + rr; const int need = needv[row];
            if (need > 0) {
                const LAS unsigned* hr = hist + row * B_HROW + 4 * lane;
                const unsigned c0 = hr[0], c1 = hr[1], c2 = hr[2], c3 = hr[3];
                const unsigned sl = c0 + c1 + c2 + c3; unsigned suf = sl;
#pragma unroll
                for (int o = 1; o < 64; o <<= 1) { const unsigned tv = __shfl_down(suf, o); if (lane + o < 64) suf += tv; }
                unsigned cum = suf - sl; int fbin = -1; unsigned fabove = 0u, fcnt = 0u;
                { if ((int)cum < need && (int)(cum + c3) >= need) { fbin = 4 * lane + 3; fabove = cum; fcnt = c3; } cum += c3;
                  if ((int)cum < need && (int)(cum + c2) >= need) { fbin = 4 * lane + 2; fabove = cum; fcnt = c2; } cum += c2;
                  if ((int)cum < need && (int)(cum + c1) >= need) { fbin = 4 * lane + 1; fabove = cum; fcnt = c1; } cum += c1;
                  if ((int)cum < need && (int)(cum + c0) >= need) { fbin = 4 * lane + 0; fabove = cum; fcnt = c0; } }
                if (fbin >= 0) { pfx[row] = (unsigned)fbin << 24; needv[row] = need - (int)fabove; ceqv[row] = fcnt; }
            }
        }
        }
        __syncthreads();
        {
            const int tid = otid(wv);
            for (int i = tid; i < 2560; i += 512) { const int hh = i / 320, d = 223 - (i - 320 * hh);
                Tb[i] = d < 0 ? -1e30f : (p.rel_bias[t5_bucket(min(d, 127)) * 12 + 4 + hh] - p.rel_bias[31 * 12 + 4 + hh]) * LOG2E; }
        }
        {
        const int tid = otid(wv);
        const int lane = tid & 63, wid = __builtin_amdgcn_readfirstlane(tid >> 6);
        LAS unsigned* wh = (LAS unsigned*)lds + wid * 320;
        const int nwords = 2 * NT;
        u32x4 bufA[16], bufB[16];
#define ROW_LOAD(buf, rowi) do { const float* sr_ = SC + (size_t)(rowi) * SEQ + 4 * lane; _Pragma("unroll") for (int i = 0; i < 16; ++i) { buf[i] = (u32x4){0u, 0u, 0u, 0u}; if (256 * i <= q0 + 63) buf[i] = *(const u32x4*)(sr_ + 256 * i); } } while (0)
#define OKEY(u) ((u) ^ (((u) >> 31) ? 0xffffffffu : 0x80000000u))
#define ROW_PROC(key, rowi) do { \
            const int row = (rowi), tr = q0 + row; \
            unsigned thr = 0u; int cut = -1; \
            int need = needv[row]; \
            _Pragma("unroll") for (int i = 0; i < 16; ++i) { const int e = 256 * i + 4 * lane; \
                key[i].x = (e <= tr) ? OKEY(key[i].x) : 0u; key[i].y = (e + 1 <= tr) ? OKEY(key[i].y) : 0u; key[i].z = (e + 2 <= tr) ? OKEY(key[i].z) : 0u; key[i].w = (e + 3 <= tr) ? OKEY(key[i].w) : 0u; } \
            if (need > 0) { \
                unsigned prefix = pfx[row]; unsigned cnt = ceqv[row]; bool done = false; \
                if (need == (int)cnt) { thr = prefix - 1u; done = true; } \
                _Pragma("unroll 1") for (int pass = 1; pass < 4 && !done; ++pass) { \
                    const int shift = 24 - 8 * pass; const unsigned msk = 0xffffffffu << (shift + 8); \
                    wh[lane] = 0u; wh[64 + lane] = 0u; wh[128 + lane] = 0u; wh[192 + lane] = 0u; \
                    _Pragma("unroll") for (int i = 0; i < 16; ++i) { \
                        { const unsigned k = key[i].x; atomicAdd((unsigned*)&wh[((k & msk) == prefix) ? ((k >> shift) & 255u) : (256u + lane)], 1u); } \
                        { const unsigned k = key[i].y; atomicAdd((unsigned*)&wh[((k & msk) == prefix) ? ((k >> shift) & 255u) : (256u + lane)], 1u); } \
                        { const unsigned k = key[i].z; atomicAdd((unsigned*)&wh[((k & msk) == prefix) ? ((k >> shift) & 255u) : (256u + lane)], 1u); } \
                        { const unsigned k = key[i].w; atomicAdd((unsigned*)&wh[((k & msk) == prefix) ? ((k >> shift) & 255u) : (256u + lane)], 1u); } } \
                    const unsigned c0 = wh[4 * lane], c1 = wh[4 * lane + 1], c2 = wh[4 * lane + 2], c3 = wh[4 * lane + 3]; \
                    const unsigned sl = c0 + c1 + c2 + c3; unsigned suf = sl; \
                    _Pragma("unroll") for (int o = 1; o < 64; o <<= 1) { const unsigned tv = __shfl_down(suf, o); if (lane + o < 64) suf += tv; } \
                    unsigned cum = suf - sl; int fbin = -1; unsigned fabove = 0u, fcnt = 0u; \
                    { if ((int)cum < need && (int)(cum + c3) >= need) { fbin = 4 * lane + 3; fabove = cum; fcnt = c3; } cum += c3; \
                      if ((int)cum < need && (int)(cum + c2) >= need) { fbin = 4 * lane + 2; fabove = cum; fcnt = c2; } cum += c2; \
                      if ((int)cum < need && (int)(cum + c1) >= need) { fbin = 4 * lane + 1; fabove = cum; fcnt = c1; } cum += c1; \
                      if ((int)cum < need && (int)(cum + c0) >= need) { fbin = 4 * lane + 0; fabove = cum; fcnt = c0; } } \
                    const unsigned long long bm = __ballot(fbin >= 0); const int src = __ffsll((long long)bm) - 1; \
                    const int bin = __shfl(fbin, src); const unsigned above = __shfl(fabove, src); cnt = __shfl(fcnt, src); \
                    prefix |= (unsigned)bin << shift; need -= (int)above; \
                    if (pass < 3 && need == (int)cnt) { thr = prefix - 1u; done = true; } \
                } \
                if (!done) { thr = prefix; cut = 4096; \
                    if (need < (int)cnt) {        \
                        const float* srow = SC + (size_t)row * SEQ; int tbase = 0; \
                        for (int j = 0; j * 64 <= tr; ++j) { const int e = 64 * j + lane; const bool eq = (e <= tr) && (ord_key(srow[e]) == thr); \
                            const unsigned long long be = __ballot(eq); \
                            const int tpos = tbase + (int)__builtin_amdgcn_mbcnt_hi((unsigned)(be >> 32), __builtin_amdgcn_mbcnt_lo((unsigned)be, 0u)); \
                            const unsigned long long bh = __ballot(eq && tpos == need - 1); \
                            if (bh) { cut = 64 * j + (__ffsll((long long)bh) - 1); break; } \
                            tbase += __popcll(be); } \
                    } \
                } \
            } \
            LAS unsigned* mw = (LAS unsigned*)(lds + B_MASK) + row * B_MROW; \
            _Pragma("unroll") for (int i = 0; i < 16; ++i) if (256 * i <= q0 + 63) { const int e = 256 * i + 4 * lane; \
                unsigned nib = 0u; \
                nib |= (key[i].x > thr || (key[i].x == thr && e <= cut)) ? 1u : 0u; nib |= (key[i].y > thr || (key[i].y == thr && e + 1 <= cut)) ? 2u : 0u; \
                nib |= (key[i].z > thr || (key[i].z == thr && e + 2 <= cut)) ? 4u : 0u; nib |= (key[i].w > thr || (key[i].w == thr && e + 3 <= cut)) ? 8u : 0u; \
                unsigned v = nib << (4 * (lane & 7)); v |= __shfl_xor(v, 1); v |= __shfl_xor(v, 2); v |= __shfl_xor(v, 4); \
                const int w = 8 * i + (lane >> 3); if ((lane & 7) == 0 && w < nwords) mw[w] = v; } \
        } while (0)
        ROW_LOAD(bufA, wid * 8);
#pragma unroll 1
        for (int rr = 0; rr < 8; rr += 2) {
            ROW_LOAD(bufB, wid * 8 + rr + 1);
            ROW_PROC(bufA, wid * 8 + rr);
            if (rr + 2 < 8) ROW_LOAD(bufA, wid * 8 + rr + 2);
            ROW_PROC(bufB, wid * 8 + rr + 1);
        }
#undef ROW_LOAD
#undef ROW_PROC
#undef OKEY
        }
        __syncthreads();
#pragma unroll 1
        for (int rep3 = 0; rep3 < ((SKIP & 8) ? 0 : REPT); ++rep3) {
        const int tid = otid(wv);
        const int lane = tid & 63, wid = __builtin_amdgcn_readfirstlane(tid >> 6), r32 = lane & 31, hi = lane >> 5; (void)r32; (void)hi; (void)wid;
            LAS float* linv = (LAS float*)(lds + B_LINV) + wid * 64;
            const int qg = wid & 1, hp = wid >> 1, g = hp >> 1;
            const int qpos = q0 + 32 * qg + r32, qw0 = q0 + 32 * qg;
            const unsigned char* Qp0 = BQ + (tokbase + qpos) * 1024 + (2 * hp) * 128 + hi * 16;
            const LAS unsigned* mrow = (const LAS unsigned*)(lds + B_MASK) + (32 * qg + r32) * B_MROW;
            bf16x8 qf2[2][4];
#pragma unroll
            for (int hh = 0; hh < 2; ++hh)
#pragma unroll
                for (int ds = 0; ds < 4; ++ds) qf2[hh][ds] = *(const bf16x8*)(Qp0 + hh * 128 + 32 * ds);
            f32x16 O[2][2];
#pragma unroll
            for (int hh = 0; hh < 2; ++hh)
#pragma unroll
                for (int db = 0; db < 2; ++db)
#pragma unroll
                    for (int r = 0; r < 16; ++r) O[hh][db][r] = 0.f;
            float l0 = 0.f, l1 = 0.f;
            u32x4 kreg[2], vreg[2];
            const int srow_ = tid >> 4, sch = tid & 15;
#define B_LOAD(t) do { _Pragma("unroll") for (int i = 0; i < 2; ++i) { const size_t gofs = (tokbase + 64 * (t) + srow_ + 32 * i) * 256 + sch * 16; \
            kreg[i] = *(const u32x4*)(BK + gofs); vreg[i] = *(const u32x4*)(BV + gofs); } } while (0)
#define B_WRITE(st) do { _Pragma("unroll") for (int i = 0; i < 2; ++i) { *(LAS u32x4*)(lds + (st) * A_STG + (srow_ + 32 * i) * A_KROW + sch * 16) = kreg[i]; \
            *(LAS u32x4*)(lds + (st) * A_STG + A_KBUF + (srow_ + 32 * i) * A_VROW + sch * 16) = vreg[i]; } } while (0)
            B_LOAD(0); B_WRITE(0);
            __syncthreads();
#pragma unroll 1
            for (int t = 0; t < NT; ++t) {
                if (t + 1 < NT) B_LOAD(t + 1);
                const int k0 = 64 * t;
                const bool near = (k0 + 63 + 113 > qw0);
                const LAS unsigned char* Kb = lds + (t & 1) * A_STG; const LAS unsigned char* Vb = Kb + A_KBUF;
                unsigned selm;
                { const unsigned w0 = mrow[2 * t] >> (8 * hi), w1 = mrow[2 * t + 1] >> (8 * hi);
                  selm = (w0 & 0xffu) | ((w0 >> 8) & 0xff00u) | ((w1 & 0xffu) << 16) | ((w1 << 8) & 0xff000000u); }
                float sacc0 = 0.f, sacc1 = 0.f;
#pragma unroll
                for (int hf = 0; hf < 2; ++hf) {
                    f32x16 s0, s1;
#pragma unroll
                    for (int r = 0; r < 16; ++r) { const float cm = ((selm >> (16 * hf + r)) & 1u) ? 0.f : -1e30f; s0[r] = cm; s1[r] = cm; }
                    const LAS unsigned char* kp = Kb + (32 * hf + pi32(r32)) * A_KROW + g * 128 + hi * 16;
#pragma unroll
                    for (int ds = 0; ds < 4; ++ds) { const bf16x8 kf = *(const LAS bf16x8*)(kp + 32 * ds);
                        s0 = __builtin_amdgcn_mfma_f32_32x32x16_bf16(kf, qf2[0][ds], s0, 0, 0, 0); s1 = __builtin_amdgcn_mfma_f32_32x32x16_bf16(kf, qf2[1][ds], s1, 0, 0, 0); }
                    if (!near) {
#pragma unroll
                        for (int r = 0; r < 16; ++r) { s0[r] = __builtin_amdgcn_exp2f(s0[r]); s1[r] = __builtin_amdgcn_exp2f(s1[r]); }
                    } else {
                        int ib = 223 - (qpos - k0 - 8 * hi - 32 * hf); asm volatile("" : "+v"(ib));
                        const LAS float* tp0 = Tb + (2 * hp) * 320 + ib; const LAS float* tp1 = tp0 + 320;
#pragma unroll
                        for (int r = 0; r < 16; ++r) { s0[r] = __builtin_amdgcn_exp2f(s0[r] + tp0[16 * (r >> 3) + (r & 7)]); s1[r] = __builtin_amdgcn_exp2f(s1[r] + tp1[16 * (r >> 3) + (r & 7)]); }
                    }
#pragma unroll
                    for (int r = 0; r < 16; ++r) { sacc0 += s0[r]; sacc1 += s1[r]; }
#pragma unroll
                    for (int jj = 0; jj < 2; ++jj) {
                        const int j = 2 * hf + jj, rb = 8 * jj;
                        u32x4 pw0, pw1;
                        pw0.x = cvt_pk_bf16(s0[rb], s0[rb + 1]); pw0.y = cvt_pk_bf16(s0[rb + 2], s0[rb + 3]); pw0.z = cvt_pk_bf16(s0[rb + 4], s0[rb + 5]); pw0.w = cvt_pk_bf16(s0[rb + 6], s0[rb + 7]);
                        pw1.x = cvt_pk_bf16(s1[rb], s1[rb + 1]); pw1.y = cvt_pk_bf16(s1[rb + 2], s1[rb + 3]); pw1.z = cvt_pk_bf16(s1[rb + 4], s1[rb + 5]); pw1.w = cvt_pk_bf16(s1[rb + 6], s1[rb + 7]);
                        const bf16x8 pa0 = __builtin_bit_cast(bf16x8, pw0), pa1 = __builtin_bit_cast(bf16x8, pw1);
                        const LAS unsigned char* vp = Vb + (16 * j + 8 * hi + ((lane & 15) >> 2)) * A_VROW + (g * 64 + 16 * ((lane >> 4) & 1) + 4 * (lane & 3)) * 2;
#pragma unroll
                        for (int db = 0; db < 2; ++db) {
                            const s16x4 lo = vtr(vp + db * 64), hv = vtr(vp + 4 * A_VROW + db * 64);
                            const bf16x8 vf = (bf16x8){lo[0], lo[1], lo[2], lo[3], hv[0], hv[1], hv[2], hv[3]};
                            O[0][db] = __builtin_amdgcn_mfma_f32_32x32x16_bf16(pa0, vf, O[0][db], 0, 0, 0);
                            O[1][db] = __builtin_amdgcn_mfma_f32_32x32x16_bf16(pa1, vf, O[1][db], 0, 0, 0);
                        }
                    }
                    __builtin_amdgcn_sched_barrier(0);
                }
                l0 += sacc0; l1 += sacc1;
                if (t + 1 < NT) B_WRITE((t + 1) & 1);
                __syncthreads();
            }
#undef B_LOAD
#undef B_WRITE
            l0 += __shfl_xor(l0, 32); l1 += __shfl_xor(l1, 32);
            if (hi == 0) { linv[r32] = 1.0f / l0; linv[32 + r32] = 1.0f / l1; }
#pragma unroll
            for (int hh = 0; hh < 2; ++hh)
#pragma unroll
                for (int r = 0; r < 16; ++r) { const int qr = crow(r, hi); const float f = linv[32 * hh + qr];
                    bf16_t* op = CAT + (tokbase + q0 + 32 * qg + qr) * 1024 + 512 + (2 * hp + hh) * 64 + r32;
#pragma unroll
                    for (int db = 0; db < 2; ++db) op[32 * db] = (bf16_t)(cvt_pk_bf16(O[hh][db][r] * f, 0.f) & 0xffffu); }
            if (REPT > 1) __syncthreads();
        }
        __syncthreads();
    }
}
#ifndef REPG1
#define REPG1 1
#endif
#ifndef REPG2
#define REPG2 1
#endif
#ifndef REPG3
#define REPG3 1
#endif
#ifndef PH
#define PH 255
#endif

#define XB_TMO      128
#define XB_XCNT(j)  (256  + 64 * (j))
#define XB_XSUB(j)  (1280 + 64 * (j))
#define XB_XGEN(j)  (2304 + 64 * (j))
#define XB_TOP      3328
#define XB_TOPGEN   3392
#define XCD_BAR_WORDS 3456
#define XB_SPIN_CAP (1u << 18)

__device__ __forceinline__ unsigned xb_ld(unsigned* p)              { return __hip_atomic_load(p, __ATOMIC_RELAXED, __HIP_MEMORY_SCOPE_AGENT); }
__device__ __forceinline__ unsigned xb_add(unsigned* p, unsigned v) { return __hip_atomic_fetch_add(p, v, __ATOMIC_RELAXED, __HIP_MEMORY_SCOPE_AGENT); }
__device__ __forceinline__ unsigned xb_xcc_id() { return (unsigned)__builtin_amdgcn_s_getreg((3 << 11) | 20) & 0xFu; }
#define XB_SPIN(cond, bar) do { unsigned _sp = 0; while (cond) { __builtin_amdgcn_s_sleep(1); \
    if ((++_sp & 255u) == 0u) { if (xb_ld(&(bar)[XB_TMO])) break; if (_sp > XB_SPIN_CAP) { atomicAdd(&(bar)[XB_TMO], 1u); break; } } } } while (0)

struct XcdBarrier {
    unsigned* bar; unsigned x;
    volatile LAS unsigned* st;
};

__device__ __forceinline__ XcdBarrier xcd_barrier_post(unsigned* bar, volatile LAS unsigned* st) {
    XcdBarrier b; b.bar = bar; b.x = xb_xcc_id(); b.st = st;
    if (threadIdx.x == 0) (void)xb_add(&bar[XB_XCNT(b.x)], 1u);
    return b;
}
__device__ __forceinline__ void xcd_barrier_complete(unsigned* bar, unsigned x, unsigned& nloc, unsigned& nx) {
    const unsigned G = gridDim.x * gridDim.y * gridDim.z;
    unsigned sum, cnt, mine, sp = 0u;
    for (;;) {
        sum = 0u; cnt = 0u; mine = 0u;
#pragma unroll
        for (unsigned j = 0; j < 16; ++j) { const unsigned c = xb_ld(&bar[XB_XCNT(j)]); sum += c; cnt += (c > 0u) ? 1u : 0u; mine = (j == x) ? c : mine; }
        if (sum == G) break;
        __builtin_amdgcn_s_sleep(1);
        if ((++sp & 255u) == 0u) { if (xb_ld(&bar[XB_TMO])) break; if (sp > XB_SPIN_CAP) { atomicAdd(&bar[XB_TMO], 1u); break; } }
    }
    nloc = mine > 0u ? mine : 1u; nx = cnt > 0u ? cnt : 1u;
}

__device__ __forceinline__ void xcd_barrier(const XcdBarrier& b) {
    asm volatile("s_waitcnt vmcnt(0)" ::: "memory");
    __syncthreads();
    if (threadIdx.x == 0) {
        unsigned* bar = b.bar;
        __builtin_amdgcn_s_waitcnt(0);
        unsigned nloc = b.st[0], nx = b.st[1];
        if (nloc == 0u) { xcd_barrier_complete(bar, b.x, nloc, nx); b.st[0] = nloc; b.st[1] = nx; }
        const unsigned old = xb_add(&bar[XB_XSUB(b.x)], 1u);
        const unsigned gen = old / nloc;
        if (old + 1u == (gen + 1u) * nloc) {
            __builtin_amdgcn_fence(__ATOMIC_RELEASE, "agent");
            asm volatile("s_waitcnt vmcnt(0)" ::: "memory");
            const unsigned og = xb_add(&bar[XB_TOP], 1u);
            const unsigned tg = og / nx;
            if (og + 1u == (tg + 1u) * nx) xb_add(&bar[XB_TOPGEN], 1u);
            else XB_SPIN(xb_ld(&bar[XB_TOPGEN]) == tg, bar);
            __builtin_amdgcn_fence(__ATOMIC_ACQUIRE, "agent");
            xb_add(&bar[XB_XGEN(b.x)], 1u);
            asm volatile("s_waitcnt vmcnt(0)" ::: "memory");
        } else {
            XB_SPIN(xb_ld(&bar[XB_XGEN(b.x)]) == gen, bar);
            __builtin_amdgcn_fence(__ATOMIC_ACQUIRE, "agent");
            asm volatile("s_waitcnt vmcnt(0)" ::: "memory");
        }
    }
    __syncthreads();
}

constexpr size_t WS_BAR = 786432;
constexpr int XB_LDS_OFF = LDS_BYTES - 16;
typedef const __attribute__((address_space(4))) Params* KParamsPtr;
__device__ __forceinline__ Params load_params(KParamsPtr q) {
    Params r; r.x = q->x; r.c = q->c; r.w_ada = q->w_ada; r.b_ada = q->b_ada; r.g_attn = q->g_attn; r.w_in = q->w_in; r.qna = q->qna; r.kna = q->kna; r.qnb = q->qnb; r.knb = q->knb;
    r.lam = q->lam; r.subln = q->subln; r.w_out = q->w_out; r.g_ffn = q->g_ffn; r.w_up = q->w_up; r.conv_w = q->conv_w; r.conv_b = q->conv_b; r.w_down = q->w_down; r.rel_bias = q->rel_bias;
    r.out = q->out; r.ws = q->ws; return r;
}
#define FRESH_PARAMS() KParamsPtr pp_ = (KParamsPtr)__builtin_amdgcn_kernarg_segment_ptr(); asm volatile("" : "+s"(pp_)); const Params p = load_params(pp_); \
    float* mod = (float*)(p.ws + WS_MOD); bf16_t* H = (bf16_t*)(p.ws + WS_H); const int G = (int)gridDim.x, cb = (int)blockIdx.x; (void)mod; (void)H; (void)G; (void)cb
__global__ void __launch_bounds__(512, 2) hybrid_block_fwd(Params p_unused) {
    extern __shared__ __attribute__((aligned(16))) unsigned char lds_raw[];
    LAS unsigned char* lds = (LAS unsigned char*)lds_raw;
    cg::grid_group grid = cg::this_grid();
    if (threadIdx.x < 4) ((LAS unsigned*)(lds + XB_LDS_OFF))[threadIdx.x] = 0u;
    __syncthreads();
    const int wv = __builtin_amdgcn_readfirstlane((int)threadIdx.x >> 6);
    { FRESH_PARAMS(); if (blockIdx.x == 0) { unsigned* bw = (unsigned*)(p.ws + WS_BAR); for (int i = threadIdx.x; i < XCD_BAR_WORDS; i += 512) bw[i] = 0u; }
      phase0(p, lds, wv); }
    grid.sync();
    XcdBarrier bar;
    { FRESH_PARAMS(); bar = xcd_barrier_post((unsigned*)(p.ws + WS_BAR), (volatile LAS unsigned*)(lds + XB_LDS_OFF)); }
    { FRESH_PARAMS(); norm_phase(p.x, p.g_attn, mod, 1024, 0, H, wv); }
    xcd_barrier(bar);
    {
        FRESH_PARAMS();
        pg8::Gemm g{H, (const bf16_t*)(p.ws + WS_WIN), MTOK, NPROJ, DM}; pg8::StaticOrder S; S.init(MTOK, NPROJ, G, cb);
        EpiProj E{p.ws, p.qna, p.kna, p.qnb, p.knb};
#pragma unroll 1
        for (int rep = 0; rep < REPG1; ++rep) pg8::gemm_phase<EpiProj, pg8::StaticOrder, true, true>(lds, g, S, E, wv);
    }
    xcd_barrier(bar);
    { FRESH_PARAMS(); attnA_phase(p, lds, wv); }
    __syncthreads();
    { FRESH_PARAMS(); phaseB(p, lds, wv); }
    xcd_barrier(bar);
    {
        FRESH_PARAMS();
        pg8::Gemm g{(const bf16_t*)(p.ws + WS_CAT), (const bf16_t*)(p.ws + WS_WOUT), MTOK, DM, DM}; pg8::StaticOrder S; S.init(MTOK, DM, G, cb);
        EpiOut E{p.x, mod + 2048, p.out};
#pragma unroll 1
        for (int rep = 0; rep < REPG2; ++rep) pg8::gemm_phase<EpiOut, pg8::StaticOrder, true, true>(lds, g, S, E, wv);
    }
    xcd_barrier(bar);
    { FRESH_PARAMS(); norm_phase(p.out, p.g_ffn, mod, 4096, 3072, H, wv); }
    xcd_barrier(bar);
    {
        FRESH_PARAMS();
        pg8::Gemm g{H - 2 * DM, (const bf16_t*)(p.ws + WS_WUP), 259 * 256, NUP, DM, 254}; pg8::StaticOrder S; S.init(259 * 256, NUP, G, cb);
        EpiUpConv E{(bf16_t*)(p.ws + WS_U), p.conv_w, p.conv_b, (LAS float*)(lds + HALO_OFF)};
#pragma unroll 1
        for (int rep = 0; rep < REPG3; ++rep) pg8::gemm_phase<EpiUpConv, pg8::StaticOrder, true, true>(lds, g, S, E, wv);
    }
    xcd_barrier(bar);
    {
        FRESH_PARAMS();
        pg8::Gemm g{(const bf16_t*)(p.ws + WS_U), (const bf16_t*)(p.ws + WS_WDN), MTOK, DM, DFF}; pg8::StaticOrder S; S.init(MTOK, DM, G, cb);
        EpiDown E{mod + 5120, p.out, 0};
        pg8::gemm_phase<EpiDown, pg8::StaticOrder, true, true>(lds, g, S, E, wv);
    }
}

extern "C" void kernel_launch(void* const* d_in, const int* in_sizes, int n_in, void* d_out, int out_size, void* d_ws, size_t ws_size, hipStream_t stream) {
    static int grid_blocks = 0;
    if (grid_blocks == 0) {
        if (n_in != 19 || ws_size < WS_END) { fprintf(stderr, "kernel_launch: unexpected n_in %d / ws %zu\n", n_in, ws_size); grid_blocks = -1; return; }
        int dev = 0, cus = 0, per_cu = 0;
        hipGetDevice(&dev);
        hipDeviceGetAttribute(&cus, hipDeviceAttributeMultiprocessorCount, dev);
        if (hipFuncSetAttribute((const void*)hybrid_block_fwd, hipFuncAttributeMaxDynamicSharedMemorySize, LDS_BYTES) != hipSuccess) { fprintf(stderr, "hipFuncSetAttribute failed\n"); }
        if (hipOccupancyMaxActiveBlocksPerMultiprocessor(&per_cu, (const void*)hybrid_block_fwd, 512, LDS_BYTES) != hipSuccess || per_cu < 1) { fprintf(stderr, "occupancy query: %d\n", per_cu); per_cu = 1; }
        (void)hipGetLastError();
        grid_blocks = cus * (per_cu > 1 ? 1 : per_cu);
        if (grid_blocks > 256) grid_blocks = 256;
    }
    if (grid_blocks < 0) return;
    Params p{};
    const float** f = (const float**)&p;
    for (int i = 0; i < 19; ++i) f[i] = (const float*)d_in[i];
    p.out = (float*)d_out; p.ws = (unsigned char*)d_ws;
    void* args[] = {&p};
    hipError_t e = hipLaunchCooperativeKernel((const void*)hybrid_block_fwd, dim3(grid_blocks), dim3(512), args, LDS_BYTES, stream);
    if (e != hipSuccess) fprintf(stderr, "cooperative launch failed: %s (grid %d)\n", hipGetErrorString(e), grid_blocks);
}
```

```cpp
#include <hip/hip_runtime.h>
#include <hip/hip_cooperative_groups.h>
#include <cstdio>
#include <cstdint>
#include <cmath>
namespace cg = cooperative_groups;

namespace pg8 {
#define PG8_LAS __attribute__((address_space(3)))
typedef unsigned short bf16_t;
typedef short bf16x8 __attribute__((ext_vector_type(8)));
typedef float f32x4 __attribute__((ext_vector_type(4)));
typedef unsigned u32x4 __attribute__((ext_vector_type(4)));
constexpr int BM = 256, BK = 64, HALF = 128, HTB = HALF * BK * 2  , STAGE_BYTES = 8 * HTB, NXCD = 8, WGM = 8;

__host__ __device__ __forceinline__ int lds_byte(int r, int c) { const int st = (r >> 4) * 2 + (c >> 5), rr = r & 15, cc = c & 31, ob = rr * 64 + cc * 2; return st * 1024 + (ob ^ (((ob >> 9) & 1) << 5)); }
__host__ __device__ __forceinline__ void stage_rc(int b, int& R, int& C) { const int st = b / 1024, sb = b % 1024, swz = sb ^ (((sb >> 9) & 1) << 5); R = (st >> 1) * 16 + swz / 64; C = (st & 1) * 32 + (swz % 64) / 2; }
__host__ __device__ __forceinline__ int perm32(int rho) { const int n = rho >> 4, i = rho & 15; return 8 * (i >> 2) + 4 * n + (i & 3); }

struct Unit { int pm, pn; };
struct Gemm { const bf16_t* A; const bf16_t* Bt; int M, N, K; int a_rows = 256; };

struct StaticOrder {
    int nM, nN, nwg, G, c;
    __host__ __device__ void init(int M, int N, int G_, int c_) { nM = M / BM; nN = N / BM; nwg = nM * nN; G = G_; c = c_; }
    __host__ __device__ bool next(int i, Unit& u) const {
        const long L = (long)i * G + c; if (L >= nwg) return false;
        int wgid = (int)L; { const int q = nwg / NXCD, r = nwg % NXCD, xcd = wgid % NXCD, off = wgid / NXCD; wgid = (xcd < r ? xcd * (q + 1) : r * (q + 1) + (xcd - r) * q) + off; }
        const int nig = WGM * nN, gid = wgid / nig, fm = gid * WGM, gsz = (nM - fm) < WGM ? (nM - fm) : WGM;
        u.pm = fm + ((wgid % nig) % gsz); u.pn = (wgid % nig) / gsz; return true;
    }
    __device__ __forceinline__ void a_ready(const Unit&) const {}
    __device__ __forceinline__ void done(const Unit&) const {}
};

__device__ __forceinline__ unsigned cvt_pk_bf16(float lo, float hi) { unsigned r; asm volatile("v_cvt_pk_bf16_f32 %0, %1, %2" : "=v"(r) : "v"(lo), "v"(hi)); return r; }
template <class Epi, class Sched, bool ALIGN_EPI = false, bool SP2 = false>
__device__ __forceinline__ void gemm_phase(PG8_LAS unsigned char* lds, const Gemm g, const Sched& S, const Epi& E, const int wv) {
    int tid_; asm volatile("v_mbcnt_lo_u32_b32 %0, -1, 0\n\tv_mbcnt_hi_u32_b32 %0, -1, %0" : "=v"(tid_)); tid_ += wv * 64;
    const int tid = tid_, wid = __builtin_amdgcn_readfirstlane(tid >> 6), lane = tid & 63, wr = wid >> 2, wc = wid & 3, fr = lane & 15, fq = lane >> 4;
    const int K = g.K, nt = K / BK;
    unsigned voffA[2], voffB[2];
#pragma unroll
    for (int i = 0; i < 2; ++i) { int R, C; stage_rc(tid * 16 + i * 8192, R, C); const int Rb = Epi::PERM ? ((R & ~31) + perm32(R & 31)) : R;
        voffA[i] = (unsigned)(R * K + C) * 2u; voffB[i] = (unsigned)(Rb * K + C) * 2u; }
    const size_t kstep = (size_t)(BK * 2);
    const size_t hstep = (size_t)HALF * K * 2;
    const size_t tstep = 2 * hstep; const size_t tstepA = (size_t)g.a_rows * K * 2;
    const unsigned ldsw = (unsigned)wid * 1024u;
    const int aoff = lds_byte(wr * 64 + fr, fq * 8), boff = lds_byte(wc * 32 + fr, fq * 8);
#define PG8_SA(b, h) (((b) * 2 + (h)) * HTB)
#define PG8_SB(b, h) ((4 + (b) * 2 + (h)) * HTB)
#define PG8_STAGE(bufoff, gbase, voff) do { _Pragma("unroll") for (int _i = 0; _i < 2; ++_i) \
        __builtin_amdgcn_global_load_lds((const unsigned*)((const char*)(gbase) + (voff)[_i]), (PG8_LAS unsigned*)(lds + (bufoff) + ldsw + _i * 8192), 16, 0, 0); } while (0)
#define PG8_LDA(dst, b, h) do { _Pragma("unroll") for (int m = 0; m < 4; ++m) _Pragma("unroll") for (int k = 0; k < 2; ++k) dst[m][k] = *(const PG8_LAS bf16x8*)(lds + PG8_SA(b, h) + aoff + m * 2048 + k * 1024); } while (0)
#define PG8_LDB(dst, b, h) do { _Pragma("unroll") for (int n = 0; n < 2; ++n) _Pragma("unroll") for (int k = 0; k < 2; ++k) dst[n][k] = *(const PG8_LAS bf16x8*)(lds + PG8_SB(b, h) + boff + n * 2048 + k * 1024); } while (0)
#define PG8_MMA(ai, bj, At, Bt) do { __builtin_amdgcn_s_setprio(1); _Pragma("unroll") for (int m = 0; m < 4; ++m) _Pragma("unroll") for (int n = 0; n < 2; ++n) _Pragma("unroll") for (int k = 0; k < 2; ++k) \
        acc[ai][bj][m][n] = __builtin_amdgcn_mfma_f32_16x16x32_bf16(Bt[n][k], At[m][k], acc[ai][bj][m][n], 0, 0, 0); __builtin_amdgcn_s_setprio(0); } while (0)
#define PG8_WAIT_V(n) asm volatile("s_waitcnt vmcnt(" #n ")" ::: "memory")
#define PG8_WAIT_L(n) asm volatile("s_waitcnt lgkmcnt(" #n ")" ::: "memory")
#define PG8_BAR __builtin_amdgcn_s_barrier()
#define PG8_SCHED __builtin_amdgcn_sched_barrier(0)
    Unit cur, nxt; int ui = 0;
    if (!S.next(0, cur)) return;
    f32x4 acc[2][2][4][2];
#pragma unroll
    for (int a = 0; a < 2; ++a)
#pragma unroll
        for (int b = 0; b < 2; ++b)
#pragma unroll
            for (int m = 0; m < 4; ++m)
#pragma unroll
                for (int n = 0; n < 2; ++n) acc[a][b][m][n] = (f32x4){0.f, 0.f, 0.f, 0.f};
    bf16x8 At[4][2], B0[2][2], B1[2][2];
    const char* cA = (const char*)g.A + (size_t)cur.pm * tstepA; const char* cB = (const char*)g.Bt + (size_t)cur.pn * tstep;
    S.a_ready(cur);
    if constexpr (SP2) {
        PG8_STAGE(PG8_SB(0, 0), cB, voffB); PG8_STAGE(PG8_SB(0, 1), cB + hstep, voffB); PG8_STAGE(PG8_SA(0, 0), cA, voffA); PG8_STAGE(PG8_SA(0, 1), cA + hstep, voffA);
        if (wr == 1) PG8_BAR;
        PG8_WAIT_V(2); PG8_BAR;
        PG8_STAGE(PG8_SB(1, 0), cB + kstep, voffB); PG8_STAGE(PG8_SA(1, 0), cA + kstep, voffA); PG8_STAGE(PG8_SB(1, 1), cB + hstep + kstep, voffB);
        PG8_WAIT_V(6); PG8_BAR;
    } else {
        PG8_STAGE(PG8_SB(0, 0), cB, voffB); PG8_STAGE(PG8_SA(0, 0), cA, voffA); PG8_STAGE(PG8_SB(0, 1), cB + hstep, voffB); PG8_STAGE(PG8_SA(0, 1), cA + hstep, voffA);
        if (wr == 1) PG8_BAR;
        PG8_WAIT_V(4); PG8_BAR;
        PG8_STAGE(PG8_SB(1, 0), cB + kstep, voffB); PG8_STAGE(PG8_SA(1, 0), cA + kstep, voffA); PG8_STAGE(PG8_SB(1, 1), cB + hstep + kstep, voffB);
        PG8_WAIT_V(6); PG8_BAR;
    }
    for (;;) {
        const bool has_next = S.next(ui + 1, nxt);
        const char* nA = has_next ? (const char*)g.A + (size_t)nxt.pm * tstepA : cA; const char* nB = has_next ? (const char*)g.Bt + (size_t)nxt.pn * tstep : cB;
        for (int t = 0; t < nt; t += 2) {
            const bool last = (t == nt - 2);
            const char* a1 = cA + (size_t)(t + 1) * kstep;
            const char* a2 = last ? nA : cA + (size_t)(t + 2) * kstep; const char* b2 = last ? nB : cB + (size_t)(t + 2) * kstep;
            const char* a3 = a2 + kstep; const char* b3 = b2 + kstep;
            if (last && has_next) S.a_ready(nxt);
            if constexpr (SP2) {
            PG8_LDB(B0, 0, 0); PG8_LDB(B1, 0, 1); PG8_SCHED; PG8_LDA(At, 0, 0); PG8_STAGE(PG8_SA(1, 1), a1 + hstep, voffA);
            PG8_WAIT_V(8); PG8_WAIT_L(0); PG8_BAR; PG8_MMA(0, 0, At, B0); PG8_MMA(0, 1, At, B1); PG8_BAR; PG8_SCHED;
            PG8_LDA(At, 0, 1); PG8_STAGE(PG8_SB(0, 0), b2, voffB); PG8_STAGE(PG8_SB(0, 1), b2 + hstep, voffB); PG8_STAGE(PG8_SA(0, 0), a2, voffA);
            PG8_WAIT_V(8); PG8_WAIT_L(0); PG8_BAR; PG8_MMA(1, 0, At, B0); PG8_MMA(1, 1, At, B1); PG8_BAR; PG8_SCHED;
            PG8_LDB(B0, 1, 0); PG8_LDB(B1, 1, 1); PG8_SCHED; PG8_LDA(At, 1, 0); PG8_STAGE(PG8_SA(0, 1), a2 + hstep, voffA);
            PG8_WAIT_V(8); PG8_WAIT_L(0); PG8_BAR; PG8_MMA(0, 0, At, B0); PG8_MMA(0, 1, At, B1); PG8_BAR; PG8_SCHED;
            PG8_LDA(At, 1, 1); PG8_STAGE(PG8_SB(1, 0), b3, voffB); PG8_STAGE(PG8_SB(1, 1), b3 + hstep, voffB); PG8_STAGE(PG8_SA(1, 0), a3, voffA);
            PG8_WAIT_V(8); PG8_WAIT_L(0); PG8_BAR; PG8_MMA(1, 0, At, B0); PG8_MMA(1, 1, At, B1); PG8_BAR; PG8_SCHED;
            } else {
            PG8_LDB(B0, 0, 0); PG8_SCHED; PG8_LDA(At, 0, 0); PG8_STAGE(PG8_SA(1, 1), a1 + hstep, voffA);
            PG8_WAIT_L(8); PG8_BAR; PG8_WAIT_L(0); PG8_MMA(0, 0, At, B0); PG8_BAR; PG8_SCHED;
            PG8_LDB(B1, 0, 1); PG8_STAGE(PG8_SB(0, 0), b2, voffB);
            PG8_BAR; PG8_WAIT_L(0); PG8_MMA(0, 1, At, B1); PG8_BAR;
            PG8_LDA(At, 0, 1); PG8_STAGE(PG8_SA(0, 0), a2, voffA);
            PG8_BAR; PG8_WAIT_L(0); PG8_MMA(1, 0, At, B0); PG8_BAR; PG8_SCHED;
            PG8_STAGE(PG8_SB(0, 1), b2 + hstep, voffB);
            PG8_WAIT_V(6); PG8_BAR; PG8_MMA(1, 1, At, B1); PG8_BAR;
            PG8_LDB(B0, 1, 0); PG8_SCHED; PG8_LDA(At, 1, 0); PG8_STAGE(PG8_SA(0, 1), a2 + hstep, voffA);
            PG8_WAIT_L(8); PG8_BAR; PG8_WAIT_L(0); PG8_MMA(0, 0, At, B0); PG8_BAR; PG8_SCHED;
            PG8_LDB(B1, 1, 1); PG8_STAGE(PG8_SB(1, 0), b3, voffB);
            PG8_BAR; PG8_WAIT_L(0); PG8_MMA(0, 1, At, B1); PG8_BAR;
            PG8_LDA(At, 1, 1); PG8_STAGE(PG8_SA(1, 0), a3, voffA);
            PG8_BAR; PG8_WAIT_L(0); PG8_MMA(1, 0, At, B0); PG8_BAR; PG8_SCHED;
            PG8_STAGE(PG8_SB(1, 1), b3 + hstep, voffB);
            PG8_WAIT_V(6); PG8_BAR; PG8_MMA(1, 1, At, B1); PG8_BAR;
            }
        }
        if constexpr (ALIGN_EPI) { if (wr == 0) PG8_BAR; }
        if constexpr (!Epi::AFTER_DRAIN) { E(acc, cur, wr, wc, fr, fq); S.done(cur); }
        if (!has_next) break;
#pragma unroll
        for (int a = 0; a < 2; ++a)
#pragma unroll
            for (int b = 0; b < 2; ++b)
#pragma unroll
                for (int m = 0; m < 4; ++m)
#pragma unroll
                    for (int n = 0; n < 2; ++n) acc[a][b][m][n] = (f32x4){0.f, 0.f, 0.f, 0.f};
        cur = nxt; cA = nA; cB = nB; ++ui;
        if constexpr (ALIGN_EPI) { if (wr == 1) PG8_BAR; }
    }
    PG8_WAIT_V(0);
    if constexpr (!ALIGN_EPI) { if (wr == 0) PG8_BAR; }
    PG8_BAR;
    if constexpr (Epi::AFTER_DRAIN) { E.fused(acc, cur, wr, wc, fr, fq, lds, wid, lane); S.done(cur); }
#undef PG8_SA
#undef PG8_SB
#undef PG8_STAGE
#undef PG8_LDA
#undef PG8_LDB
#undef PG8_MMA
#undef PG8_WAIT_V
#undef PG8_WAIT_L
#undef PG8_BAR
#undef PG8_SCHED
}
}

using pg8::bf16_t; using pg8::f32x4; using pg8::Unit; using pg8::cvt_pk_bf16;
typedef short bf16x8 __attribute__((ext_vector_type(8)));
typedef _Float16 f16x8 __attribute__((ext_vector_type(8)));
typedef float f32x16 __attribute__((ext_vector_type(16)));
typedef unsigned u32x4 __attribute__((ext_vector_type(4)));
typedef unsigned u32x2 __attribute__((ext_vector_type(2)));
typedef short s16x4 __attribute__((ext_vector_type(4)));
#define LAS __attribute__((address_space(3)))

constexpr int BATCH = 16, SEQ = 4096, DM = 1024, MTOK = BATCH * SEQ;
constexpr int NPROJ = 3072, NREAL = 2888, DFF = 2816, NUP = 5632, MODW = 6144;
constexpr int MHALF = MTOK / 2;
constexpr float EPS = 1e-6f, LOG2E = 1.4426950408889634f, QSCALE = 0.125f * LOG2E;
constexpr size_t MiB = 1u << 20;
constexpr size_t WS_MOD = 0, WS_WIN = 1 * MiB, WS_WOUT = 7 * MiB, WS_WUP = 9 * MiB, WS_WDN = 20 * MiB, WS_H = 26 * MiB;
constexpr size_t WS_AQ = 154 * MiB, WS_AK = 218 * MiB, WS_AV = 282 * MiB, WS_BQ = 346 * MiB, WS_BK = 410 * MiB, WS_BV = 426 * MiB;
constexpr size_t WS_IQ = 442 * MiB, WS_IK = 506 * MiB, WS_IW = 514 * MiB, WS_CAT = 516 * MiB, WS_SC = 644 * MiB;
constexpr size_t WS_U = 154 * MiB, WS_G = 506 * MiB, WS_END = 1024 * MiB;
constexpr int LDS_BYTES = 147456;

struct Params {
    const float *x, *c, *w_ada, *b_ada, *g_attn, *w_in, *qna, *kna, *qnb, *knb, *lam, *subln, *w_out, *g_ffn, *w_up, *conv_w, *conv_b, *w_down, *rel_bias;
    float* out; unsigned char* ws;
};

__device__ __forceinline__ int otid(int wv) { int l; asm volatile("v_mbcnt_lo_u32_b32 %0, -1, 0\n\tv_mbcnt_hi_u32_b32 %0, -1, %0" : "=v"(l)); return wv * 64 + l; }
__device__ __forceinline__ float wave_sum(float v) {
#pragma unroll
    for (int o = 1; o < 64; o <<= 1) v += __shfl_xor(v, o);
    return v;
}
__device__ __forceinline__ float wave_max(float v) {
#pragma unroll
    for (int o = 1; o < 64; o <<= 1) v = fmaxf(v, __shfl_xor(v, o));
    return v;
}
__device__ __forceinline__ unsigned pk_f16(float a, float b) {
    _Float16 x = (_Float16)a, y = (_Float16)b;
    return (unsigned)__builtin_bit_cast(unsigned short, x) | ((unsigned)__builtin_bit_cast(unsigned short, y) << 16);
}
__device__ __forceinline__ int pi32(int m) { const int a = m >> 3, h = (m >> 2) & 1, c = m & 3; return 16 * (a >> 1) + 8 * h + 4 * (a & 1) + c; }
__device__ __forceinline__ int crow(int r, int hi) { return (r & 3) + 8 * (r >> 2) + 4 * hi; }
__device__ __forceinline__ int t5_bucket(int n) {
    if (n < 16) return n;
    return 16 + (n >= 19) + (n >= 21) + (n >= 24) + (n >= 27) + (n >= 31) + (n >= 35) + (n >= 40) + (n >= 46) + (n >= 52) + (n >= 59) + (n >= 67) + (n >= 77) + (n >= 87) + (n >= 99) + (n >= 113);
}
__device__ __forceinline__ s16x4 vtr(const LAS unsigned char* p) {
    return __builtin_bit_cast(s16x4, __builtin_amdgcn_ds_read_tr16_b64_v4i16((LAS s16x4*)p));
}

__device__ __forceinline__ int perm_inv(int n) { return (n & ~255) + 128 * ((n >> 5) & 1) + 32 * ((n >> 6) & 3) + (n & 31); }
__device__ __forceinline__ int perm_up(int n) { const int v = n >= DFF, m = n - (v ? DFF : 0); return (m >> 7) * 256 + 128 * v + (m & 127); }
__device__ __forceinline__ void transpose_tile(const float* W, int K, int N, int nreal, bf16_t* Bt, int k0, int n0, int permute, LAS float* scr, int tid) {
#pragma unroll
    for (int i = 0; i < 8; ++i) { const int kk = (tid >> 6) + 8 * i, nn = tid & 63, n = n0 + nn; scr[kk * 65 + nn] = (n < nreal) ? W[(size_t)(k0 + kk) * N + n] : 0.f; }
    __syncthreads();
    { const int nn = tid >> 3, c = tid & 7, n = n0 + nn, drow = permute == 1 ? perm_inv(n) : (permute == 2 ? perm_up(n) : n); const LAS float* s = scr + (8 * c) * 65 + nn;
      u32x4 o; o.x = cvt_pk_bf16(s[0], s[65]); o.y = cvt_pk_bf16(s[130], s[195]); o.z = cvt_pk_bf16(s[260], s[325]); o.w = cvt_pk_bf16(s[390], s[455]);
      *(u32x4*)(Bt + (size_t)drow * K + k0 + 8 * c) = o; }
    __syncthreads();
}
__device__ __forceinline__ void phase0(const Params& p, LAS unsigned char* lds, int wv) {
    const int tid = otid(wv);
    LAS float* sc = (LAS float*)lds;
    LAS float* scr = (LAS float*)(lds + 65536);
    LAS float* red = (LAS float*)(lds + 65536 + 16640);
    constexpr int I_IN = 16 * 48, I_OUT = 16 * 16, I_UP = 16 * 88, I_DN = 44 * 16, NIT = I_IN + I_OUT + I_UP + I_DN;
    for (int it = blockIdx.x; it < NIT; it += gridDim.x) {
        int r = it;
        if (r < I_IN) { transpose_tile(p.w_in, 1024, NREAL, NREAL, (bf16_t*)(p.ws + WS_WIN), 64 * (r / 48), 64 * (r % 48), 1, scr, tid); continue; } r -= I_IN;
        if (r < I_OUT) { transpose_tile(p.w_out, 1024, 1024, 1024, (bf16_t*)(p.ws + WS_WOUT), 64 * (r / 16), 64 * (r % 16), 0, scr, tid); continue; } r -= I_OUT;
        if (r < I_UP) { transpose_tile(p.w_up, 1024, NUP, NUP, (bf16_t*)(p.ws + WS_WUP), 64 * (r / 88), 64 * (r % 88), 2, scr, tid); continue; } r -= I_UP;
        transpose_tile(p.w_down, DFF, 1024, 1024, (bf16_t*)(p.ws + WS_WDN), 64 * (r / 16), 64 * (r % 16), 0, scr, tid);
    }
    if (blockIdx.x < 192) {
        for (int i = tid; i < 16 * 1024; i += 512) { const float v = p.c[i]; sc[i] = v / (1.f + __expf(-v)); }
        __syncthreads();
        float* mod = (float*)(p.ws + WS_MOD);
        for (int g = blockIdx.x; g < 192; g += gridDim.x) {
            const int kq = tid >> 5, col = tid & 31;
            float acc[16];
#pragma unroll
            for (int b = 0; b < 16; ++b) acc[b] = 0.f;
#pragma unroll 1
            for (int kb = 0; kb < 64; kb += 16) {
                float wv16[16];
#pragma unroll
                for (int i = 0; i < 16; ++i) wv16[i] = p.w_ada[(size_t)(kq * 64 + kb + i) * MODW + g * 32 + col];
#pragma unroll
                for (int i = 0; i < 16; ++i) { const int k = kq * 64 + kb + i;
#pragma unroll
                    for (int b = 0; b < 16; ++b) acc[b] += sc[b * 1024 + k] * wv16[i]; } }
#pragma unroll
            for (int b = 0; b < 16; ++b) red[(kq * 16 + b) * 32 + col] = acc[b];
            __syncthreads();
            { const int b = tid >> 5; float s = p.b_ada[g * 32 + col];
#pragma unroll
              for (int q = 0; q < 16; ++q) s += red[(q * 16 + b) * 32 + col];
              mod[b * MODW + g * 32 + col] = s; }
            __syncthreads();
        }
    }
}

__device__ __forceinline__ void norm_phase(const float* X, const float* gvec, const float* mod, int sc_off, int sh_off, bf16_t* H, int wv) {
    const int tid = otid(wv); const int lane = tid & 63, gw = blockIdx.x * 8 + (tid >> 6), NGW = gridDim.x * 8;
    for (int row0 = gw; row0 < MTOK; row0 += 4 * NGW) {
        f32x4 v[4][4];
#pragma unroll
        for (int q = 0; q < 4; ++q) { const int row = min(row0 + q * NGW, MTOK - 1); const f32x4* xr = (const f32x4*)(X + (size_t)row * DM) + lane;
#pragma unroll
            for (int j = 0; j < 4; ++j) v[q][j] = xr[64 * j]; }
#pragma unroll
        for (int q = 0; q < 4; ++q) {
            const int row = row0 + q * NGW;
            float ss = 0.f;
#pragma unroll
            for (int j = 0; j < 4; ++j) ss += (v[q][j].x * v[q][j].x + v[q][j].y * v[q][j].y) + (v[q][j].z * v[q][j].z + v[q][j].w * v[q][j].w);
            const float rs = 1.0f / sqrtf(wave_sum(ss) * (1.f / DM) + EPS);
            if (row < MTOK) { const int b = row >> 12;
#pragma unroll
                for (int j = 0; j < 4; ++j) { const int col = (lane + 64 * j) * 4;
                    const f32x4 g4 = *(const f32x4*)(gvec + col), s4 = *(const f32x4*)(mod + b * MODW + sc_off + col), h4 = *(const f32x4*)(mod + b * MODW + sh_off + col);
                    const f32x4 y = (v[q][j] * rs) * g4 * (s4 + 1.0f) + h4; u32x2 o; o.x = cvt_pk_bf16(y.x, y.y); o.y = cvt_pk_bf16(y.z, y.w);
                    *(u32x2*)(H + (size_t)row * DM + col) = o; } }
        }
    }
}

struct EpiProj {
    static constexpr bool PERM = true, AFTER_DRAIN = false;
    unsigned char* ws; const float *qa, *ka, *qb, *kb;
    __device__ __forceinline__ void operator()(const f32x4 (&acc)[2][2][4][2], const Unit& u, int wr, int wc, int fr, int fq) const {
        const int G = u.pn * 4 + wc;
        if (G >= 46) return;
        int kind = 0, ld = 512, coloff = 0; unsigned char* base = ws; const float* gn = nullptr; float scale = 1.f;
        if (G < 8) { base = ws + WS_AQ; coloff = 64 * G; gn = qa; scale = QSCALE; }
        else if (G < 16) { base = ws + WS_AK; coloff = 64 * (G - 8); gn = ka; }
        else if (G < 24) { base = ws + WS_AV; coloff = 64 * (G - 16); }
        else if (G < 32) { base = ws + WS_BQ; coloff = 64 * (G - 24); gn = qb; scale = QSCALE; }
        else if (G < 34) { base = ws + WS_BK; ld = 128; coloff = 64 * (G - 32); gn = kb; }
        else if (G < 36) { base = ws + WS_BV; ld = 128; coloff = 64 * (G - 34); }
        else if (G < 44) { base = ws + WS_IQ; kind = 1; coloff = 64 * (G - 36); }
        else if (G == 44) { base = ws + WS_IK; kind = 1; ld = 64; }
        else { base = ws + WS_IW; kind = 2; }
        const int row0 = u.pm * 256 + wr * 64 + fr;
        f32x4 gv[2][2];
#pragma unroll
        for (int bj = 0; bj < 2; ++bj)
#pragma unroll
            for (int n = 0; n < 2; ++n) { gv[bj][n] = gn ? *(const f32x4*)(gn + 32 * bj + 8 * fq + 4 * n) : (f32x4){1.f, 1.f, 1.f, 1.f}; gv[bj][n] = gv[bj][n] * scale; }
#pragma unroll
        for (int ai = 0; ai < 2; ++ai)
#pragma unroll
            for (int m = 0; m < 4; ++m) {
                const size_t row = (size_t)(row0 + 128 * ai + 16 * m);
                float rs = 1.f;
                if (gn) { float ss = 0.f;
#pragma unroll
                    for (int bj = 0; bj < 2; ++bj)
#pragma unroll
                        for (int n = 0; n < 2; ++n) { const f32x4 v = acc[ai][bj][m][n]; ss += (v.x * v.x + v.y * v.y) + (v.z * v.z + v.w * v.w); }
                    ss += __shfl_xor(ss, 16); ss += __shfl_xor(ss, 32);
                    rs = __builtin_amdgcn_rsqf(ss * (1.f / 64.f) + EPS); }
                if (kind == 2) { if (fq == 0) { *(f32x4*)((float*)base + row * 8) = acc[ai][0][m][0] * 0.04419417382415922f; *(f32x4*)((float*)base + row * 8 + 4) = acc[ai][0][m][1] * 0.04419417382415922f; } }
                else {
#pragma unroll
                    for (int bj = 0; bj < 2; ++bj) { const f32x4 v0 = acc[ai][bj][m][0] * rs * gv[bj][0], v1 = acc[ai][bj][m][1] * rs * gv[bj][1]; u32x4 w;
                        if (kind == 0) { w.x = cvt_pk_bf16(v0.x, v0.y); w.y = cvt_pk_bf16(v0.z, v0.w); w.z = cvt_pk_bf16(v1.x, v1.y); w.w = cvt_pk_bf16(v1.z, v1.w); }
                        else { w.x = pk_f16(v0.x, v0.y); w.y = pk_f16(v0.z, v0.w); w.z = pk_f16(v1.x, v1.y); w.w = pk_f16(v1.z, v1.w); }
                        *(u32x4*)((bf16_t*)base + row * ld + coloff + 32 * bj + 8 * fq) = w; }
                }
            }
    }
};
struct EpiOut {
    static constexpr bool PERM = true, AFTER_DRAIN = false;
    const float* x; const float* gate; float* out;
    __device__ __forceinline__ void operator()(const f32x4 (&acc)[2][2][4][2], const Unit& u, int wr, int wc, int fr, int fq) const {
        const int row0 = u.pm * 256 + wr * 64 + fr, col0 = u.pn * 256 + wc * 32 + 8 * fq, b = (u.pm * 256) >> 12;
        f32x4 g[2][2];
#pragma unroll
        for (int bj = 0; bj < 2; ++bj)
#pragma unroll
            for (int n = 0; n < 2; ++n) g[bj][n] = *(const f32x4*)(gate + b * MODW + col0 + 128 * bj + 4 * n);
#pragma unroll
        for (int ai = 0; ai < 2; ++ai)
#pragma unroll
            for (int m = 0; m < 4; ++m) { const int row = row0 + 128 * ai + 16 * m;
#pragma unroll
                for (int bj = 0; bj < 2; ++bj)
#pragma unroll
                    for (int n = 0; n < 2; ++n) { const size_t off = (size_t)row * DM + col0 + 128 * bj + 4 * n;
                        const f32x4 xv = *(const f32x4*)(x + off);
                        *(f32x4*)(out + off) = xv + g[bj][n] * acc[ai][bj][m][n]; } }
    }
};
struct EpiUp {
    static constexpr bool PERM = false, AFTER_DRAIN = false;
    bf16_t* U;
    __device__ __forceinline__ void operator()(const f32x4 (&acc)[2][2][4][2], const Unit& u, int wr, int wc, int fr, int fq) const {
        const int row0 = u.pm * 256 + wr * 64 + fr, col0 = u.pn * 256 + wc * 32 + 4 * fq;
#pragma unroll
        for (int ai = 0; ai < 2; ++ai)
#pragma unroll
            for (int m = 0; m < 4; ++m) { const size_t row = (size_t)(row0 + 128 * ai + 16 * m);
#pragma unroll
                for (int bj = 0; bj < 2; ++bj)
#pragma unroll
                    for (int n = 0; n < 2; ++n) { const f32x4 v = acc[ai][bj][m][n]; u32x2 w; w.x = cvt_pk_bf16(v.x, v.y); w.y = cvt_pk_bf16(v.z, v.w);
                        *(u32x2*)(U + row * NUP + col0 + 128 * bj + 16 * n) = w; } }
    }
};
constexpr int HALO_OFF = 131072;
__device__ __forceinline__ f32x4 dpp_ror(const f32x4 v, const int which) {
    f32x4 r;
    if (which == 1) { r.x = __int_as_float(__builtin_amdgcn_update_dpp(0, __float_as_int(v.x), 0x121, 0xf, 0xf, false)); r.y = __int_as_float(__builtin_amdgcn_update_dpp(0, __float_as_int(v.y), 0x121, 0xf, 0xf, false));
                      r.z = __int_as_float(__builtin_amdgcn_update_dpp(0, __float_as_int(v.z), 0x121, 0xf, 0xf, false)); r.w = __int_as_float(__builtin_amdgcn_update_dpp(0, __float_as_int(v.w), 0x121, 0xf, 0xf, false)); }
    else { r.x = __int_as_float(__builtin_amdgcn_update_dpp(0, __float_as_int(v.x), 0x122, 0xf, 0xf, false)); r.y = __int_as_float(__builtin_amdgcn_update_dpp(0, __float_as_int(v.y), 0x122, 0xf, 0xf, false));
           r.z = __int_as_float(__builtin_amdgcn_update_dpp(0, __float_as_int(v.z), 0x122, 0xf, 0xf, false)); r.w = __int_as_float(__builtin_amdgcn_update_dpp(0, __float_as_int(v.w), 0x122, 0xf, 0xf, false)); }
    return r;
}
struct EpiUpConv {
    static constexpr bool PERM = true, AFTER_DRAIN = false;
    bf16_t* Gout; const float* cw; const float* cb; LAS float* halo;
    __device__ __forceinline__ void operator()(const f32x4 (&acc)[2][2][4][2], const Unit& u, int wr, int wc, int fr_, int fq_) const {
        int fr = fr_, fq = fq_; asm volatile("" : "+v"(fr), "+v"(fq));
        if (fr >= 14) {
#pragma unroll
            for (int ai = 0; ai < 2; ++ai)
#pragma unroll
                for (int bj = 0; bj < 2; ++bj)
#pragma unroll
                    for (int n = 0; n < 2; ++n) *(LAS f32x4*)(halo + ((2 * ai + wr) * 2 + (fr - 14)) * 256 + 128 * bj + 32 * wc + 8 * fq + 4 * n) = acc[ai][bj][3][n];
        }
        asm volatile("s_waitcnt lgkmcnt(0)" ::: "memory"); __builtin_amdgcn_s_barrier(); asm volatile("" ::: "memory");
        const int R0 = u.pm * 254 - 2;
#pragma unroll
        for (int n = 0; n < 2; ++n) {
            const int cr = u.pn * 128 + wc * 32 + 8 * fq + 4 * n;
            const f32x4 g0 = *(const f32x4*)(cw + cr), g1 = *(const f32x4*)(cw + NUP + cr), g2 = *(const f32x4*)(cw + 2 * NUP + cr), gb = *(const f32x4*)(cb + cr);
            const f32x4 v0 = *(const f32x4*)(cw + DFF + cr), v1 = *(const f32x4*)(cw + NUP + DFF + cr), v2 = *(const f32x4*)(cw + 2 * NUP + DFF + cr), vb = *(const f32x4*)(cb + DFF + cr);
#pragma unroll
            for (int ai = 0; ai < 2; ++ai) {
                const int seg = 2 * ai + wr;
                f32x4 pr1[2], pr2[2];
#pragma unroll
                for (int bj = 0; bj < 2; ++bj) {
                    pr1[bj] = (f32x4){0.f, 0.f, 0.f, 0.f}; pr2[bj] = (f32x4){0.f, 0.f, 0.f, 0.f};
                    if (seg > 0) { const LAS float* hp = halo + ((seg - 1) * 2) * 256 + 128 * bj + 32 * wc + 8 * fq + 4 * n;
                        pr1[bj] = *(const LAS f32x4*)(hp + 256); pr2[bj] = *(const LAS f32x4*)(hp + ((fr & 1) ? 256 : 0)); }
                }
#pragma unroll
                for (int m = 0; m < 4; ++m) {
                    const int r = 128 * ai + 64 * wr + 16 * m + fr, R = R0 + r, t = R & (SEQ - 1);
                    f32x4 y[2];
#pragma unroll
                    for (int bj = 0; bj < 2; ++bj) {
                        const f32x4 X = acc[ai][bj][m][n]; const f32x4 r1 = dpp_ror(X, 1), r2 = dpp_ror(X, 2);
                        f32x4 p1 = (fr == 0) ? pr1[bj] : r1, p2 = (fr < 2) ? pr2[bj] : r2;
                        pr1[bj] = r1; pr2[bj] = r2;
                        if (t == 0) p1 = (f32x4){0.f, 0.f, 0.f, 0.f};
                        if (t <= 1) p2 = (f32x4){0.f, 0.f, 0.f, 0.f};
                        y[bj] = bj == 0 ? (gb + g0 * p2 + g1 * p1 + g2 * X) : (vb + v0 * p2 + v1 * p1 + v2 * X);
                    }
                    f32x4 o;
                    o.x = y[0].x * __builtin_amdgcn_rcpf(1.f + __builtin_amdgcn_exp2f(-LOG2E * y[0].x)) * y[1].x; o.y = y[0].y * __builtin_amdgcn_rcpf(1.f + __builtin_amdgcn_exp2f(-LOG2E * y[0].y)) * y[1].y;
                    o.z = y[0].z * __builtin_amdgcn_rcpf(1.f + __builtin_amdgcn_exp2f(-LOG2E * y[0].z)) * y[1].z; o.w = y[0].w * __builtin_amdgcn_rcpf(1.f + __builtin_amdgcn_exp2f(-LOG2E * y[0].w)) * y[1].w;
                    if (r >= 2 && R < MTOK) { u32x2 w; w.x = cvt_pk_bf16(o.x, o.y); w.y = cvt_pk_bf16(o.z, o.w); *(u32x2*)(Gout + (size_t)R * DFF + cr) = w; }
                }
            }
        }
    }
};
struct EpiDown {
    static constexpr bool PERM = true, AFTER_DRAIN = false;
    const float* gate; float* out; int rowoff;
    __device__ __forceinline__ void operator()(const f32x4 (&acc)[2][2][4][2], const Unit& u, int wr, int wc, int fr, int fq) const {
        const int row0 = rowoff + u.pm * 256 + wr * 64 + fr, col0 = u.pn * 256 + wc * 32 + 8 * fq, b = (rowoff + u.pm * 256) >> 12;
        f32x4 g[2][2];
#pragma unroll
        for (int bj = 0; bj < 2; ++bj)
#pragma unroll
            for (int n = 0; n < 2; ++n) g[bj][n] = *(const f32x4*)(gate + b * MODW + col0 + 128 * bj + 4 * n);
#pragma unroll
        for (int ai = 0; ai < 2; ++ai)
#pragma unroll
            for (int m = 0; m < 4; ++m) { const int row = row0 + 128 * ai + 16 * m;
#pragma unroll
                for (int bj = 0; bj < 2; ++bj)
#pragma unroll
                    for (int n = 0; n < 2; ++n) { const size_t off = (size_t)row * DM + col0 + 128 * bj + 4 * n;
                        const f32x4 xv = *(const f32x4*)(out + off);
                        *(f32x4*)(out + off) = xv + g[bj][n] * acc[ai][bj][m][n]; } }
    }
};

__device__ __forceinline__ void unpack8(const u32x4 w, float* f) {
    f[0] = __uint_as_float(w.x << 16); f[1] = __uint_as_float(w.x & 0xffff0000u); f[2] = __uint_as_float(w.y << 16); f[3] = __uint_as_float(w.y & 0xffff0000u);
    f[4] = __uint_as_float(w.z << 16); f[5] = __uint_as_float(w.z & 0xffff0000u); f[6] = __uint_as_float(w.w << 16); f[7] = __uint_as_float(w.w & 0xffff0000u);
}
__device__ __forceinline__ void conv_phase(const Params& p, const bf16_t* U, bf16_t* Gb, int wv) {
    constexpr int NCH = DFF / 8, NTASK = (MHALF / 32) * NCH;
    const int tid = otid(wv);
    for (int task = blockIdx.x * 512 + tid; task < NTASK; task += gridDim.x * 512) {
        const int ch = task % NCH, strip = task / NCH, r0 = strip * 32, col = ch * 8;
        float wg[3][8], wv[3][8], bg[8], bv[8];
#pragma unroll
        for (int j = 0; j < 3; ++j)
#pragma unroll
            for (int e = 0; e < 8; ++e) { wg[j][e] = p.conv_w[j * NUP + col + e]; wv[j][e] = p.conv_w[j * NUP + DFF + col + e]; }
#pragma unroll
        for (int e = 0; e < 8; ++e) { bg[e] = p.conv_b[col + e]; bv[e] = p.conv_b[DFF + col + e]; }
        float g2[8], g1[8], v2[8], v1[8];
        if ((r0 & (SEQ - 1)) == 0) {
#pragma unroll
            for (int e = 0; e < 8; ++e) { g2[e] = 0.f; g1[e] = 0.f; v2[e] = 0.f; v1[e] = 0.f; }
        } else {
            unpack8(*(const u32x4*)(U + (size_t)(r0 - 2) * NUP + col), g2); unpack8(*(const u32x4*)(U + (size_t)(r0 - 1) * NUP + col), g1);
            unpack8(*(const u32x4*)(U + (size_t)(r0 - 2) * NUP + DFF + col), v2); unpack8(*(const u32x4*)(U + (size_t)(r0 - 1) * NUP + DFF + col), v1);
        }
        for (int r = 0; r < 32; ++r) {
            float g0[8], v0[8], o[8];
            unpack8(*(const u32x4*)(U + (size_t)(r0 + r) * NUP + col), g0); unpack8(*(const u32x4*)(U + (size_t)(r0 + r) * NUP + DFF + col), v0);
#pragma unroll
            for (int e = 0; e < 8; ++e) {
                const float yg = bg[e] + wg[0][e] * g2[e] + wg[1][e] * g1[e] + wg[2][e] * g0[e];
                const float yv = bv[e] + wv[0][e] * v2[e] + wv[1][e] * v1[e] + wv[2][e] * v0[e];
                o[e] = yg / (1.f + __expf(-yg)) * yv;
                g2[e] = g1[e]; g1[e] = g0[e]; v2[e] = v1[e]; v1[e] = v0[e]; }
            u32x4 w; w.x = cvt_pk_bf16(o[0], o[1]); w.y = cvt_pk_bf16(o[2], o[3]); w.z = cvt_pk_bf16(o[4], o[5]); w.w = cvt_pk_bf16(o[6], o[7]);
            *(u32x4*)(Gb + (size_t)(r0 + r) * DFF + col) = w;
        }
    }
}
#ifndef REPM
#define REPM 1
#endif
#ifndef REPK
#define REPK 1
#endif
#ifndef REPT
#define REPT 1
#endif
#ifndef REPA
#define REPA 1
#endif
#ifndef REPB
#define REPB 1
#endif
#ifndef PB
#define PB 7
#endif

constexpr int A_KROW = 272, A_VROW = 320, A_KBUF = 64 * A_KROW, A_VBUF = 64 * A_VROW, A_STG = A_KBUF + A_VBUF;
constexpr int A_TOFF = 2 * A_STG, A_LOFF = A_TOFF + 1280;
__device__ __forceinline__ void attnA_phase(const Params& p, LAS unsigned char* lds, int wv) {
    const int tid = otid(wv), lane = tid & 63, wid = __builtin_amdgcn_readfirstlane(tid >> 6), r32 = lane & 31, hi = lane >> 5;
    const int c = wid >> 2, qg = wid & 3;
    float lam; { float a = p.lam[lane] * p.lam[64 + lane], b2 = p.lam[128 + lane] * p.lam[192 + lane]; a = wave_sum(a); b2 = wave_sum(b2); lam = expf(a) - expf(b2) + 0.2f; }
    const float Mq = wave_max(fabsf(p.qna[lane])), Mk = wave_max(fabsf(p.kna[lane]));
    const unsigned char* AQ = p.ws + WS_AQ; const unsigned char* AK = p.ws + WS_AK; const unsigned char* AV = p.ws + WS_AV;
    bf16_t* CAT = (bf16_t*)(p.ws + WS_CAT);
    LAS float* T = (LAS float*)(lds + A_TOFF);
    LAS float* linv = (LAS float*)(lds + A_LOFF) + wid * 32;
    const int vblkA = (gridDim.x == 256) ? (int)((blockIdx.x & 7) * 32 + (blockIdx.x >> 3)) : (int)blockIdx.x;
    for (int ui = vblkA; ui < 2048 * REPA; ui += gridDim.x) {
        const int v = ui & 255, rnd = (ui >> 8) & 7, bh = v >> 2, pp = (v & 3) + 4 * (rnd >> 1), qb = (rnd & 1) ? 31 - pp : pp;
        const int b = bh >> 2, h = bh & 3, q0 = qb * 128, NT = 2 * qb + 2;
        const size_t tokbase = (size_t)b * SEQ;
        if (tid < 320) { const int d = 223 - tid;
            T[tid] = d < 0 ? -1e30f : (p.rel_bias[t5_bucket(min(d, 127)) * 12 + h] - p.rel_bias[31 * 12 + h]) * LOG2E; }
        bf16x8 qf[4];
        { const unsigned char* Qp = AQ + (tokbase + q0 + 32 * qg + r32) * 1024 + h * 256 + c * 128 + hi * 16;
#pragma unroll
          for (int ds = 0; ds < 4; ++ds) qf[ds] = *(const bf16x8*)(Qp + 32 * ds); }
        const int qpos = q0 + 32 * qg + r32, qw0 = q0 + 32 * qg;
        f32x16 O[4];
#pragma unroll
        for (int e = 0; e < 4; ++e)
#pragma unroll
            for (int r = 0; r < 16; ++r) O[e][r] = 0.f;
        float l = 0.f;
        u32x4 kreg[2], vreg[2];
        const int srow = tid >> 4, sch = tid & 15;
#define A_LOAD(t) do { _Pragma("unroll") for (int i = 0; i < 2; ++i) { const size_t g = (tokbase + 64 * (t) + srow + 32 * i) * 1024 + h * 256 + sch * 16; \
        kreg[i] = *(const u32x4*)(AK + g); vreg[i] = *(const u32x4*)(AV + g); } } while (0)
#define A_WRITE(st) do { _Pragma("unroll") for (int i = 0; i < 2; ++i) { *(LAS u32x4*)(lds + (st) * A_STG + (srow + 32 * i) * A_KROW + sch * 16) = kreg[i]; \
        *(LAS u32x4*)(lds + (st) * A_STG + A_KBUF + (srow + 32 * i) * A_VROW + sch * 16) = vreg[i]; } } while (0)
        A_LOAD(0); A_WRITE(0);
        __syncthreads();
        for (int t = 0; t < NT; ++t) {
            if (t + 1 < NT) A_LOAD(t + 1);
            const int k0 = 64 * t;
            if (k0 <= qw0 + 31) {
                const bool near = (k0 + 63 + 113 > qw0);
                const LAS unsigned char* Kb = lds + (t & 1) * A_STG; const LAS unsigned char* Vb = Kb + A_KBUF;
                f32x16 s0, s1;
#pragma unroll
                for (int r = 0; r < 16; ++r) { s0[r] = 0.f; s1[r] = 0.f; }
                {
                    const LAS unsigned char* kp0 = Kb + (pi32(r32)) * A_KROW + c * 128 + hi * 16;
                    const LAS unsigned char* kp1 = kp0 + 32 * A_KROW;
#pragma unroll
                    for (int ds = 0; ds < 4; ++ds) { const bf16x8 ka = *(const LAS bf16x8*)(kp0 + 32 * ds), kb = *(const LAS bf16x8*)(kp1 + 32 * ds);
                        s0 = __builtin_amdgcn_mfma_f32_32x32x16_bf16(ka, qf[ds], s0, 0, 0, 0); s1 = __builtin_amdgcn_mfma_f32_32x32x16_bf16(kb, qf[ds], s1, 0, 0, 0); }
                }
                __builtin_amdgcn_sched_barrier(0);
                float sacc = 0.f;
#define A_SOFTMAX(S, HF) do { \
                    if (!near) { _Pragma("unroll") for (int r = 0; r < 16; ++r) S[r] = __builtin_amdgcn_exp2f(S[r]); } \
                    else { int ib = 223 - (qpos - k0 - 8 * hi - 32 * (HF)); asm volatile("" : "+v"(ib)); const LAS float* tp = T + ib; \
                        _Pragma("unroll") for (int r = 0; r < 16; ++r) S[r] = __builtin_amdgcn_exp2f(S[r] + tp[16 * (r >> 3) + (r & 7)]); } \
                    _Pragma("unroll") for (int r = 0; r < 16; ++r) sacc += S[r]; } while (0)
#define A_PV(S, HF) do { \
                    _Pragma("unroll") for (int jj = 0; jj < 2; ++jj) { \
                        const int j = 2 * (HF) + jj, rb = 8 * jj; \
                        u32x4 pw; pw.x = cvt_pk_bf16(S[rb], S[rb + 1]); pw.y = cvt_pk_bf16(S[rb + 2], S[rb + 3]); pw.z = cvt_pk_bf16(S[rb + 4], S[rb + 5]); pw.w = cvt_pk_bf16(S[rb + 6], S[rb + 7]); \
                        const bf16x8 pa = __builtin_bit_cast(bf16x8, pw); \
                        const LAS unsigned char* vp = Vb + (16 * j + 8 * hi + ((lane & 15) >> 2)) * A_VROW + (16 * ((lane >> 4) & 1) + 4 * (lane & 3)) * 2; \
                        _Pragma("unroll") for (int eb = 0; eb < 4; ++eb) { \
                            const s16x4 lo = vtr(vp + eb * 64), hh = vtr(vp + 4 * A_VROW + eb * 64); \
                            const bf16x8 vf = (bf16x8){lo[0], lo[1], lo[2], lo[3], hh[0], hh[1], hh[2], hh[3]}; \
                            O[eb] = __builtin_amdgcn_mfma_f32_32x32x16_bf16(pa, vf, O[eb], 0, 0, 0); } } } while (0)
                A_SOFTMAX(s0, 0);
                __builtin_amdgcn_sched_barrier(0);
                A_PV(s0, 0);
                A_SOFTMAX(s1, 1);
                __builtin_amdgcn_sched_barrier(0);
                A_PV(s1, 1);
#undef A_SOFTMAX
#undef A_PV
                l += sacc;
            }
            if (t + 1 < NT) A_WRITE((t + 1) & 1);
            __syncthreads();
        }
#undef A_LOAD
#undef A_WRITE
        l += __shfl_xor(l, 32);
        if (hi == 0) linv[r32] = (c == 1 ? lam : 1.f) / l;
        LAS float* comb = (LAS float*)lds + qg * (32 * 128);
        float f[16];
#pragma unroll
        for (int r = 0; r < 16; ++r) f[r] = linv[crow(r, hi)];
#pragma unroll
        for (int eb = 0; eb < 4; ++eb)
#pragma unroll
            for (int r = 0; r < 16; ++r) O[eb][r] *= f[r];
        if (c == 1) {
#pragma unroll
            for (int eb = 0; eb < 4; ++eb)
#pragma unroll
                for (int r = 0; r < 16; ++r) comb[crow(r, hi) * 128 + 32 * eb + r32] = O[eb][r];
        }
        __syncthreads();
        if (c == 0) {
            float gl[4];
#pragma unroll
            for (int eb = 0; eb < 4; ++eb) gl[eb] = p.subln[32 * eb + r32] * 0.8f;
#pragma unroll
            for (int r = 0; r < 16; ++r) {
                const int qr = crow(r, hi); float ss = 0.f;
#pragma unroll
                for (int eb = 0; eb < 4; ++eb) { O[eb][r] -= comb[qr * 128 + 32 * eb + r32]; ss += O[eb][r] * O[eb][r]; }
                ss += __shfl_xor(ss, 1); ss += __shfl_xor(ss, 2); ss += __shfl_xor(ss, 4); ss += __shfl_xor(ss, 8); ss += __shfl_xor(ss, 16);
                const float rs = 1.0f / sqrtf(ss * (1.f / 128.f) + EPS);
                bf16_t* op = CAT + (tokbase + q0 + 32 * qg + qr) * 1024 + h * 128 + r32;
#pragma unroll
                for (int eb = 0; eb < 4; ++eb) op[32 * eb] = (bf16_t)(cvt_pk_bf16(O[eb][r] * rs * gl[eb], 0.f) & 0xffffu);
            }
        }
        __syncthreads();
    }
}

#ifndef SKIP
#define SKIP 0
#endif
constexpr int B_QROW = 1040;
constexpr int B_HIST = 66560, B_HROW = 257;
constexpr int B_TOFF = B_HIST + 64 * B_HROW * 4;
constexpr int B_DT = 75776;
constexpr int B_INFO = B_TOFF + 4096;
constexpr int B_LINV = B_INFO + 1024;
constexpr int B_MASK = 98304, B_MROW = 130;
__device__ __forceinline__ unsigned ord_key(float f) { const unsigned u = __float_as_uint(f); return u ^ ((u >> 31) ? 0xffffffffu : 0x80000000u); }
__device__ __forceinline__ void phaseB(const Params& p, LAS unsigned char* lds, int wv) {
    const _Float16* IQ = (const _Float16*)(p.ws + WS_IQ); const _Float16* IK = (const _Float16*)(p.ws + WS_IK); const float* IW = (const float*)(p.ws + WS_IW);
    const unsigned char* BQ = p.ws + WS_BQ; const unsigned char* BK = p.ws + WS_BK; const unsigned char* BV = p.ws + WS_BV;
    bf16_t* CAT = (bf16_t*)(p.ws + WS_CAT);
    float* SC = (float*)(p.ws + WS_SC + (size_t)blockIdx.x * MiB);
    LAS float* Tb = (LAS float*)(lds + B_DT);
    LAS unsigned* hist = (LAS unsigned*)(lds + B_HIST);
    LAS unsigned* pfx = (LAS unsigned*)(lds + B_INFO); LAS int* needv = (LAS int*)(lds + B_INFO + 256); LAS unsigned* ceqv = (LAS unsigned*)(lds + B_INFO + 512); LAS int* cutv = (LAS int*)(lds + B_INFO + 768);
    const int vblkB = (gridDim.x == 256) ? (int)((blockIdx.x & 7) * 32 + (blockIdx.x >> 3)) : (int)blockIdx.x;
    for (int ui = vblkB; ui < 1024 * REPB; ui += gridDim.x) {
        const int v = ui & 255, rnd = (ui >> 8) & 3, b = v >> 4, pp = (v & 15) + 16 * (rnd >> 1), qb = (rnd & 1) ? 63 - pp : pp;
        const int q0 = 64 * qb, NT = qb + 1;
        const size_t tokbase = (size_t)b * SEQ;
        {
        const int tid = otid(wv);
        const int lane = tid & 63, wid = __builtin_amdgcn_readfirstlane(tid >> 6), r32 = lane & 31, hi = lane >> 5; (void)r32; (void)hi; (void)wid;
#pragma unroll
        for (int i = 0; i < 8; ++i) { const int id = tid + 512 * i, row = id >> 6, ch = id & 63;
            *(LAS u32x4*)(lds + row * B_QROW + ch * 16) = *(const u32x4*)((const unsigned char*)IQ + (tokbase + q0 + row) * 1024 + ch * 16); }
        for (int i = tid; i < 64 * B_HROW; i += 512) hist[i] = 0u;
        if (tid < 128) *(LAS f32x4*)(lds + B_TOFF + tid * 16) = *(const f32x4*)(IW + (tokbase + q0) * 8 + tid * 4);
        if (tid < 64) { const int n = q0 + tid + 1; pfx[tid] = 0u; needv[tid] = (n > 256) ? 256 : -1; ceqv[tid] = 0u; cutv[tid] = 4096; }
        __syncthreads();
#if !(SKIP & 1)
        {
            const int qg = wid & 1, ks = wid >> 1;
            const LAS float* wp = (const LAS float*)(lds + B_TOFF) + (32 * qg + r32) * 8;
            const LAS unsigned char* qp = lds + (32 * qg + r32) * B_QROW + hi * 16;
            LAS unsigned* hrow = hist + (32 * qg + r32) * B_HROW;
            const int tq = q0 + 32 * qg + r32;
#pragma unroll 1
            for (int rep1 = 0; rep1 < REPK; ++rep1)
#pragma unroll 1
            for (int kt = ks; kt < NT; kt += 4) {
                const int k0 = 64 * kt;
                f16x8 kf[2][4];
#pragma unroll
                for (int hf = 0; hf < 2; ++hf)
#pragma unroll
                    for (int ds = 0; ds < 4; ++ds) kf[hf][ds] = *(const f16x8*)(IK + (tokbase + k0 + 32 * hf + pi32(r32)) * 64 + 16 * ds + 8 * hi);
                f32x16 acc0, acc1;
#pragma unroll
                for (int r = 0; r < 16; ++r) { acc0[r] = 0.f; acc1[r] = 0.f; }
#pragma unroll 2
                for (int hh = 0; hh < 8; ++hh) {
                    const float wh = wp[hh];
                    f32x16 s0, s1;
#pragma unroll
                    for (int r = 0; r < 16; ++r) { s0[r] = 0.f; s1[r] = 0.f; }
#pragma unroll
                    for (int ds = 0; ds < 4; ++ds) { const f16x8 qfr = *(const LAS f16x8*)(qp + hh * 128 + ds * 32);
                        s0 = __builtin_amdgcn_mfma_f32_32x32x16_f16(kf[0][ds], qfr, s0, 0, 0, 0); s1 = __builtin_amdgcn_mfma_f32_32x32x16_f16(kf[1][ds], qfr, s1, 0, 0, 0); }
#pragma unroll
                    for (int r = 0; r < 16; ++r) { acc0[r] += wh * fmaxf(s0[r], 0.f); acc1[r] += wh * fmaxf(s1[r], 0.f); }
                }
                float* sp = SC + (size_t)(32 * qg + r32) * SEQ + k0 + 8 * hi;
                *(f32x4*)(sp) = (f32x4){acc0[0], acc0[1], acc0[2], acc0[3]}; *(f32x4*)(sp + 4) = (f32x4){acc0[4], acc0[5], acc0[6], acc0[7]};
                *(f32x4*)(sp + 16) = (f32x4){acc0[8], acc0[9], acc0[10], acc0[11]}; *(f32x4*)(sp + 20) = (f32x4){acc0[12], acc0[13], acc0[14], acc0[15]};
                *(f32x4*)(sp + 32) = (f32x4){acc1[0], acc1[1], acc1[2], acc1[3]}; *(f32x4*)(sp + 36) = (f32x4){acc1[4], acc1[5], acc1[6], acc1[7]};
                *(f32x4*)(sp + 48) = (f32x4){acc1[8], acc1[9], acc1[10], acc1[11]}; *(f32x4*)(sp + 52) = (f32x4){acc1[12], acc1[13], acc1[14], acc1[15]};
                if (q0 + 63 > 255 && rep1 == 0) {
                    int e0 = k0 + 8 * hi; asm volatile("" : "+v"(e0));
#pragma unroll
                    for (int r = 0; r < 16; ++r) { const int kp0 = e0 + 16 * (r >> 3) + (r & 7);
                        if (kp0 <= tq) atomicAdd((unsigned*)&hrow[ord_key(acc0[r]) >> 24], 1u);
                        if (kp0 + 32 <= tq) atomicAdd((unsigned*)&hrow[ord_key(acc1[r]) >> 24], 1u); }
                }
            }
        }
#endif
        }
        __builtin_amdgcn_fence(__ATOMIC_RELEASE, "workgroup");
        __syncthreads();
        __builtin_amdgcn_fence(__ATOMIC_ACQUIRE, "workgroup");
        {
        const int tid = otid(wv);
        const int lane = tid & 63, wid = __builtin_amdgcn_readfirstlane(tid >> 6);
#pragma unroll 1
        for (int rr = 0; rr < 8; ++rr) {
            const int row = wid * 8 + rr; const int need = needv[row];
            if (need > 0) {
                const LAS unsigned* hr = hist + row * B_HROW + 4 * lane;
                const unsigned c0 = hr[0], c1 = hr[1], c2 = hr[2], c3 = hr[3];
                const unsigned sl = c0 + c1 + c2 + c3; unsigned suf = sl;
#pragma unroll
                for (int o = 1; o < 64; o <<= 1) { const unsigned tv = __shfl_down(suf, o); if (lane + o < 64) suf += tv; }
                unsigned cum = suf - sl; int fbin = -1; unsigned fabove = 0u, fcnt = 0u;
                { if ((int)cum < need && (int)(cum + c3) >= need) { fbin = 4 * lane + 3; fabove = cum; fcnt = c3; } cum += c3;
                  if ((int)cum < need && (int)(cum + c2) >= need) { fbin = 4 * lane + 2; fabove = cum; fcnt = c2; } cum += c2;
                  if ((int)cum < need && (int)(cum + c1) >= need) { fbin = 4 * lane + 1; fabove = cum; fcnt = c1; } cum += c1;
                  if ((int)cum < need && (int)(cum + c0) >= need) { fbin = 4 * lane + 0; fabove = cum; fcnt = c0; } }
                if (fbin >= 0) { pfx[row] = (unsigned)fbin << 24; needv[row] = need - (int)fabove; ceqv[row] = fcnt; }
            }
        }
        }
        __syncthreads();
        {
            const int tid = otid(wv);
            for (int i = tid; i < 2560; i += 512) { const int hh = i / 320, d = 223 - (i - 320 * hh);
                Tb[i] = d < 0 ? -1e30f : (p.rel_bias[t5_bucket(min(d, 127)) * 12 + 4 + hh] - p.rel_bias[31 * 12 + 4 + hh]) * LOG2E; }
        }
        {
        const int tid = otid(wv);
        const int lane = tid & 63, wid = __builtin_amdgcn_readfirstlane(tid >> 6);
        LAS unsigned* wh = (LAS unsigned*)lds + wid * 320;
        const int nwords = 2 * NT;
        u32x4 bufA[16], bufB[16];
#define ROW_LOAD(buf, rowi) do { const float* sr_ = SC + (size_t)(rowi) * SEQ + 4 * lane; _Pragma("unroll") for (int i = 0; i < 16; ++i) { buf[i] = (u32x4){0u, 0u, 0u, 0u}; if (256 * i <= q0 + 63) buf[i] = *(const u32x4*)(sr_ + 256 * i); } } while (0)
#define OKEY(u) ((u) ^ (((u) >> 31) ? 0xffffffffu : 0x80000000u))
#define ROW_PROC(key, rowi) do { \
            const int row = (rowi), tr = q0 + row; \
            unsigned thr = 0u; int cut = -1; \
            int need = needv[row]; \
            _Pragma("unroll") for (int i = 0; i < 16; ++i) { const int e = 256 * i + 4 * lane; \
                key[i].x = (e <= tr) ? OKEY(key[i].x) : 0u; key[i].y = (e + 1 <= tr) ? OKEY(key[i].y) : 0u; key[i].z = (e + 2 <= tr) ? OKEY(key[i].z) : 0u; key[i].w = (e + 3 <= tr) ? OKEY(key[i].w) : 0u; } \
            if (need > 0) { \
                unsigned prefix = pfx[row]; unsigned cnt = ceqv[row]; bool done = false; \
                if (need == (int)cnt) { thr = prefix - 1u; done = true; } \
                _Pragma("unroll 1") for (int pass = 1; pass < 4 && !done; ++pass) { \
                    const int shift = 24 - 8 * pass; const unsigned msk = 0xffffffffu << (shift + 8); \
                    wh[lane] = 0u; wh[64 + lane] = 0u; wh[128 + lane] = 0u; wh[192 + lane] = 0u; \
                    _Pragma("unroll") for (int i = 0; i < 16; ++i) { \
                        { const unsigned k = key[i].x; atomicAdd((unsigned*)&wh[((k & msk) == prefix) ? ((k >> shift) & 255u) : (256u + lane)], 1u); } \
                        { const unsigned k = key[i].y; atomicAdd((unsigned*)&wh[((k & msk) == prefix) ? ((k >> shift) & 255u) : (256u + lane)], 1u); } \
                        { const unsigned k = key[i].z; atomicAdd((unsigned*)&wh[((k & msk) == prefix) ? ((k >> shift) & 255u) : (256u + lane)], 1u); } \
                        { const unsigned k = key[i].w; atomicAdd((unsigned*)&wh[((k & msk) == prefix) ? ((k >> shift) & 255u) : (256u + lane)], 1u); } } \
                    const unsigned c0 = wh[4 * lane], c1 = wh[4 * lane + 1], c2 = wh[4 * lane + 2], c3 = wh[4 * lane + 3]; \
                    const unsigned sl = c0 + c1 + c2 + c3; unsigned suf = sl; \
                    _Pragma("unroll") for (int o = 1; o < 64; o <<= 1) { const unsigned tv = __shfl_down(suf, o); if (lane + o < 64) suf += tv; } \
                    unsigned cum = suf - sl; int fbin = -1; unsigned fabove = 0u, fcnt = 0u; \
                    { if ((int)cum < need && (int)(cum + c3) >= need) { fbin = 4 * lane + 3; fabove = cum; fcnt = c3; } cum += c3; \
                      if ((int)cum < need && (int)(cum + c2) >= need) { fbin = 4 * lane + 2; fabove = cum; fcnt = c2; } cum += c2; \
                      if ((int)cum < need && (int)(cum + c1) >= need) { fbin = 4 * lane + 1; fabove = cum; fcnt = c1; } cum += c1; \
                      if ((int)cum < need && (int)(cum + c0) >= need) { fbin = 4 * lane + 0; fabove = cum; fcnt = c0; } } \
                    const unsigned long long bm = __ballot(fbin >= 0); const int src = __ffsll((long long)bm) - 1; \
                    const int bin = __shfl(fbin, src); const unsigned above = __shfl(fabove, src); cnt = __shfl(fcnt, src); \
                    prefix |= (unsigned)bin << shift; need -= (int)above; \
                    if (pass < 3 && need == (int)cnt) { thr = prefix - 1u; done = true; } \
                } \
                if (!done) { thr = prefix; cut = 4096; \
                    if (need < (int)cnt) {        \
                        const float* srow = SC + (size_t)row * SEQ; int tbase = 0; \
                        for (int j = 0; j * 64 <= tr; ++j) { const int e = 64 * j + lane; const bool eq = (e <= tr) && (ord_key(srow[e]) == thr); \
                            const unsigned long long be = __ballot(eq); \
                            const int tpos = tbase + (int)__builtin_amdgcn_mbcnt_hi((unsigned)(be >> 32), __builtin_amdgcn_mbcnt_lo((unsigned)be, 0u)); \
                            const unsigned long long bh = __ballot(eq && tpos == need - 1); \
                            if (bh) { cut = 64 * j + (__ffsll((long long)bh) - 1); break; } \
                            tbase += __popcll(be); } \
                    } \
                } \
            } \
            LAS unsigned* mw = (LAS unsigned*)(lds + B_MASK) + row * B_MROW; \
            _Pragma("unroll") for (int i = 0; i < 16; ++i) if (256 * i <= q0 + 63) { const int e = 256 * i + 4 * lane; \
                unsigned nib = 0u; \
                nib |= (key[i].x > thr || (key[i].x == thr && e <= cut)) ? 1u : 0u; nib |= (key[i].y > thr || (key[i].y == thr && e + 1 <= cut)) ? 2u : 0u; \
                nib |= (key[i].z > thr || (key[i].z == thr && e + 2 <= cut)) ? 4u : 0u; nib |= (key[i].w > thr || (key[i].w == thr && e + 3 <= cut)) ? 8u : 0u; \
                unsigned v = nib << (4 * (lane & 7)); v |= __shfl_xor(v, 1); v |= __shfl_xor(v, 2); v |= __shfl_xor(v, 4); \
                const int w = 8 * i + (lane >> 3); if ((lane & 7) == 0 && w < nwords) mw[w] = v; } \
        } while (0)
        ROW_LOAD(bufA, wid * 8);
#pragma unroll 1
        for (int rr = 0; rr < 8; rr += 2) {
            ROW_LOAD(bufB, wid * 8 + rr + 1);
            ROW_PROC(bufA, wid * 8 + rr);
            if (rr + 2 < 8) ROW_LOAD(bufA, wid * 8 + rr + 2);
            ROW_PROC(bufB, wid * 8 + rr + 1);
        }
#undef ROW_LOAD
#undef ROW_PROC
#undef OKEY
        }
        __syncthreads();
#pragma unroll 1
        for (int rep3 = 0; rep3 < ((SKIP & 8) ? 0 : REPT); ++rep3) {
        const int tid = otid(wv);
        const int lane = tid & 63, wid = __builtin_amdgcn_readfirstlane(tid >> 6), r32 = lane & 31, hi = lane >> 5; (void)r32; (void)hi; (void)wid;
            LAS float* linv = (LAS float*)(lds + B_LINV) + wid * 64;
            const int qg = wid & 1, hp = wid >> 1, g = hp >> 1;
            const int qpos = q0 + 32 * qg + r32, qw0 = q0 + 32 * qg;
            const unsigned char* Qp0 = BQ + (tokbase + qpos) * 1024 + (2 * hp) * 128 + hi * 16;
            const LAS unsigned* mrow = (const LAS unsigned*)(lds + B_MASK) + (32 * qg + r32) * B_MROW;
            bf16x8 qf2[2][4];
#pragma unroll
            for (int hh = 0; hh < 2; ++hh)
#pragma unroll
                for (int ds = 0; ds < 4; ++ds) qf2[hh][ds] = *(const bf16x8*)(Qp0 + hh * 128 + 32 * ds);
            f32x16 O[2][2];
#pragma unroll
            for (int hh = 0; hh < 2; ++hh)
#pragma unroll
                for (int db = 0; db < 2; ++db)
#pragma unroll
                    for (int r = 0; r < 16; ++r) O[hh][db][r] = 0.f;
            float l0 = 0.f, l1 = 0.f;
            u32x4 kreg[2], vreg[2];
            const int srow_ = tid >> 4, sch = tid & 15;
#define B_LOAD(t) do { _Pragma("unroll") for (int i = 0; i < 2; ++i) { const size_t gofs = (tokbase + 64 * (t) + srow_ + 32 * i) * 256 + sch * 16; \
            kreg[i] = *(const u32x4*)(BK + gofs); vreg[i] = *(const u32x4*)(BV + gofs); } } while (0)
#define B_WRITE(st) do { _Pragma("unroll") for (int i = 0; i < 2; ++i) { *(LAS u32x4*)(lds + (st) * A_STG + (srow_ + 32 * i) * A_KROW + sch * 16) = kreg[i]; \
            *(LAS u32x4*)(lds + (st) * A_STG + A_KBUF + (srow_ + 32 * i) * A_VROW + sch * 16) = vreg[i]; } } while (0)
            B_LOAD(0); B_WRITE(0);
            __syncthreads();
#pragma unroll 1
            for (int t = 0; t < NT; ++t) {
                if (t + 1 < NT) B_LOAD(t + 1);
                const int k0 = 64 * t;
                const bool near = (k0 + 63 + 113 > qw0);
                const LAS unsigned char* Kb = lds + (t & 1) * A_STG; const LAS unsigned char* Vb = Kb + A_KBUF;
                unsigned selm;
                { const unsigned w0 = mrow[2 * t] >> (8 * hi), w1 = mrow[2 * t + 1] >> (8 * hi);
                  selm = (w0 & 0xffu) | ((w0 >> 8) & 0xff00u) | ((w1 & 0xffu) << 16) | ((w1 << 8) & 0xff000000u); }
                float sacc0 = 0.f, sacc1 = 0.f;
#pragma unroll
                for (int hf = 0; hf < 2; ++hf) {
                    f32x16 s0, s1;
#pragma unroll
                    for (int r = 0; r < 16; ++r) { const float cm = ((selm >> (16 * hf + r)) & 1u) ? 0.f : -1e30f; s0[r] = cm; s1[r] = cm; }
                    const LAS unsigned char* kp = Kb + (32 * hf + pi32(r32)) * A_KROW + g * 128 + hi * 16;
#pragma unroll
                    for (int ds = 0; ds < 4; ++ds) { const bf16x8 kf = *(const LAS bf16x8*)(kp + 32 * ds);
                        s0 = __builtin_amdgcn_mfma_f32_32x32x16_bf16(kf, qf2[0][ds], s0, 0, 0, 0); s1 = __builtin_amdgcn_mfma_f32_32x32x16_bf16(kf, qf2[1][ds], s1, 0, 0, 0); }
                    if (!near) {
#pragma unroll
                        for (int r = 0; r < 16; ++r) { s0[r] = __builtin_amdgcn_exp2f(s0[r]); s1[r] = __builtin_amdgcn_exp2f(s1[r]); }
                    } else {
                        int ib = 223 - (qpos - k0 - 8 * hi - 32 * hf); asm volatile("" : "+v"(ib));
                        const LAS float* tp0 = Tb + (2 * hp) * 320 + ib; const LAS float* tp1 = tp0 + 320;
#pragma unroll
                        for (int r = 0; r < 16; ++r) { s0[r] = __builtin_amdgcn_exp2f(s0[r] + tp0[16 * (r >> 3) + (r & 7)]); s1[r] = __builtin_amdgcn_exp2f(s1[r] + tp1[16 * (r >> 3) + (r & 7)]); }
                    }
#pragma unroll
                    for (int r = 0; r < 16; ++r) { sacc0 += s0[r]; sacc1 += s1[r]; }
#pragma unroll
                    for (int jj = 0; jj < 2; ++jj) {
                        const int j = 2 * hf + jj, rb = 8 * jj;
                        u32x4 pw0, pw1;
                        pw0.x = cvt_pk_bf16(s0[rb], s0[rb + 1]); pw0.y = cvt_pk_bf16(s0[rb + 2], s0[rb + 3]); pw0.z = cvt_pk_bf16(s0[rb + 4], s0[rb + 5]); pw0.w = cvt_pk_bf16(s0[rb + 6], s0[rb + 7]);
                        pw1.x = cvt_pk_bf16(s1[rb], s1[rb + 1]); pw1.y = cvt_pk_bf16(s1[rb + 2], s1[rb + 3]); pw1.z = cvt_pk_bf16(s1[rb + 4], s1[rb + 5]); pw1.w = cvt_pk_bf16(s1[rb + 6], s1[rb + 7]);
                        const bf16x8 pa0 = __builtin_bit_cast(bf16x8, pw0), pa1 = __builtin_bit_cast(bf16x8, pw1);
                        const LAS unsigned char* vp = Vb + (16 * j + 8 * hi + ((lane & 15) >> 2)) * A_VROW + (g * 64 + 16 * ((lane >> 4) & 1) + 4 * (lane & 3)) * 2;
#pragma unroll
                        for (int db = 0; db < 2; ++db) {
                            const s16x4 lo = vtr(vp + db * 64), hv = vtr(vp + 4 * A_VROW + db * 64);
                            const bf16x8 vf = (bf16x8){lo[0], lo[1], lo[2], lo[3], hv[0], hv[1], hv[2], hv[3]};
                            O[0][db] = __builtin_amdgcn_mfma_f32_32x32x16_bf16(pa0, vf, O[0][db], 0, 0, 0);
                            O[1][db] = __builtin_amdgcn_mfma_f32_32x32x16_bf16(pa1, vf, O[1][db], 0, 0, 0);
                        }
                    }
                    __builtin_amdgcn_sched_barrier(0);
                }
                l0 += sacc0; l1 += sacc1;
                if (t + 1 < NT) B_WRITE((t + 1) & 1);
                __syncthreads();
            }
#undef B_LOAD
#undef B_WRITE
            l0 += __shfl_xor(l0, 32); l1 += __shfl_xor(l1, 32);
            if (hi == 0) { linv[r32] = 1.0f / l0; linv[32 + r32] = 1.0f / l1; }
#pragma unroll
            for (int hh = 0; hh < 2; ++hh)
#pragma unroll
                for (int r = 0; r < 16; ++r) { const int qr = crow(r, hi); const float f = linv[32 * hh + qr];
                    bf16_t* op = CAT + (tokbase + q0 + 32 * qg + qr) * 1024 + 512 + (2 * hp + hh) * 64 + r32;
#pragma unroll
                    for (int db = 0; db < 2; ++db) op[32 * db] = (bf16_t)(cvt_pk_bf16(O[hh][db][r] * f, 0.f) & 0xffffu); }
            if (REPT > 1) __syncthreads();
        }
        __syncthreads();
    }
}
#ifndef REPG1
#define REPG1 1
#endif
#ifndef REPG2
#define REPG2 1
#endif
#ifndef REPG3
#define REPG3 1
#endif
#ifndef PH
#define PH 255
#endif

#define XB_TMO      128
#define XB_XCNT(j)  (256  + 64 * (j))
#define XB_XSUB(j)  (1280 + 64 * (j))
#define XB_XGEN(j)  (2304 + 64 * (j))
#define XB_TOP      3328
#define XB_TOPGEN   3392
#define XCD_BAR_WORDS 3456
#define XB_SPIN_CAP (1u << 18)

__device__ __forceinline__ unsigned xb_ld(unsigned* p)              { return __hip_atomic_load(p, __ATOMIC_RELAXED, __HIP_MEMORY_SCOPE_AGENT); }
__device__ __forceinline__ unsigned xb_add(unsigned* p, unsigned v) { return __hip_atomic_fetch_add(p, v, __ATOMIC_RELAXED, __HIP_MEMORY_SCOPE_AGENT); }
__device__ __forceinline__ unsigned xb_xcc_id() { return (unsigned)__builtin_amdgcn_s_getreg((3 << 11) | 20) & 0xFu; }
#define XB_SPIN(cond, bar) do { unsigned _sp = 0; while (cond) { __builtin_amdgcn_s_sleep(1); \
    if ((++_sp & 255u) == 0u) { if (xb_ld(&(bar)[XB_TMO])) break; if (_sp > XB_SPIN_CAP) { atomicAdd(&(bar)[XB_TMO], 1u); break; } } } } while (0)

struct XcdBarrier {
    unsigned* bar; unsigned x;
    volatile LAS unsigned* st;
};

__device__ __forceinline__ XcdBarrier xcd_barrier_post(unsigned* bar, volatile LAS unsigned* st) {
    XcdBarrier b; b.bar = bar; b.x = xb_xcc_id(); b.st = st;
    if (threadIdx.x == 0) (void)xb_add(&bar[XB_XCNT(b.x)], 1u);
    return b;
}
__device__ __forceinline__ void xcd_barrier_complete(unsigned* bar, unsigned x, unsigned& nloc, unsigned& nx) {
    const unsigned G = gridDim.x * gridDim.y * gridDim.z;
    unsigned sum, cnt, mine, sp = 0u;
    for (;;) {
        sum = 0u; cnt = 0u; mine = 0u;
#pragma unroll
        for (unsigned j = 0; j < 16; ++j) { const unsigned c = xb_ld(&bar[XB_XCNT(j)]); sum += c; cnt += (c > 0u) ? 1u : 0u; mine = (j == x) ? c : mine; }
        if (sum == G) break;
        __builtin_amdgcn_s_sleep(1);
        if ((++sp & 255u) == 0u) { if (xb_ld(&bar[XB_TMO])) break; if (sp > XB_SPIN_CAP) { atomicAdd(&bar[XB_TMO], 1u); break; } }
    }
    nloc = mine > 0u ? mine : 1u; nx = cnt > 0u ? cnt : 1u;
}

__device__ __forceinline__ void xcd_barrier(const XcdBarrier& b) {
    asm volatile("s_waitcnt vmcnt(0)" ::: "memory");
    __syncthreads();
    if (threadIdx.x == 0) {
        unsigned* bar = b.bar;
        __builtin_amdgcn_s_waitcnt(0);
        unsigned nloc = b.st[0], nx = b.st[1];
        if (nloc == 0u) { xcd_barrier_complete(bar, b.x, nloc, nx); b.st[0] = nloc; b.st[1] = nx; }
        const unsigned old = xb_add(&bar[XB_XSUB(b.x)], 1u);
        const unsigned gen = old / nloc;
        if (old + 1u == (gen + 1u) * nloc) {
            __builtin_amdgcn_fence(__ATOMIC_RELEASE, "agent");
            asm volatile("s_waitcnt vmcnt(0)" ::: "memory");
            const unsigned og = xb_add(&bar[XB_TOP], 1u);
            const unsigned tg = og / nx;
            if (og + 1u == (tg + 1u) * nx) xb_add(&bar[XB_TOPGEN], 1u);
            else XB_SPIN(xb_ld(&bar[XB_TOPGEN]) == tg, bar);
            __builtin_amdgcn_fence(__ATOMIC_ACQUIRE, "agent");
            xb_add(&bar[XB_XGEN(b.x)], 1u);
            asm volatile("s_waitcnt vmcnt(0)" ::: "memory");
        } else {
            XB_SPIN(xb_ld(&bar[XB_XGEN(b.x)]) == gen, bar);
            __builtin_amdgcn_fence(__ATOMIC_ACQUIRE, "agent");
            asm volatile("s_waitcnt vmcnt(0)" ::: "memory");
        }
    }
    __syncthreads();
}

constexpr size_t WS_BAR = 786432;
constexpr int XB_LDS_OFF = LDS_BYTES - 16;
typedef const __attribute__((address_space(4))) Params* KParamsPtr;
__device__ __forceinline__ Params load_params(KParamsPtr q) {
    Params r; r.x = q->x; r.c = q->c; r.w_ada = q->w_ada; r.b_ada = q->b_ada; r.g_attn = q->g_attn; r.w_in = q->w_in; r.qna = q->qna; r.kna = q->kna; r.qnb = q->qnb; r.knb = q->knb;
    r.lam = q->lam; r.subln = q->subln; r.w_out = q->w_out; r.g_ffn = q->g_ffn; r.w_up = q->w_up; r.conv_w = q->conv_w; r.conv_b = q->conv_b; r.w_down = q->w_down; r.rel_bias = q->rel_bias;
    r.out = q->out; r.ws = q->ws; return r;
}
#define FRESH_PARAMS() KParamsPtr pp_ = (KParamsPtr)__builtin_amdgcn_kernarg_segment_ptr(); asm volatile("" : "+s"(pp_)); const Params p = load_params(pp_); \
    float* mod = (float*)(p.ws + WS_MOD); bf16_t* H = (bf16_t*)(p.ws + WS_H); const int G = (int)gridDim.x, cb = (int)blockIdx.x; (void)mod; (void)H; (void)G; (void)cb
__global__ void __launch_bounds__(512, 2) hybrid_block_fwd(Params p_unused) {
    extern __shared__ __attribute__((aligned(16))) unsigned char lds_raw[];
    LAS unsigned char* lds = (LAS unsigned char*)lds_raw;
    cg::grid_group grid = cg::this_grid();
    if (threadIdx.x < 4) ((LAS unsigned*)(lds + XB_LDS_OFF))[threadIdx.x] = 0u;
    __syncthreads();
    const int wv = __builtin_amdgcn_readfirstlane((int)threadIdx.x >> 6);
    { FRESH_PARAMS(); if (blockIdx.x == 0) { unsigned* bw = (unsigned*)(p.ws + WS_BAR); for (int i = threadIdx.x; i < XCD_BAR_WORDS; i += 512) bw[i] = 0u; }
      phase0(p, lds, wv); }
    grid.sync();
    XcdBarrier bar;
    { FRESH_PARAMS(); bar = xcd_barrier_post((unsigned*)(p.ws + WS_BAR), (volatile LAS unsigned*)(lds + XB_LDS_OFF)); }
    { FRESH_PARAMS(); norm_phase(p.x, p.g_attn, mod, 1024, 0, H, wv); }
    xcd_barrier(bar);
    {
        FRESH_PARAMS();
        pg8::Gemm g{H, (const bf16_t*)(p.ws + WS_WIN), MTOK, NPROJ, DM}; pg8::StaticOrder S; S.init(MTOK, NPROJ, G, cb);
        EpiProj E{p.ws, p.qna, p.kna, p.qnb, p.knb};
#pragma unroll 1
        for (int rep = 0; rep < REPG1; ++rep) pg8::gemm_phase<EpiProj, pg8::StaticOrder, true, true>(lds, g, S, E, wv);
    }
    xcd_barrier(bar);
    { FRESH_PARAMS(); attnA_phase(p, lds, wv); }
    __syncthreads();
    { FRESH_PARAMS(); phaseB(p, lds, wv); }
    xcd_barrier(bar);
    {
        FRESH_PARAMS();
        pg8::Gemm g{(const bf16_t*)(p.ws + WS_CAT), (const bf16_t*)(p.ws + WS_WOUT), MTOK, DM, DM}; pg8::StaticOrder S; S.init(MTOK, DM, G, cb);
        EpiOut E{p.x, mod + 2048, p.out};
#pragma unroll 1
        for (int rep = 0; rep < REPG2; ++rep) pg8::gemm_phase<EpiOut, pg8::StaticOrder, true, true>(lds, g, S, E, wv);
    }
    xcd_barrier(bar);
    { FRESH_PARAMS(); norm_phase(p.out, p.g_ffn, mod, 4096, 3072, H, wv); }
    xcd_barrier(bar);
    {
        FRESH_PARAMS();
        pg8::Gemm g{H - 2 * DM, (const bf16_t*)(p.ws + WS_WUP), 259 * 256, NUP, DM, 254}; pg8::StaticOrder S; S.init(259 * 256, NUP, G, cb);
        EpiUpConv E{(bf16_t*)(p.ws + WS_U), p.conv_w, p.conv_b, (LAS float*)(lds + HALO_OFF)};
#pragma unroll 1
        for (int rep = 0; rep < REPG3; ++rep) pg8::gemm_phase<EpiUpConv, pg8::StaticOrder, true, true>(lds, g, S, E, wv);
    }
    xcd_barrier(bar);
    {
        FRESH_PARAMS();
        pg8::Gemm g{(const bf16_t*)(p.ws + WS_U), (const bf16_t*)(p.ws + WS_WDN), MTOK, DM, DFF}; pg8::StaticOrder S; S.init(MTOK, DM, G, cb);
        EpiDown E{mod + 5120, p.out, 0};
        pg8::gemm_phase<EpiDown, pg8::StaticOrder, true, true>(lds, g, S, E, wv);
    }
}

extern "C" void kernel_launch(void* const* d_in, const int* in_sizes, int n_in, void* d_out, int out_size, void* d_ws, size_t ws_size, hipStream_t stream) {
    static int grid_blocks = 0;
    if (grid_blocks == 0) {
        if (n_in != 19 || ws_size < WS_END) { fprintf(stderr, "kernel_launch: unexpected n_in %d / ws %zu\n", n_in, ws_size); grid_blocks = -1; return; }
        int dev = 0, cus = 0, per_cu = 0;
        hipGetDevice(&dev);
        hipDeviceGetAttribute(&cus, hipDeviceAttributeMultiprocessorCount, dev);
        if (hipFuncSetAttribute((const void*)hybrid_block_fwd, hipFuncAttributeMaxDynamicSharedMemorySize, LDS_BYTES) != hipSuccess) { fprintf(stderr, "hipFuncSetAttribute failed\n"); }
        if (hipOccupancyMaxActiveBlocksPerMultiprocessor(&per_cu, (const void*)hybrid_block_fwd, 512, LDS_BYTES) != hipSuccess || per_cu < 1) { fprintf(stderr, "occupancy query: %d\n", per_cu); per_cu = 1; }
        (void)hipGetLastError();
        grid_blocks = cus * (per_cu > 1 ? 1 : per_cu);
        if (grid_blocks > 256) grid_blocks = 256;
    }
    if (grid_blocks < 0) return;
    Params p{};
    const float** f = (const float**)&p;
    for (int i = 0; i < 19; ++i) f[i] = (const float*)d_in[i];
    p.out = (float*)d_out; p.ws = (unsigned char*)d_ws;
    void* args[] = {&p};
    hipError_t e = hipLaunchCooperativeKernel((const void*)hybrid_block_fwd, dim3(grid_blocks), dim3(512), args, LDS_BYTES, stream);
    if (e != hipSuccess) fprintf(stderr, "cooperative launch failed: %s (grid %d)\n", hipGetErrorString(e), grid_blocks);
}
```

```cpp
#include <hip/hip_runtime.h>
#include <hip/hip_cooperative_groups.h>
#include <cstdio>
#include <cstdint>
#include <cmath>
namespace cg = cooperative_groups;

namespace pg8 {
#define PG8_LAS __attribute__((address_space(3)))
typedef unsigned short bf16_t;
typedef short bf16x8 __attribute__((ext_vector_type(8)));
typedef float f32x4 __attribute__((ext_vector_type(4)));
typedef unsigned u32x4 __attribute__((ext_vector_type(4)));
constexpr int BM = 256, BK = 64, HALF = 128, HTB = HALF * BK * 2  , STAGE_BYTES = 8 * HTB, NXCD = 8, WGM = 8;

__host__ __device__ __forceinline__ int lds_byte(int r, int c) { const int st = (r >> 4) * 2 + (c >> 5), rr = r & 15, cc = c & 31, ob = rr * 64 + cc * 2; return st * 1024 + (ob ^ (((ob >> 9) & 1) << 5)); }
__host__ __device__ __forceinline__ void stage_rc(int b, int& R, int& C) { const int st = b / 1024, sb = b % 1024, swz = sb ^ (((sb >> 9) & 1) << 5); R = (st >> 1) * 16 + swz / 64; C = (st & 1) * 32 + (swz % 64) / 2; }
__host__ __device__ __forceinline__ int perm32(int rho) { const int n = rho >> 4, i = rho & 15; return 8 * (i >> 2) + 4 * n + (i & 3); }

struct Unit { int pm, pn; };
struct Gemm { const bf16_t* A; const bf16_t* Bt; int M, N, K; int a_rows = 256; };

struct StaticOrder {
    int nM, nN, nwg, G, c;
    __host__ __device__ void init(int M, int N, int G_, int c_) { nM = M / BM; nN = N / BM; nwg = nM * nN; G = G_; c = c_; }
    __host__ __device__ bool next(int i, Unit& u) const {
        const long L = (long)i * G + c; if (L >= nwg) return false;
        int wgid = (int)L; { const int q = nwg / NXCD, r = nwg % NXCD, xcd = wgid % NXCD, off = wgid / NXCD; wgid = (xcd < r ? xcd * (q + 1) : r * (q + 1) + (xcd - r) * q) + off; }
        const int nig = WGM * nN, gid = wgid / nig, fm = gid * WGM, gsz = (nM - fm) < WGM ? (nM - fm) : WGM;
        u.pm = fm + ((wgid % nig) % gsz); u.pn = (wgid % nig) / gsz; return true;
    }
    __device__ __forceinline__ void a_ready(const Unit&) const {}
    __device__ __forceinline__ void done(const Unit&) const {}
};

__device__ __forceinline__ unsigned cvt_pk_bf16(float lo, float hi) { unsigned r; asm volatile("v_cvt_pk_bf16_f32 %0, %1, %2" : "=v"(r) : "v"(lo), "v"(hi)); return r; }
template <class Epi, class Sched, bool ALIGN_EPI = false, bool SP2 = false>
__device__ __forceinline__ void gemm_phase(PG8_LAS unsigned char* lds, const Gemm g, const Sched& S, const Epi& E, const int wv) {
    int tid_; asm volatile("v_mbcnt_lo_u32_b32 %0, -1, 0\n\tv_mbcnt_hi_u32_b32 %0, -1, %0" : "=v"(tid_)); tid_ += wv * 64;
    const int tid = tid_, wid = __builtin_amdgcn_readfirstlane(tid >> 6), lane = tid & 63, wr = wid >> 2, wc = wid & 3, fr = lane & 15, fq = lane >> 4;
    const int K = g.K, nt = K / BK;
    unsigned voffA[2], voffB[2];
#pragma unroll
    for (int i = 0; i < 2; ++i) { int R, C; stage_rc(tid * 16 + i * 8192, R, C); const int Rb = Epi::PERM ? ((R & ~31) + perm32(R & 31)) : R;
        voffA[i] = (unsigned)(R * K + C) * 2u; voffB[i] = (unsigned)(Rb * K + C) * 2u; }
    const size_t kstep = (size_t)(BK * 2);
    const size_t hstep = (size_t)HALF * K * 2;
    const size_t tstep = 2 * hstep; const size_t tstepA = (size_t)g.a_rows * K * 2;
    const unsigned ldsw = (unsigned)wid * 1024u;
    const int aoff = lds_byte(wr * 64 + fr, fq * 8), boff = lds_byte(wc * 32 + fr, fq * 8);
#define PG8_SA(b, h) (((b) * 2 + (h)) * HTB)
#define PG8_SB(b, h) ((4 + (b) * 2 + (h)) * HTB)
#define PG8_STAGE(bufoff, gbase, voff) do { _Pragma("unroll") for (int _i = 0; _i < 2; ++_i) \
        __builtin_amdgcn_global_load_lds((const unsigned*)((const char*)(gbase) + (voff)[_i]), (PG8_LAS unsigned*)(lds + (bufoff) + ldsw + _i * 8192), 16, 0, 0); } while (0)
#define PG8_LDA(dst, b, h) do { _Pragma("unroll") for (int m = 0; m < 4; ++m) _Pragma("unroll") for (int k = 0; k < 2; ++k) dst[m][k] = *(const PG8_LAS bf16x8*)(lds + PG8_SA(b, h) + aoff + m * 2048 + k * 1024); } while (0)
#define PG8_LDB(dst, b, h) do { _Pragma("unroll") for (int n = 0; n < 2; ++n) _Pragma("unroll") for (int k = 0; k < 2; ++k) dst[n][k] = *(const PG8_LAS bf16x8*)(lds + PG8_SB(b, h) + boff + n * 2048 + k * 1024); } while (0)
#define PG8_MMA(ai, bj, At, Bt) do { __builtin_amdgcn_s_setprio(1); _Pragma("unroll") for (int m = 0; m < 4; ++m) _Pragma("unroll") for (int n = 0; n < 2; ++n) _Pragma("unroll") for (int k = 0; k < 2; ++k) \
        acc[ai][bj][m][n] = __builtin_amdgcn_mfma_f32_16x16x32_bf16(Bt[n][k], At[m][k], acc[ai][bj][m][n], 0, 0, 0); __builtin_amdgcn_s_setprio(0); } while (0)
#define PG8_WAIT_V(n) asm volatile("s_waitcnt vmcnt(" #n ")" ::: "memory")
#define PG8_WAIT_L(n) asm volatile("s_waitcnt lgkmcnt(" #n ")" ::: "memory")
#define PG8_BAR __builtin_amdgcn_s_barrier()
#define PG8_SCHED __builtin_amdgcn_sched_barrier(0)
    Unit cur, nxt; int ui = 0;
    if (!S.next(0, cur)) return;
    f32x4 acc[2][2][4][2];
#pragma unroll
    for (int a = 0; a < 2; ++a)
#pragma unroll
        for (int b = 0; b < 2; ++b)
#pragma unroll
            for (int m = 0; m < 4; ++m)
#pragma unroll
                for (int n = 0; n < 2; ++n) acc[a][b][m][n] = (f32x4){0.f, 0.f, 0.f, 0.f};
    bf16x8 At[4][2], B0[2][2], B1[2][2];
    const char* cA = (const char*)g.A + (size_t)cur.pm * tstepA; const char* cB = (const char*)g.Bt + (size_t)cur.pn * tstep;
    S.a_ready(cur);
    if constexpr (SP2) {
        PG8_STAGE(PG8_SB(0, 0), cB, voffB); PG8_STAGE(PG8_SB(0, 1), cB + hstep, voffB); PG8_STAGE(PG8_SA(0, 0), cA, voffA); PG8_STAGE(PG8_SA(0, 1), cA + hstep, voffA);
        if (wr == 1) PG8_BAR;
        PG8_WAIT_V(2); PG8_BAR;
        PG8_STAGE(PG8_SB(1, 0), cB + kstep, voffB); PG8_STAGE(PG8_SA(1, 0), cA + kstep, voffA); PG8_STAGE(PG8_SB(1, 1), cB + hstep + kstep, voffB);
        PG8_WAIT_V(6); PG8_BAR;
    } else {
        PG8_STAGE(PG8_SB(0, 0), cB, voffB); PG8_STAGE(PG8_SA(0, 0), cA, voffA); PG8_STAGE(PG8_SB(0, 1), cB + hstep, voffB); PG8_STAGE(PG8_SA(0, 1), cA + hstep, voffA);
        if (wr == 1) PG8_BAR;
        PG8_WAIT_V(4); PG8_BAR;
        PG8_STAGE(PG8_SB(1, 0), cB + kstep, voffB); PG8_STAGE(PG8_SA(1, 0), cA + kstep, voffA); PG8_STAGE(PG8_SB(1, 1), cB + hstep + kstep, voffB);
        PG8_WAIT_V(6); PG8_BAR;
    }
    for (;;) {
        const bool has_next = S.next(ui + 1, nxt);
        const char* nA = has_next ? (const char*)g.A + (size_t)nxt.pm * tstepA : cA; const char* nB = has_next ? (const char*)g.Bt + (size_t)nxt.pn * tstep : cB;
        for (int t = 0; t < nt; t += 2) {
            const bool last = (t == nt - 2);
            const char* a1 = cA + (size_t)(t + 1) * kstep;
            const char* a2 = last ? nA : cA + (size_t)(t + 2) * kstep; const char* b2 = last ? nB : cB + (size_t)(t + 2) * kstep;
            const char* a3 = a2 + kstep; const char* b3 = b2 + kstep;
            if (last && has_next) S.a_ready(nxt);
            if constexpr (SP2) {
            PG8_LDB(B0, 0, 0); PG8_LDB(B1, 0, 1); PG8_SCHED; PG8_LDA(At, 0, 0); PG8_STAGE(PG8_SA(1, 1), a1 + hstep, voffA);
            PG8_WAIT_V(8); PG8_WAIT_L(0); PG8_BAR; PG8_MMA(0, 0, At, B0); PG8_MMA(0, 1, At, B1); PG8_BAR; PG8_SCHED;
            PG8_LDA(At, 0, 1); PG8_STAGE(PG8_SB(0, 0), b2, voffB); PG8_STAGE(PG8_SB(0, 1), b2 + hstep, voffB); PG8_STAGE(PG8_SA(0, 0), a2, voffA);
            PG8_WAIT_V(8); PG8_WAIT_L(0); PG8_BAR; PG8_MMA(1, 0, At, B0); PG8_MMA(1, 1, At, B1); PG8_BAR; PG8_SCHED;
            PG8_LDB(B0, 1, 0); PG8_LDB(B1, 1, 1); PG8_SCHED; PG8_LDA(At, 1, 0); PG8_STAGE(PG8_SA(0, 1), a2 + hstep, voffA);
            PG8_WAIT_V(8); PG8_WAIT_L(0); PG8_BAR; PG8_MMA(0, 0, At, B0); PG8_MMA(0, 1, At, B1); PG8_BAR; PG8_SCHED;
            PG8_LDA(At, 1, 1); PG8_STAGE(PG8_SB(1, 0), b3, voffB); PG8_STAGE(PG8_SB(1, 1), b3 + hstep, voffB); PG8_STAGE(PG8_SA(1, 0), a3, voffA);
            PG8_WAIT_V(8); PG8_WAIT_L(0); PG8_BAR; PG8_MMA(1, 0, At, B0); PG8_MMA(1, 1, At, B1); PG8_BAR; PG8_SCHED;
            } else {
            PG8_LDB(B0, 0, 0); PG8_SCHED; PG8_LDA(At, 0, 0); PG8_STAGE(PG8_SA(1, 1), a1 + hstep, voffA);
            PG8_WAIT_L(8); PG8_BAR; PG8_WAIT_L(0); PG8_MMA(0, 0, At, B0); PG8_BAR; PG8_SCHED;
            PG8_LDB(B1, 0, 1); PG8_STAGE(PG8_SB(0, 0), b2, voffB);
            PG8_BAR; PG8_WAIT_L(0); PG8_MMA(0, 1, At, B1); PG8_BAR;
            PG8_LDA(At, 0, 1); PG8_STAGE(PG8_SA(0, 0), a2, voffA);
            PG8_BAR; PG8_WAIT_L(0); PG8_MMA(1, 0, At, B0); PG8_BAR; PG8_SCHED;
            PG8_STAGE(PG8_SB(0, 1), b2 + hstep, voffB);
            PG8_WAIT_V(6); PG8_BAR; PG8_MMA(1, 1, At, B1); PG8_BAR;
            PG8_LDB(B0, 1, 0); PG8_SCHED; PG8_LDA(At, 1, 0); PG8_STAGE(PG8_SA(0, 1), a2 + hstep, voffA);
            PG8_WAIT_L(8); PG8_BAR; PG8_WAIT_L(0); PG8_MMA(0, 0, At, B0); PG8_BAR; PG8_SCHED;
            PG8_LDB(B1, 1, 1); PG8_STAGE(PG8_SB(1, 0), b3, voffB);
            PG8_BAR; PG8_WAIT_L(0); PG8_MMA(0, 1, At, B1); PG8_BAR;
            PG8_LDA(At, 1, 1); PG8_STAGE(PG8_SA(1, 0), a3, voffA);
            PG8_BAR; PG8_WAIT_L(0); PG8_MMA(1, 0, At, B0); PG8_BAR; PG8_SCHED;
            PG8_STAGE(PG8_SB(1, 1), b3 + hstep, voffB);
            PG8_WAIT_V(6); PG8_BAR; PG8_MMA(1, 1, At, B1); PG8_BAR;
            }
        }
        if constexpr (ALIGN_EPI) { if (wr == 0) PG8_BAR; }
        if constexpr (!Epi::AFTER_DRAIN) { E(acc, cur, wr, wc, fr, fq); S.done(cur); }
        if (!has_next) break;
#pragma unroll
        for (int a = 0; a < 2; ++a)
#pragma unroll
            for (int b = 0; b < 2; ++b)
#pragma unroll
                for (int m = 0; m < 4; ++m)
#pragma unroll
                    for (int n = 0; n < 2; ++n) acc[a][b][m][n] = (f32x4){0.f, 0.f, 0.f, 0.f};
        cur = nxt; cA = nA; cB = nB; ++ui;
        if constexpr (ALIGN_EPI) { if (wr == 1) PG8_BAR; }
    }
    PG8_WAIT_V(0);
    if constexpr (!ALIGN_EPI) { if (wr == 0) PG8_BAR; }
    PG8_BAR;
    if constexpr (Epi::AFTER_DRAIN) { E.fused(acc, cur, wr, wc, fr, fq, lds, wid, lane); S.done(cur); }
#undef PG8_SA
#undef PG8_SB
#undef PG8_STAGE
#undef PG8_LDA
#undef PG8_LDB
#undef PG8_MMA
#undef PG8_WAIT_V
#undef PG8_WAIT_L
#undef PG8_BAR
#undef PG8_SCHED
}
}

using pg8::bf16_t; using pg8::f32x4; using pg8::Unit; using pg8::cvt_pk_bf16;
typedef short bf16x8 __attribute__((ext_vector_type(8)));
typedef _Float16 f16x8 __attribute__((ext_vector_type(8)));
typedef float f32x16 __attribute__((ext_vector_type(16)));
typedef unsigned u32x4 __attribute__((ext_vector_type(4)));
typedef unsigned u32x2 __attribute__((ext_vector_type(2)));
typedef short s16x4 __attribute__((ext_vector_type(4)));
#define LAS __attribute__((address_space(3)))

constexpr int BATCH = 16, SEQ = 4096, DM = 1024, MTOK = BATCH * SEQ;
constexpr int NPROJ = 3072, NREAL = 2888, DFF = 2816, NUP = 5632, MODW = 6144;
constexpr int MHALF = MTOK / 2;
constexpr float EPS = 1e-6f, LOG2E = 1.4426950408889634f, QSCALE = 0.125f * LOG2E;
constexpr size_t MiB = 1u << 20;
constexpr size_t WS_MOD = 0, WS_WIN = 1 * MiB, WS_WOUT = 7 * MiB, WS_WUP = 9 * MiB, WS_WDN = 20 * MiB, WS_H = 26 * MiB;
constexpr size_t WS_AQ = 154 * MiB, WS_AK = 218 * MiB, WS_AV = 282 * MiB, WS_BQ = 346 * MiB, WS_BK = 410 * MiB, WS_BV = 426 * MiB;
constexpr size_t WS_IQ = 442 * MiB, WS_IK = 506 * MiB, WS_IW = 514 * MiB, WS_CAT = 516 * MiB, WS_SC = 644 * MiB;
constexpr size_t WS_U = 154 * MiB, WS_G = 506 * MiB, WS_END = 1024 * MiB;
constexpr size_t WS_X1B = 644 * MiB;
constexpr int LDS_BYTES = 147456;

struct Params {
    const float *x, *c, *w_ada, *b_ada, *g_attn, *w_in, *qna, *kna, *qnb, *knb, *lam, *subln, *w_out, *g_ffn, *w_up, *conv_w, *conv_b, *w_down, *rel_bias;
    float* out; unsigned char* ws;
};

__device__ __forceinline__ int otid(int wv) { int l; asm volatile("v_mbcnt_lo_u32_b32 %0, -1, 0\n\tv_mbcnt_hi_u32_b32 %0, -1, %0" : "=v"(l)); return wv * 64 + l; }
__device__ __forceinline__ float wave_sum(float v) {
#pragma unroll
    for (int o = 1; o < 64; o <<= 1) v += __shfl_xor(v, o);
    return v;
}
__device__ __forceinline__ float wave_max(float v) {
#pragma unroll
    for (int o = 1; o < 64; o <<= 1) v = fmaxf(v, __shfl_xor(v, o));
    return v;
}
__device__ __forceinline__ unsigned pk_f16(float a, float b) {
    _Float16 x = (_Float16)a, y = (_Float16)b;
    return (unsigned)__builtin_bit_cast(unsigned short, x) | ((unsigned)__builtin_bit_cast(unsigned short, y) << 16);
}
__device__ __forceinline__ int pi32(int m) { const int a = m >> 3, h = (m >> 2) & 1, c = m & 3; return 16 * (a >> 1) + 8 * h + 4 * (a & 1) + c; }
__device__ __forceinline__ int crow(int r, int hi) { return (r & 3) + 8 * (r >> 2) + 4 * hi; }
__device__ __forceinline__ int t5_bucket(int n) {
    if (n < 16) return n;
    return 16 + (n >= 19) + (n >= 21) + (n >= 24) + (n >= 27) + (n >= 31) + (n >= 35) + (n >= 40) + (n >= 46) + (n >= 52) + (n >= 59) + (n >= 67) + (n >= 77) + (n >= 87) + (n >= 99) + (n >= 113);
}
__device__ __forceinline__ s16x4 vtr(const LAS unsigned char* p) {
    return __builtin_bit_cast(s16x4, __builtin_amdgcn_ds_read_tr16_b64_v4i16((LAS s16x4*)p));
}

__device__ __forceinline__ int perm_inv(int n) { return (n & ~255) + 128 * ((n >> 5) & 1) + 32 * ((n >> 6) & 3) + (n & 31); }
__device__ __forceinline__ int perm_up(int n) { const int v = n >= DFF, m = n - (v ? DFF : 0); return (m >> 7) * 256 + 128 * v + (m & 127); }
__device__ __forceinline__ void transpose_tile(const float* W, int K, int N, int nreal, bf16_t* Bt, int k0, int n0, int permute, LAS float* scr, int tid) {
#pragma unroll
    for (int i = 0; i < 8; ++i) { const int kk = (tid >> 6) + 8 * i, nn = tid & 63, n = n0 + nn; scr[kk * 65 + nn] = (n < nreal) ? W[(size_t)(k0 + kk) * N + n] : 0.f; }
    __syncthreads();
    { const int nn = tid >> 3, c = tid & 7, n = n0 + nn, drow = permute == 1 ? perm_inv(n) : (permute == 2 ? perm_up(n) : n); const LAS float* s = scr + (8 * c) * 65 + nn;
      u32x4 o; o.x = cvt_pk_bf16(s[0], s[65]); o.y = cvt_pk_bf16(s[130], s[195]); o.z = cvt_pk_bf16(s[260], s[325]); o.w = cvt_pk_bf16(s[390], s[455]);
      *(u32x4*)(Bt + (size_t)drow * K + k0 + 8 * c) = o; }
    __syncthreads();
}
__device__ __forceinline__ void phase0(const Params& p, LAS unsigned char* lds, int wv) {
    const int tid = otid(wv);
    LAS float* sc = (LAS float*)lds;
    LAS float* scr = (LAS float*)(lds + 65536);
    LAS float* red = (LAS float*)(lds + 65536 + 16640);
    constexpr int I_IN = 16 * 48, I_OUT = 16 * 16, I_UP = 16 * 88, I_DN = 44 * 16, NIT = I_IN + I_OUT + I_UP + I_DN;
    for (int it = blockIdx.x; it < NIT; it += gridDim.x) {
        int r = it;
        if (r < I_IN) { transpose_tile(p.w_in, 1024, NREAL, NREAL, (bf16_t*)(p.ws + WS_WIN), 64 * (r / 48), 64 * (r % 48), 1, scr, tid); continue; } r -= I_IN;
        if (r < I_OUT) { transpose_tile(p.w_out, 1024, 1024, 1024, (bf16_t*)(p.ws + WS_WOUT), 64 * (r / 16), 64 * (r % 16), 0, scr, tid); continue; } r -= I_OUT;
        if (r < I_UP) { transpose_tile(p.w_up, 1024, NUP, NUP, (bf16_t*)(p.ws + WS_WUP), 64 * (r / 88), 64 * (r % 88), 2, scr, tid); continue; } r -= I_UP;
        transpose_tile(p.w_down, DFF, 1024, 1024, (bf16_t*)(p.ws + WS_WDN), 64 * (r / 16), 64 * (r % 16), 0, scr, tid);
    }
    if (blockIdx.x < 192) {
        for (int i = tid; i < 16 * 1024; i += 512) { const float v = p.c[i]; sc[i] = v / (1.f + __expf(-v)); }
        __syncthreads();
        float* mod = (float*)(p.ws + WS_MOD);
        for (int g = blockIdx.x; g < 192; g += gridDim.x) {
            const int kq = tid >> 5, col = tid & 31;
            float acc[16];
#pragma unroll
            for (int b = 0; b < 16; ++b) acc[b] = 0.f;
#pragma unroll 1
            for (int kb = 0; kb < 64; kb += 16) {
                float wv16[16];
#pragma unroll
                for (int i = 0; i < 16; ++i) wv16[i] = p.w_ada[(size_t)(kq * 64 + kb + i) * MODW + g * 32 + col];
#pragma unroll
                for (int i = 0; i < 16; ++i) { const int k = kq * 64 + kb + i;
#pragma unroll
                    for (int b = 0; b < 16; ++b) acc[b] += sc[b * 1024 + k] * wv16[i]; } }
#pragma unroll
            for (int b = 0; b < 16; ++b) red[(kq * 16 + b) * 32 + col] = acc[b];
            __syncthreads();
            { const int b = tid >> 5; float s = p.b_ada[g * 32 + col];
#pragma unroll
              for (int q = 0; q < 16; ++q) s += red[(q * 16 + b) * 32 + col];
              mod[b * MODW + g * 32 + col] = s; }
            __syncthreads();
        }
    }
}

__device__ __forceinline__ void norm_phase(const float* X, const float* gvec, const float* mod, int sc_off, int sh_off, bf16_t* H, int wv) {
    const int tid = otid(wv); const int lane = tid & 63, gw = blockIdx.x * 8 + (tid >> 6), NGW = gridDim.x * 8;
    for (int row0 = gw; row0 < MTOK; row0 += 4 * NGW) {
        f32x4 v[4][4];
#pragma unroll
        for (int q = 0; q < 4; ++q) { const int row = min(row0 + q * NGW, MTOK - 1); const f32x4* xr = (const f32x4*)(X + (size_t)row * DM) + lane;
#pragma unroll
            for (int j = 0; j < 4; ++j) v[q][j] = xr[64 * j]; }
#pragma unroll
        for (int q = 0; q < 4; ++q) {
            const int row = row0 + q * NGW;
            float ss = 0.f;
#pragma unroll
            for (int j = 0; j < 4; ++j) ss += (v[q][j].x * v[q][j].x + v[q][j].y * v[q][j].y) + (v[q][j].z * v[q][j].z + v[q][j].w * v[q][j].w);
            const float rs = 1.0f / sqrtf(wave_sum(ss) * (1.f / DM) + EPS);
            if (row < MTOK) { const int b = row >> 12;
#pragma unroll
                for (int j = 0; j < 4; ++j) { const int col = (lane + 64 * j) * 4;
                    const f32x4 g4 = *(const f32x4*)(gvec + col), s4 = *(const f32x4*)(mod + b * MODW + sc_off + col), h4 = *(const f32x4*)(mod + b * MODW + sh_off + col);
                    const f32x4 y = (v[q][j] * rs) * g4 * (s4 + 1.0f) + h4; u32x2 o; o.x = cvt_pk_bf16(y.x, y.y); o.y = cvt_pk_bf16(y.z, y.w);
                    *(u32x2*)(H + (size_t)row * DM + col) = o; } }
        }
    }
}

__device__ __forceinline__ void norm_phase_b16(const bf16_t* X, const float* gvec, const float* mod, int sc_off, int sh_off, bf16_t* H, int wv) {
    const int tid = otid(wv); const int lane = tid & 63, gw = blockIdx.x * 8 + (tid >> 6), NGW = gridDim.x * 8;
    for (int row0 = gw; row0 < MTOK; row0 += 4 * NGW) {
        u32x4 raw[4][2];
#pragma unroll
        for (int q = 0; q < 4; ++q) { const int row = min(row0 + q * NGW, MTOK - 1); const u32x4* xr = (const u32x4*)(X + (size_t)row * DM) + lane;
            raw[q][0] = xr[0]; raw[q][1] = xr[64]; }
#pragma unroll
        for (int q = 0; q < 4; ++q) {
            const int row = row0 + q * NGW;
            float f[16];
#pragma unroll
            for (int j = 0; j < 2; ++j) { const u32x4 w = raw[q][j];
                f[8 * j + 0] = __uint_as_float(w.x << 16); f[8 * j + 1] = __uint_as_float(w.x & 0xffff0000u); f[8 * j + 2] = __uint_as_float(w.y << 16); f[8 * j + 3] = __uint_as_float(w.y & 0xffff0000u);
                f[8 * j + 4] = __uint_as_float(w.z << 16); f[8 * j + 5] = __uint_as_float(w.z & 0xffff0000u); f[8 * j + 6] = __uint_as_float(w.w << 16); f[8 * j + 7] = __uint_as_float(w.w & 0xffff0000u); }
            float ss = 0.f;
#pragma unroll
            for (int e = 0; e < 16; ++e) ss += f[e] * f[e];
            const float rs = 1.0f / sqrtf(wave_sum(ss) * (1.f / DM) + EPS);
            if (row < MTOK) { const int b = row >> 12;
#pragma unroll
                for (int j = 0; j < 2; ++j) { const int col = 512 * j + 8 * lane; float y[8];
#pragma unroll
                    for (int h = 0; h < 2; ++h) { const f32x4 g4 = *(const f32x4*)(gvec + col + 4 * h), s4 = *(const f32x4*)(mod + b * MODW + sc_off + col + 4 * h), h4 = *(const f32x4*)(mod + b * MODW + sh_off + col + 4 * h);
                        y[4 * h + 0] = f[8 * j + 4 * h + 0] * rs * g4.x * (s4.x + 1.f) + h4.x; y[4 * h + 1] = f[8 * j + 4 * h + 1] * rs * g4.y * (s4.y + 1.f) + h4.y;
                        y[4 * h + 2] = f[8 * j + 4 * h + 2] * rs * g4.z * (s4.z + 1.f) + h4.z; y[4 * h + 3] = f[8 * j + 4 * h + 3] * rs * g4.w * (s4.w + 1.f) + h4.w; }
                    u32x4 o; o.x = cvt_pk_bf16(y[0], y[1]); o.y = cvt_pk_bf16(y[2], y[3]); o.z = cvt_pk_bf16(y[4], y[5]); o.w = cvt_pk_bf16(y[6], y[7]);
                    *(u32x4*)(H + (size_t)row * DM + col) = o; } }
        }
    }
}

struct EpiProj {
    static constexpr bool PERM = true, AFTER_DRAIN = false;
    unsigned char* ws; const float *qa, *ka, *qb, *kb;
    __device__ __forceinline__ void operator()(const f32x4 (&acc)[2][2][4][2], const Unit& u, int wr, int wc, int fr, int fq) const {
        const int G = u.pn * 4 + wc;
        if (G >= 46) return;
        int kind = 0, ld = 512, coloff = 0; unsigned char* base = ws; const float* gn = nullptr; float scale = 1.f;
        if (G < 8) { base = ws + WS_AQ; coloff = 64 * G; gn = qa; scale = QSCALE; }
        else if (G < 16) { base = ws + WS_AK; coloff = 64 * (G - 8); gn = ka; }
        else if (G < 24) { base = ws + WS_AV; coloff = 64 * (G - 16); }
        else if (G < 32) { base = ws + WS_BQ; coloff = 64 * (G - 24); gn = qb; scale = QSCALE; }
        else if (G < 34) { base = ws + WS_BK; ld = 128; coloff = 64 * (G - 32); gn = kb; }
        else if (G < 36) { base = ws + WS_BV; ld = 128; coloff = 64 * (G - 34); }
        else if (G < 44) { base = ws + WS_IQ; kind = 1; coloff = 64 * (G - 36); }
        else if (G == 44) { base = ws + WS_IK; kind = 1; ld = 64; }
        else { base = ws + WS_IW; kind = 2; }
        const int row0 = u.pm * 256 + wr * 64 + fr;
        f32x4 gv[2][2];
#pragma unroll
        for (int bj = 0; bj < 2; ++bj)
#pragma unroll
            for (int n = 0; n < 2; ++n) { gv[bj][n] = gn ? *(const f32x4*)(gn + 32 * bj + 8 * fq + 4 * n) : (f32x4){1.f, 1.f, 1.f, 1.f}; gv[bj][n] = gv[bj][n] * scale; }
#pragma unroll
        for (int ai = 0; ai < 2; ++ai)
#pragma unroll
            for (int m = 0; m < 4; ++m) {
                const size_t row = (size_t)(row0 + 128 * ai + 16 * m);
                float rs = 1.f;
                if (gn) { float ss = 0.f;
#pragma unroll
                    for (int bj = 0; bj < 2; ++bj)
#pragma unroll
                        for (int n = 0; n < 2; ++n) { const f32x4 v = acc[ai][bj][m][n]; ss += (v.x * v.x + v.y * v.y) + (v.z * v.z + v.w * v.w); }
                    ss += __shfl_xor(ss, 16); ss += __shfl_xor(ss, 32);
                    rs = __builtin_amdgcn_rsqf(ss * (1.f / 64.f) + EPS); }
                if (kind == 2) { if (fq == 0) { *(f32x4*)((float*)base + row * 8) = acc[ai][0][m][0] * 0.04419417382415922f; *(f32x4*)((float*)base + row * 8 + 4) = acc[ai][0][m][1] * 0.04419417382415922f; } }
                else {
#pragma unroll
                    for (int bj = 0; bj < 2; ++bj) { const f32x4 v0 = acc[ai][bj][m][0] * rs * gv[bj][0], v1 = acc[ai][bj][m][1] * rs * gv[bj][1]; u32x4 w;
                        if (kind == 0) { w.x = cvt_pk_bf16(v0.x, v0.y); w.y = cvt_pk_bf16(v0.z, v0.w); w.z = cvt_pk_bf16(v1.x, v1.y); w.w = cvt_pk_bf16(v1.z, v1.w); }
                        else { w.x = pk_f16(v0.x, v0.y); w.y = pk_f16(v0.z, v0.w); w.z = pk_f16(v1.x, v1.y); w.w = pk_f16(v1.z, v1.w); }
                        *(u32x4*)((bf16_t*)base + row * ld + coloff + 32 * bj + 8 * fq) = w; }
                }
            }
    }
};
struct EpiOut {
    static constexpr bool PERM = true, AFTER_DRAIN = false;
    const float* x; const float* gate; bf16_t* x1b;
    __device__ __forceinline__ void operator()(const f32x4 (&acc)[2][2][4][2], const Unit& u, int wr, int wc, int fr, int fq) const {
        const int row0 = u.pm * 256 + wr * 64 + fr, col0 = u.pn * 256 + wc * 32 + 8 * fq, b = (u.pm * 256) >> 12;
        f32x4 g[2][2];
#pragma unroll
        for (int bj = 0; bj < 2; ++bj)
#pragma unroll
            for (int n = 0; n < 2; ++n) g[bj][n] = *(const f32x4*)(gate + b * MODW + col0 + 128 * bj + 4 * n);
#pragma unroll
        for (int ai = 0; ai < 2; ++ai)
#pragma unroll
            for (int m = 0; m < 4; ++m) { const int row = row0 + 128 * ai + 16 * m;
#pragma unroll
                for (int bj = 0; bj < 2; ++bj) { const size_t off = (size_t)row * DM + col0 + 128 * bj;
                    const f32x4 a0 = *(const f32x4*)(x + off) + g[bj][0] * acc[ai][bj][m][0], a1 = *(const f32x4*)(x + off + 4) + g[bj][1] * acc[ai][bj][m][1];
                    u32x4 w; w.x = cvt_pk_bf16(a0.x, a0.y); w.y = cvt_pk_bf16(a0.z, a0.w); w.z = cvt_pk_bf16(a1.x, a1.y); w.w = cvt_pk_bf16(a1.z, a1.w);
                    *(u32x4*)(x1b + off) = w; } }
    }
};
struct EpiUp {
    static constexpr bool PERM = false, AFTER_DRAIN = false;
    bf16_t* U;
    __device__ __forceinline__ void operator()(const f32x4 (&acc)[2][2][4][2], const Unit& u, int wr, int wc, int fr, int fq) const {
        const int row0 = u.pm * 256 + wr * 64 + fr, col0 = u.pn * 256 + wc * 32 + 4 * fq;
#pragma unroll
        for (int ai = 0; ai < 2; ++ai)
#pragma unroll
            for (int m = 0; m < 4; ++m) { const size_t row = (size_t)(row0 + 128 * ai + 16 * m);
#pragma unroll
                for (int bj = 0; bj < 2; ++bj)
#pragma unroll
                    for (int n = 0; n < 2; ++n) { const f32x4 v = acc[ai][bj][m][n]; u32x2 w; w.x = cvt_pk_bf16(v.x, v.y); w.y = cvt_pk_bf16(v.z, v.w);
                        *(u32x2*)(U + row * NUP + col0 + 128 * bj + 16 * n) = w; } }
    }
};
constexpr int HALO_OFF = 131072;
__device__ __forceinline__ f32x4 dpp_ror(const f32x4 v, const int which) {
    f32x4 r;
    if (which == 1) { r.x = __int_as_float(__builtin_amdgcn_update_dpp(0, __float_as_int(v.x), 0x121, 0xf, 0xf, false)); r.y = __int_as_float(__builtin_amdgcn_update_dpp(0, __float_as_int(v.y), 0x121, 0xf, 0xf, false));
                      r.z = __int_as_float(__builtin_amdgcn_update_dpp(0, __float_as_int(v.z), 0x121, 0xf, 0xf, false)); r.w = __int_as_float(__builtin_amdgcn_update_dpp(0, __float_as_int(v.w), 0x121, 0xf, 0xf, false)); }
    else { r.x = __int_as_float(__builtin_amdgcn_update_dpp(0, __float_as_int(v.x), 0x122, 0xf, 0xf, false)); r.y = __int_as_float(__builtin_amdgcn_update_dpp(0, __float_as_int(v.y), 0x122, 0xf, 0xf, false));
           r.z = __int_as_float(__builtin_amdgcn_update_dpp(0, __float_as_int(v.z), 0x122, 0xf, 0xf, false)); r.w = __int_as_float(__builtin_amdgcn_update_dpp(0, __float_as_int(v.w), 0x122, 0xf, 0xf, false)); }
    return r;
}
struct EpiUpConv {
    static constexpr bool PERM = true, AFTER_DRAIN = false;
    bf16_t* Gout; const float* cw; const float* cb; LAS float* halo;
    __device__ __forceinline__ void operator()(const f32x4 (&acc)[2][2][4][2], const Unit& u, int wr, int wc, int fr_, int fq_) const {
        int fr = fr_, fq = fq_; asm volatile("" : "+v"(fr), "+v"(fq));
        if (fr >= 14) {
#pragma unroll
            for (int ai = 0; ai < 2; ++ai)
#pragma unroll
                for (int bj = 0; bj < 2; ++bj)
#pragma unroll
                    for (int n = 0; n < 2; ++n) *(LAS f32x4*)(halo + ((2 * ai + wr) * 2 + (fr - 14)) * 256 + 128 * bj + 32 * wc + 8 * fq + 4 * n) = acc[ai][bj][3][n];
        }
        asm volatile("s_waitcnt lgkmcnt(0)" ::: "memory"); __builtin_amdgcn_s_barrier(); asm volatile("" ::: "memory");
        const int R0 = u.pm * 254 - 2;
#pragma unroll
        for (int n = 0; n < 2; ++n) {
            const int cr = u.pn * 128 + wc * 32 + 8 * fq + 4 * n;
            const f32x4 g0 = *(const f32x4*)(cw + cr), g1 = *(const f32x4*)(cw + NUP + cr), g2 = *(const f32x4*)(cw + 2 * NUP + cr), gb = *(const f32x4*)(cb + cr);
            const f32x4 v0 = *(const f32x4*)(cw + DFF + cr), v1 = *(const f32x4*)(cw + NUP + DFF + cr), v2 = *(const f32x4*)(cw + 2 * NUP + DFF + cr), vb = *(const f32x4*)(cb + DFF + cr);
#pragma unroll
            for (int ai = 0; ai < 2; ++ai) {
                const int seg = 2 * ai + wr;
                f32x4 pr1[2], pr2[2];
#pragma unroll
                for (int bj = 0; bj < 2; ++bj) {
                    pr1[bj] = (f32x4){0.f, 0.f, 0.f, 0.f}; pr2[bj] = (f32x4){0.f, 0.f, 0.f, 0.f};
                    if (seg > 0) { const LAS float* hp = halo + ((seg - 1) * 2) * 256 + 128 * bj + 32 * wc + 8 * fq + 4 * n;
                        pr1[bj] = *(const LAS f32x4*)(hp + 256); pr2[bj] = *(const LAS f32x4*)(hp + ((fr & 1) ? 256 : 0)); }
                }
#pragma unroll
                for (int m = 0; m < 4; ++m) {
                    const int r = 128 * ai + 64 * wr + 16 * m + fr, R = R0 + r, t = R & (SEQ - 1);
                    f32x4 y[2];
#pragma unroll
                    for (int bj = 0; bj < 2; ++bj) {
                        const f32x4 X = acc[ai][bj][m][n]; const f32x4 r1 = dpp_ror(X, 1), r2 = dpp_ror(X, 2);
                        f32x4 p1 = (fr == 0) ? pr1[bj] : r1, p2 = (fr < 2) ? pr2[bj] : r2;
                        pr1[bj] = r1; pr2[bj] = r2;
                        if (t == 0) p1 = (f32x4){0.f, 0.f, 0.f, 0.f};
                        if (t <= 1) p2 = (f32x4){0.f, 0.f, 0.f, 0.f};
                        y[bj] = bj == 0 ? (gb + g0 * p2 + g1 * p1 + g2 * X) : (vb + v0 * p2 + v1 * p1 + v2 * X);
                    }
                    f32x4 o;
                    o.x = y[0].x * __builtin_amdgcn_rcpf(1.f + __builtin_amdgcn_exp2f(-LOG2E * y[0].x)) * y[1].x; o.y = y[0].y * __builtin_amdgcn_rcpf(1.f + __builtin_amdgcn_exp2f(-LOG2E * y[0].y)) * y[1].y;
                    o.z = y[0].z * __builtin_amdgcn_rcpf(1.f + __builtin_amdgcn_exp2f(-LOG2E * y[0].z)) * y[1].z; o.w = y[0].w * __builtin_amdgcn_rcpf(1.f + __builtin_amdgcn_exp2f(-LOG2E * y[0].w)) * y[1].w;
                    if (r >= 2 && R < MTOK) { u32x2 w; w.x = cvt_pk_bf16(o.x, o.y); w.y = cvt_pk_bf16(o.z, o.w); *(u32x2*)(Gout + (size_t)R * DFF + cr) = w; }
                }
            }
        }
    }
};
struct EpiDown {
    static constexpr bool PERM = true, AFTER_DRAIN = false;
    const float* gate; float* out; const bf16_t* x1b;
    __device__ __forceinline__ void operator()(const f32x4 (&acc)[2][2][4][2], const Unit& u, int wr, int wc, int fr, int fq) const {
        const int row0 = u.pm * 256 + wr * 64 + fr, col0 = u.pn * 256 + wc * 32 + 8 * fq, b = (u.pm * 256) >> 12;
        f32x4 g[2][2];
#pragma unroll
        for (int bj = 0; bj < 2; ++bj)
#pragma unroll
            for (int n = 0; n < 2; ++n) g[bj][n] = *(const f32x4*)(gate + b * MODW + col0 + 128 * bj + 4 * n);
#pragma unroll
        for (int ai = 0; ai < 2; ++ai)
#pragma unroll
            for (int m = 0; m < 4; ++m) { const int row = row0 + 128 * ai + 16 * m;
#pragma unroll
                for (int bj = 0; bj < 2; ++bj) { const size_t off = (size_t)row * DM + col0 + 128 * bj;
                    const u32x4 w = *(const u32x4*)(x1b + off);
                    const f32x4 x0 = (f32x4){__uint_as_float(w.x << 16), __uint_as_float(w.x & 0xffff0000u), __uint_as_float(w.y << 16), __uint_as_float(w.y & 0xffff0000u)};
                    const f32x4 x1 = (f32x4){__uint_as_float(w.z << 16), __uint_as_float(w.z & 0xffff0000u), __uint_as_float(w.w << 16), __uint_as_float(w.w & 0xffff0000u)};
                    *(f32x4*)(out + off) = x0 + g[bj][0] * acc[ai][bj][m][0]; *(f32x4*)(out + off + 4) = x1 + g[bj][1] * acc[ai][bj][m][1]; } }
    }
};

__device__ __forceinline__ void unpack8(const u32x4 w, float* f) {
    f[0] = __uint_as_float(w.x << 16); f[1] = __uint_as_float(w.x & 0xffff0000u); f[2] = __uint_as_float(w.y << 16); f[3] = __uint_as_float(w.y & 0xffff0000u);
    f[4] = __uint_as_float(w.z << 16); f[5] = __uint_as_float(w.z & 0xffff0000u); f[6] = __uint_as_float(w.w << 16); f[7] = __uint_as_float(w.w & 0xffff0000u);
}
__device__ __forceinline__ void conv_phase(const Params& p, const bf16_t* U, bf16_t* Gb, int wv) {
    constexpr int NCH = DFF / 8, NTASK = (MHALF / 32) * NCH;
    const int tid = otid(wv);
    for (int task = blockIdx.x * 512 + tid; task < NTASK; task += gridDim.x * 512) {
        const int ch = task % NCH, strip = task / NCH, r0 = strip * 32, col = ch * 8;
        float wg[3][8], wv[3][8], bg[8], bv[8];
#pragma unroll
        for (int j = 0; j < 3; ++j)
#pragma unroll
            for (int e = 0; e < 8; ++e) { wg[j][e] = p.conv_w[j * NUP + col + e]; wv[j][e] = p.conv_w[j * NUP + DFF + col + e]; }
#pragma unroll
        for (int e = 0; e < 8; ++e) { bg[e] = p.conv_b[col + e]; bv[e] = p.conv_b[DFF + col + e]; }
        float g2[8], g1[8], v2[8], v1[8];
        if ((r0 & (SEQ - 1)) == 0) {
#pragma unroll
            for (int e = 0; e < 8; ++e) { g2[e] = 0.f; g1[e] = 0.f; v2[e] = 0.f; v1[e] = 0.f; }
        } else {
            unpack8(*(const u32x4*)(U + (size_t)(r0 - 2) * NUP + col), g2); unpack8(*(const u32x4*)(U + (size_t)(r0 - 1) * NUP + col), g1);
            unpack8(*(const u32x4*)(U + (size_t)(r0 - 2) * NUP + DFF + col), v2); unpack8(*(const u32x4*)(U + (size_t)(r0 - 1) * NUP + DFF + col), v1);
        }
        for (int r = 0; r < 32; ++r) {
            float g0[8], v0[8], o[8];
            unpack8(*(const u32x4*)(U + (size_t)(r0 + r) * NUP + col), g0); unpack8(*(const u32x4*)(U + (size_t)(r0 + r) * NUP + DFF + col), v0);
#pragma unroll
            for (int e = 0; e < 8; ++e) {
                const float yg = bg[e] + wg[0][e] * g2[e] + wg[1][e] * g1[e] + wg[2][e] * g0[e];
                const float yv = bv[e] + wv[0][e] * v2[e] + wv[1][e] * v1[e] + wv[2][e] * v0[e];
                o[e] = yg / (1.f + __expf(-yg)) * yv;
                g2[e] = g1[e]; g1[e] = g0[e]; v2[e] = v1[e]; v1[e] = v0[e]; }
            u32x4 w; w.x = cvt_pk_bf16(o[0], o[1]); w.y = cvt_pk_bf16(o[2], o[3]); w.z = cvt_pk_bf16(o[4], o[5]); w.w = cvt_pk_bf16(o[6], o[7]);
            *(u32x4*)(Gb + (size_t)(r0 + r) * DFF + col) = w;
        }
    }
}
#ifndef REPM
#define REPM 1
#endif
#ifndef REPK
#define REPK 1
#endif
#ifndef REPT
#define REPT 1
#endif
#ifndef REPA
#define REPA 1
#endif
#ifndef REPB
#define REPB 1
#endif
#ifndef PB
#define PB 7
#endif

constexpr int A_KROW = 272, A_VROW = 320, A_KBUF = 64 * A_KROW, A_VBUF = 64 * A_VROW, A_STG = A_KBUF + A_VBUF;
constexpr int A_TOFF = 2 * A_STG, A_LOFF = A_TOFF + 1280;
__device__ __forceinline__ void attnA_phase(const Params& p, LAS unsigned char* lds, int wv) {
    const int tid = otid(wv), lane = tid & 63, wid = __builtin_amdgcn_readfirstlane(tid >> 6), r32 = lane & 31, hi = lane >> 5;
    const int c = wid >> 2, qg = wid & 3;
    float lam; { float a = p.lam[lane] * p.lam[64 + lane], b2 = p.lam[128 + lane] * p.lam[192 + lane]; a = wave_sum(a); b2 = wave_sum(b2); lam = expf(a) - expf(b2) + 0.2f; }
    const float Mq = wave_max(fabsf(p.qna[lane])), Mk = wave_max(fabsf(p.kna[lane]));
    const unsigned char* AQ = p.ws + WS_AQ; const unsigned char* AK = p.ws + WS_AK; const unsigned char* AV = p.ws + WS_AV;
    bf16_t* CAT = (bf16_t*)(p.ws + WS_CAT);
    LAS float* T = (LAS float*)(lds + A_TOFF);
    LAS float* linv = (LAS float*)(lds + A_LOFF) + wid * 32;
    const int vblkA = (gridDim.x == 256) ? (int)((blockIdx.x & 7) * 32 + (blockIdx.x >> 3)) : (int)blockIdx.x;
    for (int ui = vblkA; ui < 2048 * REPA; ui += gridDim.x) {
        const int v = ui & 255, rnd = (ui >> 8) & 7, bh = v >> 2, pp = (v & 3) + 4 * (rnd >> 1), qb = (rnd & 1) ? 31 - pp : pp;
        const int b = bh >> 2, h = bh & 3, q0 = qb * 128, NT = 2 * qb + 2;
        const size_t tokbase = (size_t)b * SEQ;
        if (tid < 320) { const int d = 223 - tid;
            T[tid] = d < 0 ? -1e30f : (p.rel_bias[t5_bucket(min(d, 127)) * 12 + h] - p.rel_bias[31 * 12 + h]) * LOG2E; }
        bf16x8 qf[4];
        { const unsigned char* Qp = AQ + (tokbase + q0 + 32 * qg + r32) * 1024 + h * 256 + c * 128 + hi * 16;
#pragma unroll
          for (int ds = 0; ds < 4; ++ds) qf[ds] = *(const bf16x8*)(Qp + 32 * ds); }
        const int qpos = q0 + 32 * qg + r32, qw0 = q0 + 32 * qg;
        f32x16 O[4];
#pragma unroll
        for (int e = 0; e < 4; ++e)
#pragma unroll
            for (int r = 0; r < 16; ++r) O[e][r] = 0.f;
        float l = 0.f;
        u32x4 kreg[2], vreg[2];
        const int srow = tid >> 4, sch = tid & 15;
#define A_LOAD(t) do { _Pragma("unroll") for (int i = 0; i < 2; ++i) { const size_t g = (tokbase + 64 * (t) + srow + 32 * i) * 1024 + h * 256 + sch * 16; \
        kreg[i] = *(const u32x4*)(AK + g); vreg[i] = *(const u32x4*)(AV + g); } } while (0)
#define A_WRITE(st) do { _Pragma("unroll") for (int i = 0; i < 2; ++i) { *(LAS u32x4*)(lds + (st) * A_STG + (srow + 32 * i) * A_KROW + sch * 16) = kreg[i]; \
        *(LAS u32x4*)(lds + (st) * A_STG + A_KBUF + (srow + 32 * i) * A_VROW + sch * 16) = vreg[i]; } } while (0)
        A_LOAD(0); A_WRITE(0);
        __syncthreads();
        for (int t = 0; t < NT; ++t) {
            if (t + 1 < NT) A_LOAD(t + 1);
            const int k0 = 64 * t;
            if (k0 <= qw0 + 31) {
                const bool near = (k0 + 63 + 113 > qw0);
                const LAS unsigned char* Kb = lds + (t & 1) * A_STG; const LAS unsigned char* Vb = Kb + A_KBUF;
                f32x16 s0, s1;
#pragma unroll
                for (int r = 0; r < 16; ++r) { s0[r] = 0.f; s1[r] = 0.f; }
                {
                    const LAS unsigned char* kp0 = Kb + (pi32(r32)) * A_KROW + c * 128 + hi * 16;
                    const LAS unsigned char* kp1 = kp0 + 32 * A_KROW;
#pragma unroll
                    for (int ds = 0; ds < 4; ++ds) { const bf16x8 ka = *(const LAS bf16x8*)(kp0 + 32 * ds), kb = *(const LAS bf16x8*)(kp1 + 32 * ds);
                        s0 = __builtin_amdgcn_mfma_f32_32x32x16_bf16(ka, qf[ds], s0, 0, 0, 0); s1 = __builtin_amdgcn_mfma_f32_32x32x16_bf16(kb, qf[ds], s1, 0, 0, 0); }
                }
                __builtin_amdgcn_sched_barrier(0);
                float sacc = 0.f;
#define A_SOFTMAX(S, HF) do { \
                    if (!near) { _Pragma("unroll") for (int r = 0; r < 16; ++r) S[r] = __builtin_amdgcn_exp2f(S[r]); } \
                    else { int ib = 223 - (qpos - k0 - 8 * hi - 32 * (HF)); asm volatile("" : "+v"(ib)); const LAS float* tp = T + ib; \
                        _Pragma("unroll") for (int r = 0; r < 16; ++r) S[r] = __builtin_amdgcn_exp2f(S[r] + tp[16 * (r >> 3) + (r & 7)]); } \
                    _Pragma("unroll") for (int r = 0; r < 16; ++r) sacc += S[r]; } while (0)
#define A_PV(S, HF) do { \
                    _Pragma("unroll") for (int jj = 0; jj < 2; ++jj) { \
                        const int j = 2 * (HF) + jj, rb = 8 * jj; \
                        u32x4 pw; pw.x = cvt_pk_bf16(S[rb], S[rb + 1]); pw.y = cvt_pk_bf16(S[rb + 2], S[rb + 3]); pw.z = cvt_pk_bf16(S[rb + 4], S[rb + 5]); pw.w = cvt_pk_bf16(S[rb + 6], S[rb + 7]); \
                        const bf16x8 pa = __builtin_bit_cast(bf16x8, pw); \
                        const LAS unsigned char* vp = Vb + (16 * j + 8 * hi + ((lane & 15) >> 2)) * A_VROW + (16 * ((lane >> 4) & 1) + 4 * (lane & 3)) * 2; \
                        _Pragma("unroll") for (int eb = 0; eb < 4; ++eb) { \
                            const s16x4 lo = vtr(vp + eb * 64), hh = vtr(vp + 4 * A_VROW + eb * 64); \
                            const bf16x8 vf = (bf16x8){lo[0], lo[1], lo[2], lo[3], hh[0], hh[1], hh[2], hh[3]}; \
                            O[eb] = __builtin_amdgcn_mfma_f32_32x32x16_bf16(pa, vf, O[eb], 0, 0, 0); } } } while (0)
                A_SOFTMAX(s0, 0);
                __builtin_amdgcn_sched_barrier(0);
                A_PV(s0, 0);
                A_SOFTMAX(s1, 1);
                __builtin_amdgcn_sched_barrier(0);
                A_PV(s1, 1);
#undef A_SOFTMAX
#undef A_PV
                l += sacc;
            }
            if (t + 1 < NT) A_WRITE((t + 1) & 1);
            __syncthreads();
        }
#undef A_LOAD
#undef A_WRITE
        l += __shfl_xor(l, 32);
        if (hi == 0) linv[r32] = (c == 1 ? lam : 1.f) / l;
        LAS float* comb = (LAS float*)lds + qg * (32 * 128);
        float f[16];
#pragma unroll
        for (int r = 0; r < 16; ++r) f[r] = linv[crow(r, hi)];
#pragma unroll
        for (int eb = 0; eb < 4; ++eb)
#pragma unroll
            for (int r = 0; r < 16; ++r) O[eb][r] *= f[r];
        if (c == 1) {
#pragma unroll
            for (int eb = 0; eb < 4; ++eb)
#pragma unroll
                for (int r = 0; r < 16; ++r) comb[crow(r, hi) * 128 + 32 * eb + r32] = O[eb][r];
        }
        __syncthreads();
        if (c == 0) {
            float gl[4];
#pragma unroll
            for (int eb = 0; eb < 4; ++eb) gl[eb] = p.subln[32 * eb + r32] * 0.8f;
#pragma unroll
            for (int r = 0; r < 16; ++r) {
                const int qr = crow(r, hi); float ss = 0.f;
#pragma unroll
                for (int eb = 0; eb < 4; ++eb) { O[eb][r] -= comb[qr * 128 + 32 * eb + r32]; ss += O[eb][r] * O[eb][r]; }
                ss += __shfl_xor(ss, 1); ss += __shfl_xor(ss, 2); ss += __shfl_xor(ss, 4); ss += __shfl_xor(ss, 8); ss += __shfl_xor(ss, 16);
                const float rs = 1.0f / sqrtf(ss * (1.f / 128.f) + EPS);
                bf16_t* op = CAT + (tokbase + q0 + 32 * qg + qr) * 1024 + h * 128 + r32;
#pragma unroll
                for (int eb = 0; eb < 4; ++eb) op[32 * eb] = (bf16_t)(cvt_pk_bf16(O[eb][r] * rs * gl[eb], 0.f) & 0xffffu);
            }
        }
        __syncthreads();
    }
}

#ifndef SKIP
#define SKIP 0
#endif
constexpr int B_QROW = 1040;
constexpr int B_HIST = 66560, B_HROW = 257;
constexpr int B_TOFF = B_HIST + 64 * B_HROW * 4;
constexpr int B_DT = 75776;
constexpr int B_INFO = B_TOFF + 4096;
constexpr int B_LINV = B_INFO + 1024;
constexpr int B_MASK = 98304, B_MROW = 130;
__device__ __forceinline__ unsigned ord_key(float f) { const unsigned u = __float_as_uint(f); return u ^ ((u >> 31) ? 0xffffffffu : 0x80000000u); }
__device__ __forceinline__ void phaseB(const Params& p, LAS unsigned char* lds, int wv) {
    const _Float16* IQ = (const _Float16*)(p.ws + WS_IQ); const _Float16* IK = (const _Float16*)(p.ws + WS_IK); const float* IW = (const float*)(p.ws + WS_IW);
    const unsigned char* BQ = p.ws + WS_BQ; const unsigned char* BK = p.ws + WS_BK; const unsigned char* BV = p.ws + WS_BV;
    bf16_t* CAT = (bf16_t*)(p.ws + WS_CAT);
    float* SC = (float*)(p.ws + WS_SC + (size_t)blockIdx.x * MiB);
    LAS float* Tb = (LAS float*)(lds + B_DT);
    LAS unsigned* hist = (LAS unsigned*)(lds + B_HIST);
    LAS unsigned* pfx = (LAS unsigned*)(lds + B_INFO); LAS int* needv = (LAS int*)(lds + B_INFO + 256); LAS unsigned* ceqv = (LAS unsigned*)(lds + B_INFO + 512); LAS int* cutv = (LAS int*)(lds + B_INFO + 768);
    const int vblkB = (gridDim.x == 256) ? (int)((blockIdx.x & 7) * 32 + (blockIdx.x >> 3)) : (int)blockIdx.x;
    for (int ui = vblkB; ui < 1024 * REPB; ui += gridDim.x) {
        const int v = ui & 255, rnd = (ui >> 8) & 3, b = v >> 4, pp = (v & 15) + 16 * (rnd >> 1), qb = (rnd & 1) ? 63 - pp : pp;
        const int q0 = 64 * qb, NT = qb + 1;
        const size_t tokbase = (size_t)b * SEQ;
        {
        const int tid = otid(wv);
        const int lane = tid & 63, wid = __builtin_amdgcn_readfirstlane(tid >> 6), r32 = lane & 31, hi = lane >> 5; (void)r32; (void)hi; (void)wid;
#pragma unroll
        for (int i = 0; i < 8; ++i) { const int id = tid + 512 * i, row = id >> 6, ch = id & 63;
            *(LAS u32x4*)(lds + row * B_QROW + ch * 16) = *(const u32x4*)((const unsigned char*)IQ + (tokbase + q0 + row) * 1024 + ch * 16); }
        for (int i = tid; i < 64 * B_HROW; i += 512) hist[i] = 0u;
        if (tid < 128) *(LAS f32x4*)(lds + B_TOFF + tid * 16) = *(const f32x4*)(IW + (tokbase + q0) * 8 + tid * 4);
        if (tid < 64) { const int n = q0 + tid + 1; pfx[tid] = 0u; needv[tid] = (n > 256) ? 256 : -1; ceqv[tid] = 0u; cutv[tid] = 4096; }
        __syncthreads();
#if !(SKIP & 1)
        {
            const int qg = wid & 1, ks = wid >> 1;
            const LAS float* wp = (const LAS float*)(lds + B_TOFF) + (32 * qg + r32) * 8;
            const LAS unsigned char* qp = lds + (32 * qg + r32) * B_QROW + hi * 16;
            LAS unsigned* hrow = hist + (32 * qg + r32) * B_HROW;
            const int tq = q0 + 32 * qg + r32;
#pragma unroll 1
            for (int rep1 = 0; rep1 < REPK; ++rep1)
#pragma unroll 1
            for (int kt = ks; kt < NT; kt += 4) {
                const int k0 = 64 * kt;
                f16x8 kf[2][4];
#pragma unroll
                for (int hf = 0; hf < 2; ++hf)
#pragma unroll
                    for (int ds = 0; ds < 4; ++ds) kf[hf][ds] = *(const f16x8*)(IK + (tokbase + k0 + 32 * hf + pi32(r32)) * 64 + 16 * ds + 8 * hi);
                f32x16 acc0, acc1;
#pragma unroll
                for (int r = 0; r < 16; ++r) { acc0[r] = 0.f; acc1[r] = 0.f; }
#pragma unroll 2
                for (int hh = 0; hh < 8; ++hh) {
                    const float wh = wp[hh];
                    f32x16 s0, s1;
#pragma unroll
                    for (int r = 0; r < 16; ++r) { s0[r] = 0.f; s1[r] = 0.f; }
#pragma unroll
                    for (int ds = 0; ds < 4; ++ds) { const f16x8 qfr = *(const LAS f16x8*)(qp + hh * 128 + ds * 32);
                        s0 = __builtin_amdgcn_mfma_f32_32x32x16_f16(kf[0][ds], qfr, s0, 0, 0, 0); s1 = __builtin_amdgcn_mfma_f32_32x32x16_f16(kf[1][ds], qfr, s1, 0, 0, 0); }
#pragma unroll
                    for (int r = 0; r < 16; ++r) { acc0[r] += wh * fmaxf(s0[r], 0.f); acc1[r] += wh * fmaxf(s1[r], 0.f); }
                }
                float* sp = SC + (size_t)(32 * qg + r32) * SEQ + k0 + 8 * hi;
                *(f32x4*)(sp) = (f32x4){acc0[0], acc0[1], acc0[2], acc0[3]}; *(f32x4*)(sp + 4) = (f32x4){acc0[4], acc0[5], acc0[6], acc0[7]};
                *(f32x4*)(sp + 16) = (f32x4){acc0[8], acc0[9], acc0[10], acc0[11]}; *(f32x4*)(sp + 20) = (f32x4){acc0[12], acc0[13], acc0[14], acc0[15]};
                *(f32x4*)(sp + 32) = (f32x4){acc1[0], acc1[1], acc1[2], acc1[3]}; *(f32x4*)(sp + 36) = (f32x4){acc1[4], acc1[5], acc1[6], acc1[7]};
                *(f32x4*)(sp + 48) = (f32x4){acc1[8], acc1[9], acc1[10], acc1[11]}; *(f32x4*)(sp + 52) = (f32x4){acc1[12], acc1[13], acc1[14], acc1[15]};
                if (q0 + 63 > 255 && rep1 == 0) {
                    int e0 = k0 + 8 * hi; asm volatile("" : "+v"(e0));
#pragma unroll
                    for (int r = 0; r < 16; ++r) { const int kp0 = e0 + 16 * (r >> 3) + (r & 7);
                        if (kp0 <= tq) atomicAdd((unsigned*)&hrow[ord_key(acc0[r]) >> 24], 1u);
                        if (kp0 + 32 <= tq) atomicAdd((unsigned*)&hrow[ord_key(acc1[r]) >> 24], 1u); }
                }
            }
        }
#endif
        }
        __builtin_amdgcn_fence(__ATOMIC_RELEASE, "workgroup");
        __syncthreads();
        __builtin_amdgcn_fence(__ATOMIC_ACQUIRE, "workgroup");
        {
        const int tid = otid(wv);
        const int lane = tid & 63, wid = __builtin_amdgcn_readfirstlane(tid >> 6);
#pragma unroll 1
        for (int rr = 0; rr < 8; ++rr) {
            const int row = wid * 8 + rr; const int need = needv[row];
            if (need > 0) {
                const LAS unsigned* hr = hist + row * B_HROW + 4 * lane;
                const unsigned c0 = hr[0], c1 = hr[1], c2 = hr[2], c3 = hr[3];
                const unsigned sl = c0 + c1 + c2 + c3; unsigned suf = sl;
#pragma unroll
                for (int o = 1; o < 64; o <<= 1) { const unsigned tv = __shfl_down(suf, o); if (lane + o < 64) suf += tv; }
                unsigned cum = suf - sl; int fbin = -1; unsigned fabove = 0u, fcnt = 0u;
                { if ((int)cum < need && (int)(cum + c3) >= need) { fbin = 4 * lane + 3; fabove = cum; fcnt = c3; } cum += c3;
                  if ((int)cum < need && (int)(cum + c2) >= need) { fbin = 4 * lane + 2; fabove = cum; fcnt = c2; } cum += c2;
                  if ((int)cum < need && (int)(cum + c1) >= need) { fbin = 4 * lane + 1; fabove = cum; fcnt = c1; } cum += c1;
                  if ((int)cum < need && (int)(cum + c0) >= need) { fbin = 4 * lane + 0; fabove = cum; fcnt = c0; } }
                if (fbin >= 0) { pfx[row] = (unsigned)fbin << 24; needv[row] = need - (int)fabove; ceqv[row] = fcnt; }
            }
        }
        }
        __syncthreads();
        {
            const int tid = otid(wv);
            for (int i = tid; i < 2560; i += 512) { const int hh = i / 320, d = 223 - (i - 320 * hh);
                Tb[i] = d < 0 ? -1e30f : (p.rel_bias[t5_bucket(min(d, 127)) * 12 + 4 + hh] - p.rel_bias[31 * 12 + 4 + hh]) * LOG2E; }
        }
        {
        const int tid = otid(wv);
        const int lane = tid & 63, wid = __builtin_amdgcn_readfirstlane(tid >> 6);
        LAS unsigned* wh = (LAS unsigned*)lds + wid * 320;
        const int nwords = 2 * NT;
        u32x4 bufA[16], bufB[16];
#define ROW_LOAD(buf, rowi) do { const float* sr_ = SC + (size_t)(rowi) * SEQ + 4 * lane; _Pragma("unroll") for (int i = 0; i < 16; ++i) { buf[i] = (u32x4){0u, 0u, 0u, 0u}; if (256 * i <= q0 + 63) buf[i] = *(const u32x4*)(sr_ + 256 * i); } } while (0)
#define OKEY(u) ((u) ^ (((u) >> 31) ? 0xffffffffu : 0x80000000u))
#define ROW_PROC(key, rowi) do { \
            const int row = (rowi), tr = q0 + row; \
            unsigned thr = 0u; int cut = -1; \
            int need = needv[row]; \
            _Pragma("unroll") for (int i = 0; i < 16; ++i) { const int e = 256 * i + 4 * lane; \
                key[i].x = (e <= tr) ? OKEY(key[i].x) : 0u; key[i].y = (e + 1 <= tr) ? OKEY(key[i].y) : 0u; key[i].z = (e + 2 <= tr) ? OKEY(key[i].z) : 0u; key[i].w = (e + 3 <= tr) ? OKEY(key[i].w) : 0u; } \
            if (need > 0) { \
                unsigned prefix = pfx[row]; unsigned cnt = ceqv[row]; bool done = false; \
                if (need == (int)cnt) { thr = prefix - 1u; done = true; } \
                _Pragma("unroll 1") for (int pass = 1; pass < 4 && !done; ++pass) { \
                    const int shift = 24 - 8 * pass; const unsigned msk = 0xffffffffu << (shift + 8); \
                    wh[lane] = 0u; wh[64 + lane] = 0u; wh[128 + lane] = 0u; wh[192 + lane] = 0u; \
                    _Pragma("unroll") for (int i = 0; i < 16; ++i) { \
                        { const unsigned k = key[i].x; atomicAdd((unsigned*)&wh[((k & msk) == prefix) ? ((k >> shift) & 255u) : (256u + lane)], 1u); } \
                        { const unsigned k = key[i].y; atomicAdd((unsigned*)&wh[((k & msk) == prefix) ? ((k >> shift) & 255u) : (256u + lane)], 1u); } \
                        { const unsigned k = key[i].z; atomicAdd((unsigned*)&wh[((k & msk) == prefix) ? ((k >> shift) & 255u) : (256u + lane)], 1u); } \
                        { const unsigned k = key[i].w; atomicAdd((unsigned*)&wh[((k & msk) == prefix) ? ((k >> shift) & 255u) : (256u + lane)], 1u); } } \
                    const unsigned c0 = wh[4 * lane], c1 = wh[4 * lane + 1], c2 = wh[4 * lane + 2], c3 = wh[4 * lane + 3]; \
                    const unsigned sl = c0 + c1 + c2 + c3; unsigned suf = sl; \
                    _Pragma("unroll") for (int o = 1; o < 64; o <<= 1) { const unsigned tv = __shfl_down(suf, o); if (lane + o < 64) suf += tv; } \
                    unsigned cum = suf - sl; int fbin = -1; unsigned fabove = 0u, fcnt = 0u; \
                    { if ((int)cum < need && (int)(cum + c3) >= need) { fbin = 4 * lane + 3; fabove = cum; fcnt = c3; } cum += c3; \
                      if ((int)cum < need && (int)(cum + c2) >= need) { fbin = 4 * lane + 2; fabove = cum; fcnt = c2; } cum += c2; \
                      if ((int)cum < need && (int)(cum + c1) >= need) { fbin = 4 * lane + 1; fabove = cum; fcnt = c1; } cum += c1; \
                      if ((int)cum < need && (int)(cum + c0) >= need) { fbin = 4 * lane + 0; fabove = cum; fcnt = c0; } } \
                    const unsigned long long bm = __ballot(fbin >= 0); const int src = __ffsll((long long)bm) - 1; \
                    const int bin = __shfl(fbin, src); const unsigned above = __shfl(fabove, src); cnt = __shfl(fcnt, src); \
                    prefix |= (unsigned)bin << shift; need -= (int)above; \
                    if (pass < 3 && need == (int)cnt) { thr = prefix - 1u; done = true; } \
                } \
                if (!done) { thr = prefix; cut = 4096; \
                    if (need < (int)cnt) {        \
                        const float* srow = SC + (size_t)row * SEQ; int tbase = 0; \
                        for (int j = 0; j * 64 <= tr; ++j) { const int e = 64 * j + lane; const bool eq = (e <= tr) && (ord_key(srow[e]) == thr); \
                            const unsigned long long be = __ballot(eq); \
                            const int tpos = tbase + (int)__builtin_amdgcn_mbcnt_hi((unsigned)(be >> 32), __builtin_amdgcn_mbcnt_lo((unsigned)be, 0u)); \
                            const unsigned long long bh = __ballot(eq && tpos == need - 1); \
                            if (bh) { cut = 64 * j + (__ffsll((long long)bh) - 1); break; } \
                            tbase += __popcll(be); } \
                    } \
                } \
            } \
            LAS unsigned* mw = (LAS unsigned*)(lds + B_MASK) + row * B_MROW; \
            _Pragma("unroll") for (int i = 0; i < 16; ++i) if (256 * i <= q0 + 63) { const int e = 256 * i + 4 * lane; \
                unsigned nib = 0u; \
                nib |= (key[i].x > thr || (key[i].x == thr && e <= cut)) ? 1u : 0u; nib |= (key[i].y > thr || (key[i].y == thr && e + 1 <= cut)) ? 2u : 0u; \
                nib |= (key[i].z > thr || (key[i].z == thr && e + 2 <= cut)) ? 4u : 0u; nib |= (key[i].w > thr || (key[i].w == thr && e + 3 <= cut)) ? 8u : 0u; \
                unsigned v = nib << (4 * (lane & 7)); v |= __shfl_xor(v, 1); v |= __shfl_xor(v, 2); v |= __shfl_xor(v, 4); \
                const int w = 8 * i + (lane >> 3); if ((lane & 7) == 0 && w < nwords) mw[w] = v; } \
        } while (0)
        ROW_LOAD(bufA, wid * 8);
#pragma unroll 1
        for (int rr = 0; rr < 8; rr += 2) {
            ROW_LOAD(bufB, wid * 8 + rr + 1);
            ROW_PROC(bufA, wid * 8 + rr);
            if (rr + 2 < 8) ROW_LOAD(bufA, wid * 8 + rr + 2);
            ROW_PROC(bufB, wid * 8 + rr + 1);
        }
#undef ROW_LOAD
#undef ROW_PROC
#undef OKEY
        }
        __syncthreads();
#pragma unroll 1
        for (int rep3 = 0; rep3 < ((SKIP & 8) ? 0 : REPT); ++rep3) {
        const int tid = otid(wv);
        const int lane = tid & 63, wid = __builtin_amdgcn_readfirstlane(tid >> 6), r32 = lane & 31, hi = lane >> 5; (void)r32; (void)hi; (void)wid;
            LAS float* linv = (LAS float*)(lds + B_LINV) + wid * 64;
            const int qg = wid & 1, hp = wid >> 1, g = hp >> 1;
            const int qpos = q0 + 32 * qg + r32, qw0 = q0 + 32 * qg;
            const unsigned char* Qp0 = BQ + (tokbase + qpos) * 1024 + (2 * hp) * 128 + hi * 16;
            const LAS unsigned* mrow = (const LAS unsigned*)(lds + B_MASK) + (32 * qg + r32) * B_MROW;
            bf16x8 qf2[2][4];
#pragma unroll
            for (int hh = 0; hh < 2; ++hh)
#pragma unroll
                for (int ds = 0; ds < 4; ++ds) qf2[hh][ds] = *(const bf16x8*)(Qp0 + hh * 128 + 32 * ds);
            f32x16 O[2][2];
#pragma unroll
            for (int hh = 0; hh < 2; ++hh)
#pragma unroll
                for (int db = 0; db < 2; ++db)
#pragma unroll
                    for (int r = 0; r < 16; ++r) O[hh][db][r] = 0.f;
            float l0 = 0.f, l1 = 0.f;
            u32x4 kreg[2], vreg[2];
            const int srow_ = tid >> 4, sch = tid & 15;
#define B_LOAD(t) do { _Pragma("unroll") for (int i = 0; i < 2; ++i) { const size_t gofs = (tokbase + 64 * (t) + srow_ + 32 * i) * 256 + sch * 16; \
            kreg[i] = *(const u32x4*)(BK + gofs); vreg[i] = *(const u32x4*)(BV + gofs); } } while (0)
#define B_WRITE(st) do { _Pragma("unroll") for (int i = 0; i < 2; ++i) { *(LAS u32x4*)(lds + (st) * A_STG + (srow_ + 32 * i) * A_KROW + sch * 16) = kreg[i]; \
            *(LAS u32x4*)(lds + (st) * A_STG + A_KBUF + (srow_ + 32 * i) * A_VROW + sch * 16) = vreg[i]; } } while (0)
            B_LOAD(0); B_WRITE(0);
            __syncthreads();
#pragma unroll 1
            for (int t = 0; t < NT; ++t) {
                if (t + 1 < NT) B_LOAD(t + 1);
                const int k0 = 64 * t;
                const bool near = (k0 + 63 + 113 > qw0);
                const LAS unsigned char* Kb = lds + (t & 1) * A_STG; const LAS unsigned char* Vb = Kb + A_KBUF;
                unsigned selm;
                { const unsigned w0 = mrow[2 * t] >> (8 * hi), w1 = mrow[2 * t + 1] >> (8 * hi);
                  selm = (w0 & 0xffu) | ((w0 >> 8) & 0xff00u) | ((w1 & 0xffu) << 16) | ((w1 << 8) & 0xff000000u); }
                float sacc0 = 0.f, sacc1 = 0.f;
#pragma unroll
                for (int hf = 0; hf < 2; ++hf) {
                    f32x16 s0, s1;
#pragma unroll
                    for (int r = 0; r < 16; ++r) { const float cm = ((selm >> (16 * hf + r)) & 1u) ? 0.f : -1e30f; s0[r] = cm; s1[r] = cm; }
                    const LAS unsigned char* kp = Kb + (32 * hf + pi32(r32)) * A_KROW + g * 128 + hi * 16;
#pragma unroll
                    for (int ds = 0; ds < 4; ++ds) { const bf16x8 kf = *(const LAS bf16x8*)(kp + 32 * ds);
                        s0 = __builtin_amdgcn_mfma_f32_32x32x16_bf16(kf, qf2[0][ds], s0, 0, 0, 0); s1 = __builtin_amdgcn_mfma_f32_32x32x16_bf16(kf, qf2[1][ds], s1, 0, 0, 0); }
                    if (!near) {
#pragma unroll
                        for (int r = 0; r < 16; ++r) { s0[r] = __builtin_amdgcn_exp2f(s0[r]); s1[r] = __builtin_amdgcn_exp2f(s1[r]); }
                    } else {
                        int ib = 223 - (qpos - k0 - 8 * hi - 32 * hf); asm volatile("" : "+v"(ib));
                        const LAS float* tp0 = Tb + (2 * hp) * 320 + ib; const LAS float* tp1 = tp0 + 320;
#pragma unroll
                        for (int r = 0; r < 16; ++r) { s0[r] = __builtin_amdgcn_exp2f(s0[r] + tp0[16 * (r >> 3) + (r & 7)]); s1[r] = __builtin_amdgcn_exp2f(s1[r] + tp1[16 * (r >> 3) + (r & 7)]); }
                    }
#pragma unroll
                    for (int r = 0; r < 16; ++r) { sacc0 += s0[r]; sacc1 += s1[r]; }
#pragma unroll
                    for (int jj = 0; jj < 2; ++jj) {
                        const int j = 2 * hf + jj, rb = 8 * jj;
                        u32x4 pw0, pw1;
                        pw0.x = cvt_pk_bf16(s0[rb], s0[rb + 1]); pw0.y = cvt_pk_bf16(s0[rb + 2], s0[rb + 3]); pw0.z = cvt_pk_bf16(s0[rb + 4], s0[rb + 5]); pw0.w = cvt_pk_bf16(s0[rb + 6], s0[rb + 7]);
                        pw1.x = cvt_pk_bf16(s1[rb], s1[rb + 1]); pw1.y = cvt_pk_bf16(s1[rb + 2], s1[rb + 3]); pw1.z = cvt_pk_bf16(s1[rb + 4], s1[rb + 5]); pw1.w = cvt_pk_bf16(s1[rb + 6], s1[rb + 7]);
                        const bf16x8 pa0 = __builtin_bit_cast(bf16x8, pw0), pa1 = __builtin_bit_cast(bf16x8, pw1);
                        const LAS unsigned char* vp = Vb + (16 * j + 8 * hi + ((lane & 15) >> 2)) * A_VROW + (g * 64 + 16 * ((lane >> 4) & 1) + 4 * (lane & 3)) * 2;
#pragma unroll
                        for (int db = 0; db < 2; ++db) {
                            const s16x4 lo = vtr(vp + db * 64), hv = vtr(vp + 4 * A_VROW + db * 64);
                            const bf16x8 vf = (bf16x8){lo[0], lo[1], lo[2], lo[3], hv[0], hv[1], hv[2], hv[3]};
                            O[0][db] = __builtin_amdgcn_mfma_f32_32x32x16_bf16(pa0, vf, O[0][db], 0, 0, 0);
                            O[1][db] = __builtin_amdgcn_mfma_f32_32x32x16_bf16(pa1, vf, O[1][db], 0, 0, 0);
                        }
                    }
                    __builtin_amdgcn_sched_barrier(0);
                }
                l0 += sacc0; l1 += sacc1;
                if (t + 1 < NT) B_WRITE((t + 1) & 1);
                __syncthreads();
            }
#undef B_LOAD
#undef B_WRITE
            l0 += __shfl_xor(l0, 32); l1 += __shfl_xor(l1, 32);
            if (hi == 0) { linv[r32] = 1.0f / l0; linv[32 + r32] = 1.0f / l1; }
#pragma unroll
            for (int hh = 0; hh < 2; ++hh)
#pragma unroll
                for (int r = 0; r < 16; ++r) { const int qr = crow(r, hi); const float f = linv[32 * hh + qr];
                    bf16_t* op = CAT + (tokbase + q0 + 32 * qg + qr) * 1024 + 512 + (2 * hp + hh) * 64 + r32;
#pragma unroll
                    for (int db = 0; db < 2; ++db) op[32 * db] = (bf16_t)(cvt_pk_bf16(O[hh][db][r] * f, 0.f) & 0xffffu); }
            if (REPT > 1) __syncthreads();
        }
        __syncthreads();
    }
}
#ifndef REPG1
#define REPG1 1
#endif
#ifndef REPG2
#define REPG2 1
#endif
#ifndef REPG3
#define REPG3 1
#endif
#ifndef PH
#define PH 255
#endif

#define XB_TMO      128
#define XB_XCNT(j)  (256  + 64 * (j))
#define XB_XSUB(j)  (1280 + 64 * (j))
#define XB_XGEN(j)  (2304 + 64 * (j))
#define XB_TOP      3328
#define XB_TOPGEN   3392
#define XCD_BAR_WORDS 3456
#define XB_SPIN_CAP (1u << 18)

__device__ __forceinline__ unsigned xb_ld(unsigned* p)              { return __hip_atomic_load(p, __ATOMIC_RELAXED, __HIP_MEMORY_SCOPE_AGENT); }
__device__ __forceinline__ unsigned xb_add(unsigned* p, unsigned v) { return __hip_atomic_fetch_add(p, v, __ATOMIC_RELAXED, __HIP_MEMORY_SCOPE_AGENT); }
__device__ __forceinline__ unsigned xb_xcc_id() { return (unsigned)__builtin_amdgcn_s_getreg((3 << 11) | 20) & 0xFu; }
#define XB_SPIN(cond, bar) do { unsigned _sp = 0; while (cond) { __builtin_amdgcn_s_sleep(1); \
    if ((++_sp & 255u) == 0u) { if (xb_ld(&(bar)[XB_TMO])) break; if (_sp > XB_SPIN_CAP) { atomicAdd(&(bar)[XB_TMO], 1u); break; } } } } while (0)

struct XcdBarrier {
    unsigned* bar; unsigned x;
    volatile LAS unsigned* st;
};

__device__ __forceinline__ XcdBarrier xcd_barrier_post(unsigned* bar, volatile LAS unsigned* st) {
    XcdBarrier b; b.bar = bar; b.x = xb_xcc_id(); b.st = st;
    if (threadIdx.x == 0) (void)xb_add(&bar[XB_XCNT(b.x)], 1u);
    return b;
}
__device__ __forceinline__ void xcd_barrier_complete(unsigned* bar, unsigned x, unsigned& nloc, unsigned& nx) {
    const unsigned G = gridDim.x * gridDim.y * gridDim.z;
    unsigned sum, cnt, mine, sp = 0u;
    for (;;) {
        sum = 0u; cnt = 0u; mine = 0u;
#pragma unroll
        for (unsigned j = 0; j < 16; ++j) { const unsigned c = xb_ld(&bar[XB_XCNT(j)]); sum += c; cnt += (c > 0u) ? 1u : 0u; mine = (j == x) ? c : mine; }
        if (sum == G) break;
        __builtin_amdgcn_s_sleep(1);
        if ((++sp & 255u) == 0u) { if (xb_ld(&bar[XB_TMO])) break; if (sp > XB_SPIN_CAP) { atomicAdd(&bar[XB_TMO], 1u); break; } }
    }
    nloc = mine > 0u ? mine : 1u; nx = cnt > 0u ? cnt : 1u;
}

__device__ __forceinline__ void xcd_barrier(const XcdBarrier& b) {
    asm volatile("s_waitcnt vmcnt(0)" ::: "memory");
    __syncthreads();
    if (threadIdx.x == 0) {
        unsigned* bar = b.bar;
        __builtin_amdgcn_s_waitcnt(0);
        unsigned nloc = b.st[0], nx = b.st[1];
        if (nloc == 0u) { xcd_barrier_complete(bar, b.x, nloc, nx); b.st[0] = nloc; b.st[1] = nx; }
        const unsigned old = xb_add(&bar[XB_XSUB(b.x)], 1u);
        const unsigned gen = old / nloc;
        if (old + 1u == (gen + 1u) * nloc) {
            __builtin_amdgcn_fence(__ATOMIC_RELEASE, "agent");
            asm volatile("s_waitcnt vmcnt(0)" ::: "memory");
            const unsigned og = xb_add(&bar[XB_TOP], 1u);
            const unsigned tg = og / nx;
            if (og + 1u == (tg + 1u) * nx) xb_add(&bar[XB_TOPGEN], 1u);
            else XB_SPIN(xb_ld(&bar[XB_TOPGEN]) == tg, bar);
            __builtin_amdgcn_fence(__ATOMIC_ACQUIRE, "agent");
            xb_add(&bar[XB_XGEN(b.x)], 1u);
            asm volatile("s_waitcnt vmcnt(0)" ::: "memory");
        } else {
            XB_SPIN(xb_ld(&bar[XB_XGEN(b.x)]) == gen, bar);
            __builtin_amdgcn_fence(__ATOMIC_ACQUIRE, "agent");
            asm volatile("s_waitcnt vmcnt(0)" ::: "memory");
        }
    }
    __syncthreads();
}

constexpr size_t WS_BAR = 786432;
constexpr int XB_LDS_OFF = LDS_BYTES - 16;
typedef const __attribute__((address_space(4))) Params* KParamsPtr;
__device__ __forceinline__ Params load_params(KParamsPtr q) {
    Params r; r.x = q->x; r.c = q->c; r.w_ada = q->w_ada; r.b_ada = q->b_ada; r.g_attn = q->g_attn; r.w_in = q->w_in; r.qna = q->qna; r.kna = q->kna; r.qnb = q->qnb; r.knb = q->knb;
    r.lam = q->lam; r.subln = q->subln; r.w_out = q->w_out; r.g_ffn = q->g_ffn; r.w_up = q->w_up; r.conv_w = q->conv_w; r.conv_b = q->conv_b; r.w_down = q->w_down; r.rel_bias = q->rel_bias;
    r.out = q->out; r.ws = q->ws; return r;
}
#define FRESH_PARAMS() KParamsPtr pp_ = (KParamsPtr)__builtin_amdgcn_kernarg_segment_ptr(); asm volatile("" : "+s"(pp_)); const Params p = load_params(pp_); \
    float* mod = (float*)(p.ws + WS_MOD); bf16_t* H = (bf16_t*)(p.ws + WS_H); const int G = (int)gridDim.x, cb = (int)blockIdx.x; (void)mod; (void)H; (void)G; (void)cb
__global__ void __launch_bounds__(512, 2) hybrid_block_fwd(Params p_unused) {
    extern __shared__ __attribute__((aligned(16))) unsigned char lds_raw[];
    LAS unsigned char* lds = (LAS unsigned char*)lds_raw;
    cg::grid_group grid = cg::this_grid();
    if (threadIdx.x < 4) ((LAS unsigned*)(lds + XB_LDS_OFF))[threadIdx.x] = 0u;
    __syncthreads();
    const int wv = __builtin_amdgcn_readfirstlane((int)threadIdx.x >> 6);
    { FRESH_PARAMS(); if (blockIdx.x == 0) { unsigned* bw = (unsigned*)(p.ws + WS_BAR); for (int i = threadIdx.x; i < XCD_BAR_WORDS; i += 512) bw[i] = 0u; }
      phase0(p, lds, wv); }
    grid.sync();
    XcdBarrier bar;
    { FRESH_PARAMS(); bar = xcd_barrier_post((unsigned*)(p.ws + WS_BAR), (volatile LAS unsigned*)(lds + XB_LDS_OFF)); }
    { FRESH_PARAMS(); norm_phase(p.x, p.g_attn, mod, 1024, 0, H, wv); }
    xcd_barrier(bar);
    {
        FRESH_PARAMS();
        pg8::Gemm g{H, (const bf16_t*)(p.ws + WS_WIN), MTOK, NPROJ, DM}; pg8::StaticOrder S; S.init(MTOK, NPROJ, G, cb);
        EpiProj E{p.ws, p.qna, p.kna, p.qnb, p.knb};
#pragma unroll 1
        for (int rep = 0; rep < REPG1; ++rep) pg8::gemm_phase<EpiProj, pg8::StaticOrder, true, true>(lds, g, S, E, wv);
    }
    xcd_barrier(bar);
    { FRESH_PARAMS(); attnA_phase(p, lds, wv); }
    __syncthreads();
    { FRESH_PARAMS(); phaseB(p, lds, wv); }
    xcd_barrier(bar);
    {
        FRESH_PARAMS();
        pg8::Gemm g{(const bf16_t*)(p.ws + WS_CAT), (const bf16_t*)(p.ws + WS_WOUT), MTOK, DM, DM}; pg8::StaticOrder S; S.init(MTOK, DM, G, cb);
        EpiOut E{p.x, mod + 2048, (bf16_t*)(p.ws + WS_X1B)};
#pragma unroll 1
        for (int rep = 0; rep < REPG2; ++rep) pg8::gemm_phase<EpiOut, pg8::StaticOrder, true, true>(lds, g, S, E, wv);
    }
    xcd_barrier(bar);
    { FRESH_PARAMS(); norm_phase_b16((const bf16_t*)(p.ws + WS_X1B), p.g_ffn, mod, 4096, 3072, H, wv); }
    xcd_barrier(bar);
    {
        FRESH_PARAMS();
        pg8::Gemm g{H - 2 * DM, (const bf16_t*)(p.ws + WS_WUP), 259 * 256, NUP, DM, 254}; pg8::StaticOrder S; S.init(259 * 256, NUP, G, cb);
        EpiUpConv E{(bf16_t*)(p.ws + WS_U), p.conv_w, p.conv_b, (LAS float*)(lds + HALO_OFF)};
#pragma unroll 1
        for (int rep = 0; rep < REPG3; ++rep) pg8::gemm_phase<EpiUpConv, pg8::StaticOrder, true, true>(lds, g, S, E, wv);
    }
    xcd_barrier(bar);
    {
        FRESH_PARAMS();
        pg8::Gemm g{(const bf16_t*)(p.ws + WS_U), (const bf16_t*)(p.ws + WS_WDN), MTOK, DM, DFF}; pg8::StaticOrder S; S.init(MTOK, DM, G, cb);
        EpiDown E{mod + 5120, p.out, (const bf16_t*)(p.ws + WS_X1B)};
        pg8::gemm_phase<EpiDown, pg8::StaticOrder, true, true>(lds, g, S, E, wv);
    }
}

extern "C" void kernel_launch(void* const* d_in, const int* in_sizes, int n_in, void* d_out, int out_size, void* d_ws, size_t ws_size, hipStream_t stream) {
    static int grid_blocks = 0;
    if (grid_blocks == 0) {
        if (n_in != 19 || ws_size < WS_END) { fprintf(stderr, "kernel_launch: unexpected n_in %d / ws %zu\n", n_in, ws_size); grid_blocks = -1; return; }
        int dev = 0, cus = 0, per_cu = 0;
        hipGetDevice(&dev);
        hipDeviceGetAttribute(&cus, hipDeviceAttributeMultiprocessorCount, dev);
        if (hipFuncSetAttribute((const void*)hybrid_block_fwd, hipFuncAttributeMaxDynamicSharedMemorySize, LDS_BYTES) != hipSuccess) { fprintf(stderr, "hipFuncSetAttribute failed\n"); }
        if (hipOccupancyMaxActiveBlocksPerMultiprocessor(&per_cu, (const void*)hybrid_block_fwd, 512, LDS_BYTES) != hipSuccess || per_cu < 1) { fprintf(stderr, "occupancy query: %d\n", per_cu); per_cu = 1; }
        (void)hipGetLastError();
        grid_blocks = cus * (per_cu > 1 ? 1 : per_cu);
        if (grid_blocks > 256) grid_blocks = 256;
    }
    if (grid_blocks < 0) return;
    Params p{};
    const float** f = (const float**)&p;
    for (int i = 0; i < 19; ++i) f[i] = (const float*)d_in[i];
    p.out = (float*)d_out; p.ws = (unsigned char*)d_ws;
    void* args[] = {&p};
    hipError_t e = hipLaunchCooperativeKernel((const void*)hybrid_block_fwd, dim3(grid_blocks), dim3(512), args, LDS_BYTES, stream);
    if (e != hipSuccess) fprintf(stderr, "cooperative launch failed: %s (grid %d)\n", hipGetErrorString(e), grid_blocks);
}
```
